# Optimizing an MI355X kernel written in HIP

```python
import math
import jax, jax.numpy as jnp
from jax import lax
import numpy as np

D_MODEL = 1024
BATCH = 4
SEQ = 4096
DEPTH = 1

N_META = 16
BLOCK_Q = 128
A_HEADS = 8
A_HEAD_DIM = 64
A_WIDTH = A_HEADS * A_HEAD_DIM
IDX_HEADS = 8
IDX_DIM = 64
TOPK_MAX = 256
B_HEADS = 8
B_NOPE = 64
B_ROPE = 32
B_V = 64
B_WIDTH = B_HEADS * B_V
Q_LORA = 256
KV_LORA = 128
ROPE_THETA = 10000.0
REL_BUCKETS = 32
REL_MAX_DIST = 128
D_MIX = A_WIDTH + B_WIDTH
IN_SPLITS = (
    A_WIDTH,
    A_WIDTH,
    A_WIDTH,
    A_WIDTH,
    IDX_HEADS * IDX_DIM,
    IDX_DIM,
    IDX_HEADS,
    Q_LORA,
    KV_LORA,
    B_ROPE,
    B_WIDTH,
)
D_IN = sum(IN_SPLITS)
IN_OFFSETS = tuple(int(v) for v in np.cumsum(IN_SPLITS)[:-1])
ALPHA = (2.0 * DEPTH) ** 0.25
BETA = (8.0 * DEPTH) ** -0.25
LN_EPS = 1e-5
RMS_EPS = 1e-6
NEG = float(np.finfo(np.float32).min)

kernel_name = "hymba_dsa_mla_deepnorm"


def layer_norm(x, g, b):
    x32 = x.astype(jnp.float32)
    mu = jnp.mean(x32, axis=-1, keepdims=True)
    var = jnp.mean(jnp.square(x32 - mu), axis=-1, keepdims=True)
    y = (x32 - mu) * lax.rsqrt(var + LN_EPS)
    return (y * g.astype(jnp.float32) + b.astype(jnp.float32)).astype(x.dtype)


def rms_norm(x, g):
    x32 = x.astype(jnp.float32)
    y = x32 * lax.rsqrt(jnp.mean(jnp.square(x32), axis=-1, keepdims=True) + RMS_EPS)
    return (y * g.astype(jnp.float32)).astype(x.dtype)


def apply_rope(x, cos, sin):
    x32 = x.astype(jnp.float32)
    half = x.shape[-1] // 2
    x1, x2 = x32[..., :half], x32[..., half:]
    return jnp.concatenate([x1 * cos - x2 * sin, x2 * cos + x1 * sin], axis=-1).astype(x.dtype)


def t5_bucket(dist):
    max_exact = REL_BUCKETS // 2
    d = jnp.maximum(dist, 0)
    d_f = jnp.maximum(d, 1).astype(jnp.float32)
    large = max_exact + (jnp.log(d_f / max_exact) / math.log(REL_MAX_DIST / max_exact)
                         * (REL_BUCKETS - max_exact)).astype(jnp.int32)
    large = jnp.minimum(large, REL_BUCKETS - 1)
    return jnp.where(d < max_exact, d, large)


def hybrid_layer(h, w_in, w_uq, q_norm_g, w_ukv, kv_norm_g, rel_bias, w_out, ln_g, ln_b,
                 cos, sin, topk, n_blk):
    B, Lp, _ = h.shape
    proj = h @ w_in
    (qa, ka, va, ga, qi, ki, wi, cq, ckv, kpe, gb) = jnp.split(proj, IN_OFFSETS, axis=-1)

    qa = qa.reshape(B, Lp, A_HEADS, A_HEAD_DIM)
    ka = ka.reshape(B, Lp, A_HEADS, A_HEAD_DIM)
    va = va.reshape(B, Lp, A_HEADS, A_HEAD_DIM)
    qi = qi.reshape(B, Lp, IDX_HEADS, IDX_DIM)
    wi = wi * (IDX_HEADS ** -0.5)

    qb = (rms_norm(cq, q_norm_g) @ w_uq).reshape(B, Lp, B_HEADS, B_NOPE + B_ROPE)
    q_nope, q_pe = qb[..., :B_NOPE], qb[..., B_NOPE:]
    q_pe = apply_rope(q_pe, cos[:, None, :], sin[:, None, :])
    kvb = (rms_norm(ckv, kv_norm_g) @ w_ukv).reshape(B, Lp, B_HEADS, B_NOPE + B_V)
    k_nope, vb = kvb[..., :B_NOPE], kvb[..., B_NOPE:]
    k_pe = apply_rope(kpe, cos, sin)

    scale_a = A_HEAD_DIM ** -0.5
    scale_i = IDX_DIM ** -0.5
    scale_b = (B_NOPE + B_ROPE) ** -0.5
    s_pos = jnp.arange(Lp, dtype=jnp.int32)
    bidx = jnp.arange(B)[:, None, None]

    def block(i):
        q0 = i * BLOCK_Q
        t_pos = q0 + jnp.arange(BLOCK_Q, dtype=jnp.int32)
        causal = s_pos[None, :] <= t_pos[:, None]
        sl = lambda a: lax.dynamic_slice_in_dim(a, q0, BLOCK_Q, axis=1)

        rel = jnp.einsum('bqhd,bkd->bqhk', sl(qi), ki,
                         preferred_element_type=jnp.float32) * scale_i
        idx_score = jnp.einsum('bqhk,bqh->bqk', jax.nn.relu(rel),
                               sl(wi).astype(jnp.float32))
        idx_score = jnp.where(s_pos[None, None, :] < N_META, jnp.inf, idx_score)
        idx_score = jnp.where(causal[None], idx_score, -jnp.inf)
        _, sel = lax.top_k(idx_score, topk)
        valid = sel <= t_pos[None, :, None]
        k_sel = ka[bidx, sel]
        v_sel = va[bidx, sel]
        la = jnp.einsum('bqhd,bqkhd->bqhk', sl(qa), k_sel,
                        preferred_element_type=jnp.float32) * scale_a
        bias = rel_bias[t5_bucket(t_pos[None, :, None] - sel)].astype(jnp.float32)
        la = la + jnp.transpose(bias, (0, 1, 3, 2))
        la = jnp.where(valid[:, :, None, :], la, NEG)
        pa = jax.nn.softmax(la, axis=-1).astype(v_sel.dtype)
        oa = jnp.einsum('bqhk,bqkhd->bqhd', pa, v_sel).reshape(B, BLOCK_Q, A_WIDTH)

        lb = (jnp.einsum('bqhd,bkhd->bhqk', sl(q_nope), k_nope, preferred_element_type=jnp.float32)
              + jnp.einsum('bqhr,bkr->bhqk', sl(q_pe), k_pe, preferred_element_type=jnp.float32)) * scale_b
        lb = jnp.where(causal[None, None], lb, NEG)
        pb = jax.nn.softmax(lb, axis=-1).astype(vb.dtype)
        ob = jnp.einsum('bhqk,bkhd->bqhd', pb, vb).reshape(B, BLOCK_Q, B_WIDTH)
        return oa, ob

    oa, ob = lax.map(block, jnp.arange(n_blk, dtype=jnp.int32))
    oa = jnp.transpose(oa, (1, 0, 2, 3)).reshape(B, Lp, A_WIDTH)
    ob = jnp.transpose(ob, (1, 0, 2, 3)).reshape(B, Lp, B_WIDTH)

    mixed = jnp.concatenate([oa * jax.nn.silu(ga), ob * jax.nn.silu(gb)], axis=-1)
    out = mixed @ w_out
    return layer_norm(ALPHA * h + out, ln_g, ln_b)


def setup_inputs(seed: int = 0) -> dict:
    key = jax.random.key(seed)
    ks = jax.random.split(key, 16)
    f32 = jnp.float32
    nrm = lambda k, shape: jax.random.normal(k, shape, dtype=f32)
    return {
        "x": nrm(ks[0], (BATCH, SEQ, D_MODEL)),
        "meta_tokens": nrm(ks[1], (N_META, D_MODEL)),
        "ln_emb_g": 1.0 + 0.02 * nrm(ks[2], (D_MODEL,)),
        "ln_emb_b": 0.02 * nrm(ks[3], (D_MODEL,)),
        "w_in": nrm(ks[4], (DEPTH, D_MODEL, D_IN)) * D_MODEL ** -0.5,
        "w_uq": nrm(ks[5], (DEPTH, Q_LORA, B_HEADS * (B_NOPE + B_ROPE))) * Q_LORA ** -0.5,
        "q_norm_g": 1.0 + 0.02 * nrm(ks[6], (DEPTH, Q_LORA)),
        "w_ukv": nrm(ks[7], (DEPTH, KV_LORA, B_HEADS * (B_NOPE + B_V))) * KV_LORA ** -0.5,
        "kv_norm_g": 1.0 + 0.02 * nrm(ks[8], (DEPTH, KV_LORA)),
        "rel_bias": 0.2 * nrm(ks[9], (REL_BUCKETS, A_HEADS)),
        "w_out": nrm(ks[10], (DEPTH, D_MIX, D_MODEL)) * (D_MIX ** -0.5) * BETA,
        "ln_post_g": 1.0 + 0.02 * nrm(ks[11], (DEPTH, D_MODEL)),
        "ln_post_b": 0.02 * nrm(ks[12], (DEPTH, D_MODEL)),
    }


def reference(x, meta_tokens, ln_emb_g, ln_emb_b, w_in, w_uq, q_norm_g, w_ukv, kv_norm_g,
              rel_bias, w_out, ln_post_g, ln_post_b):
    B, S, D = x.shape
    L = N_META + S
    n_blk = -(-L // BLOCK_Q)
    Lp = n_blk * BLOCK_Q
    topk = min(TOPK_MAX, S // 4)

    meta = jnp.broadcast_to(meta_tokens[None].astype(x.dtype), (B, N_META, D))
    h = jnp.concatenate([meta, x], axis=1)
    h = layer_norm(h, ln_emb_g, ln_emb_b)
    h = jnp.pad(h, ((0, 0), (0, Lp - L), (0, 0)))

    pos = jnp.arange(Lp, dtype=jnp.float32)
    inv_freq = ROPE_THETA ** (-jnp.arange(0, B_ROPE, 2, dtype=jnp.float32) / B_ROPE)
    ang = pos[:, None] * inv_freq[None, :]
    cos, sin = jnp.cos(ang), jnp.sin(ang)

    for l in range(DEPTH):
        h = hybrid_layer(h, w_in[l], w_uq[l], q_norm_g[l], w_ukv[l], kv_norm_g[l], rel_bias,
                         w_out[l], ln_post_g[l], ln_post_b[l], cos, sin, topk, n_blk)
    return h[:, N_META:N_META + S, :]
```

```cpp
#include <hip/hip_runtime.h>
#include <hip/hip_cooperative_groups.h>
#include <cstdio>
#include <cstdint>
#include <cmath>

constexpr int BATCH = 4, SEQ = 4096, DM = 1024, NMETA = 16;
constexpr int LTOK = NMETA + SEQ;
constexpr int LP = 4160;
constexpr int MROWS = BATCH * LP;
constexpr int MQ = BATCH * SEQ;
constexpr int DIN = 3560, DINP = 3584;
constexpr int OFF_QA = 0, OFF_KA = 512, OFF_VA = 1024, OFF_GA = 1536, OFF_QI = 2048, OFF_KI = 2560, OFF_WI = 2624,
              OFF_CQ = 2632, OFF_CKV = 2888, OFF_KPE = 3016, OFF_GB = 3048;
constexpr int KMLA = 384, NMLA = 1792;
constexpr int TOPK = 256, KSEL = TOPK - NMETA;
constexpr int NW64 = LP / 64;
constexpr float LN_EPS = 1e-5f, RMS_EPS = 1e-6f;
constexpr float ALPHA = 1.189207115002721f;

constexpr size_t MiB = 1u << 20;
constexpr size_t WS_CTL = 0;
constexpr size_t WS_WIN = 2 * MiB;
constexpr size_t WS_WMLA = 9 * MiB;
constexpr size_t WS_WOUT = 11 * MiB;
constexpr size_t WS_KPER = 13 * MiB;
constexpr size_t WS_BM = 15 * MiB;
constexpr size_t WS_CQKVN = 24 * MiB;
constexpr size_t WS_XN = 37 * MiB;
constexpr size_t WS_QKVB = 70 * MiB;
constexpr size_t WS_P = 127 * MiB;
constexpr size_t WS_END = 241 * MiB;

typedef unsigned short bf16;
typedef unsigned long long u64;
typedef unsigned v4u __attribute__((ext_vector_type(4)));
typedef float f32x4 __attribute__((ext_vector_type(4)));

__device__ __forceinline__ float bf2f(bf16 v) { return __uint_as_float((unsigned)v << 16); }
__device__ __forceinline__ unsigned f2bf(float f) { unsigned u = __float_as_uint(f); return (u + 0x7fffu + ((u >> 16) & 1u)) >> 16; }
__device__ __forceinline__ unsigned pk2(float lo, float hi) { return f2bf(lo) | (f2bf(hi) << 16); }
__device__ __forceinline__ float wave_sum(float v) {
#pragma unroll
    for (int o = 1; o < 64; o <<= 1) v += __shfl_xor(v, o);
    return v;
}
__device__ __forceinline__ float wave_max(float v) {
#pragma unroll
    for (int o = 1; o < 64; o <<= 1) v = fmaxf(v, __shfl_xor(v, o));
    return v;
}
__device__ __forceinline__ int wave_isum(int v) {
#pragma unroll
    for (int o = 1; o < 64; o <<= 1) v += __shfl_xor(v, o);
    return v;
}
__device__ __forceinline__ int t5_bucket(int d) {
    if (d < 16) return d < 0 ? 0 : d;
    return 16 + (d >= 19) + (d >= 21) + (d >= 24) + (d >= 27) + (d >= 31) + (d >= 35) + (d >= 40) + (d >= 46) + (d >= 52) + (d >= 59) + (d >= 67) + (d >= 77) + (d >= 87) + (d >= 99) + (d >= 113);
}
__device__ __forceinline__ unsigned fkey(float f) { unsigned u = __float_as_uint(f); return (u & 0x80000000u) ? ~u : (u | 0x80000000u); }

struct Args {
    const float* in[13];
    float* out;
    unsigned char* ws;
    float inv_freq[16];
    int ph_lo, ph_hi;
};

struct Frame {
    int tid, lane, wave, G, bid;
    const float *x, *meta, *lne_g, *lne_b, *w_in, *w_uq, *qn_g, *w_ukv, *kvn_g, *rel_bias, *w_out, *lnp_g, *lnp_b;
    float* out;
    bf16 *Win_t, *Wmla_t, *Wout_t, *KPER, *CQKVN, *XN, *MIX, *QKVB, *P;
    u64* BM;
    float* Z;
};

template <class F> __device__ __forceinline__ void transpose_tile(F src, bf16* dst, int ldk, int n0, int k0, float* scr, int tid) {
    const int ty = tid >> 6, tx = tid & 63;
#pragma unroll
    for (int i = 0; i < 8; ++i) { const int k = ty + 8 * i; scr[k * 65 + tx] = src(k0 + k, n0 + tx); }
    __syncthreads();
    const int nn = tid >> 3, kc = tid & 7;
    v4u o; o.x = pk2(scr[(8 * kc + 0) * 65 + nn], scr[(8 * kc + 1) * 65 + nn]); o.y = pk2(scr[(8 * kc + 2) * 65 + nn], scr[(8 * kc + 3) * 65 + nn]);
    o.z = pk2(scr[(8 * kc + 4) * 65 + nn], scr[(8 * kc + 5) * 65 + nn]); o.w = pk2(scr[(8 * kc + 6) * 65 + nn], scr[(8 * kc + 7) * 65 + nn]);
    *(v4u*)(dst + (size_t)(n0 + nn) * ldk + k0 + 8 * kc) = o;
    __syncthreads();
}
__device__ __forceinline__ void ph_prologue(const Frame& F, float* lds) {
    constexpr int I_IN = (DINP / 64) * (DM / 64), I_MLA = (NMLA / 64) * (KMLA / 64), I_OUT = (DM / 64) * (DM / 64);
    for (int it = F.bid; it < I_IN + I_MLA + I_OUT; it += F.G) {
        if (it < I_IN) {
            const int n0 = (it / (DM / 64)) * 64, k0 = (it % (DM / 64)) * 64; const float* w = F.w_in;
            transpose_tile([=](int k, int n) { return n < DIN ? w[(size_t)k * DIN + n] : 0.f; }, F.Win_t, DM, n0, k0, lds, F.tid);
        } else if (it < I_IN + I_MLA) {
            const int r = it - I_IN, n0 = (r / (KMLA / 64)) * 64, k0 = (r % (KMLA / 64)) * 64;
            const float *wq = F.w_uq, *wkv = F.w_ukv, *gq = F.qn_g, *gkv = F.kvn_g;
            transpose_tile([=](int k, int n) {
                if (n < 768) return k < 256 ? wq[(size_t)k * 768 + n] * gq[k] : 0.f;
                return k >= 256 ? wkv[(size_t)(k - 256) * 1024 + (n - 768)] * gkv[k - 256] : 0.f; }, F.Wmla_t, KMLA, n0, k0, lds, F.tid);
        } else {
            const int r = it - I_IN - I_MLA, n0 = (r / (DM / 64)) * 64, k0 = (r % (DM / 64)) * 64; const float* w = F.w_out;
            transpose_tile([=](int k, int n) { return w[(size_t)k * DM + n]; }, F.Wout_t, DM, n0, k0, lds, F.tid);
        }
    }
    const int gw = F.bid * 8 + F.wave, NGW = F.G * 8;
    for (int m = gw; m < MROWS; m += NGW) {
        const int b = m / LP, p = m % LP;
        unsigned long long* o8 = (unsigned long long*)(F.XN + (size_t)m * DM) + F.lane;
        if (p >= LTOK) {
#pragma unroll
            for (int j = 0; j < 4; ++j) o8[64 * j] = 0ull;
            continue;
        }
        const float* src = p < NMETA ? F.meta + (size_t)p * DM : F.x + ((size_t)b * SEQ + (p - NMETA)) * DM;
        const f32x4* xr = (const f32x4*)src + F.lane;
        f32x4 v[4]; float s = 0.f;
#pragma unroll
        for (int j = 0; j < 4; ++j) { v[j] = xr[64 * j]; s += (v[j].x + v[j].y) + (v[j].z + v[j].w); }
        const float mean = wave_sum(s) * (1.f / DM); float s2 = 0.f;
#pragma unroll
        for (int j = 0; j < 4; ++j) { v[j] = v[j] - mean; s2 += (v[j].x * v[j].x + v[j].y * v[j].y) + (v[j].z * v[j].z + v[j].w * v[j].w); }
        const float rstd = 1.f / sqrtf(wave_sum(s2) * (1.f / DM) + LN_EPS);
#pragma unroll
        for (int j = 0; j < 4; ++j) {
            const f32x4 g = ((const f32x4*)F.lne_g)[F.lane + 64 * j], bb = ((const f32x4*)F.lne_b)[F.lane + 64 * j];
            const f32x4 y = v[j] * rstd * g + bb;
            o8[64 * j] = (unsigned long long)pk2(y.x, y.y) | ((unsigned long long)pk2(y.z, y.w) << 32);
        }
    }
}

__device__ __forceinline__ void ph_gemm_naive(const Frame& F, const bf16* A, int lda, const bf16* Bt, int ldb, int M, int N, int K, bf16* Cb, float* Cf, int ldc) {
    const int tn = F.tid & 63, tm = F.tid >> 6;
    const int ntn = N / 64, ntm = M / 8; const long nt = (long)ntn * ntm;
    for (long t = F.bid; t < nt; t += F.G) {
        const int m = (int)(t / ntn) * 8 + tm, n = (int)(t % ntn) * 64 + tn;
        const v4u* a = (const v4u*)(A + (size_t)m * lda); const v4u* b = (const v4u*)(Bt + (size_t)n * ldb);
        float acc = 0.f;
        for (int k = 0; k < K / 8; ++k) {
            const v4u av = a[k], bv = b[k];
#pragma unroll
            for (int j = 0; j < 4; ++j) { acc += __uint_as_float(av[j] << 16) * __uint_as_float(bv[j] << 16); acc += __uint_as_float(av[j] & 0xffff0000u) * __uint_as_float(bv[j] & 0xffff0000u); }
        }
        if (Cb) Cb[(size_t)m * ldc + n] = (bf16)f2bf(acc); else Cf[(size_t)m * ldc + n] = acc;
    }
}

__device__ __forceinline__ void ph_rms(const Frame& F, const float* inv_freq) {
    const int gw = F.bid * 8 + F.wave, NGW = F.G * 8, lane = F.lane;
    for (int m = gw; m < MROWS; m += NGW) {
        const bf16* pr = F.P + (size_t)m * DINP; const int p = m % LP;
        const unsigned long long cq4 = *(const unsigned long long*)(pr + OFF_CQ + 4 * lane);
        const unsigned ckv2 = *(const unsigned*)(pr + OFF_CKV + 2 * lane);
        float c[4] = {bf2f((bf16)(cq4 & 0xffff)), bf2f((bf16)((cq4 >> 16) & 0xffff)), bf2f((bf16)((cq4 >> 32) & 0xffff)), bf2f((bf16)(cq4 >> 48))};
        float d[2] = {bf2f((bf16)(ckv2 & 0xffff)), bf2f((bf16)(ckv2 >> 16))};
        const float sq = wave_sum(c[0] * c[0] + c[1] * c[1] + c[2] * c[2] + c[3] * c[3]), skv = wave_sum(d[0] * d[0] + d[1] * d[1]);
        const float rq = 1.f / sqrtf(sq * (1.f / 256.f) + RMS_EPS), rkv = 1.f / sqrtf(skv * (1.f / 128.f) + RMS_EPS);
        bf16* o = F.CQKVN + (size_t)m * KMLA;
        *(unsigned long long*)(o + 4 * lane) = (unsigned long long)pk2(c[0] * rq, c[1] * rq) | ((unsigned long long)pk2(c[2] * rq, c[3] * rq) << 32);
        *(unsigned*)(o + 256 + 2 * lane) = pk2(d[0] * rkv, d[1] * rkv);
        if (lane < 16) {
            const float x1 = bf2f(pr[OFF_KPE + lane]), x2 = bf2f(pr[OFF_KPE + 16 + lane]);
            const float ang = (float)p * inv_freq[lane]; const float cs = cosf(ang), sn = sinf(ang);
            F.KPER[(size_t)m * 32 + lane] = (bf16)f2bf(x1 * cs - x2 * sn); F.KPER[(size_t)m * 32 + 16 + lane] = (bf16)f2bf(x2 * cs + x1 * sn);
        }
    }
}

__device__ __forceinline__ void ph_index_naive(const Frame& F, unsigned char* lds) {
    unsigned* ks = (unsigned*)(lds) + F.wave * (LP + 512); float* qs = (float*)(ks + LP);
    const int gw = F.bid * 8 + F.wave, NGW = F.G * 8, lane = F.lane;
    for (int qi = gw; qi < MQ; qi += NGW) {
        const int b = qi / SEQ, tq = qi % SEQ, p = NMETA + tq; const size_t qrow = (size_t)b * LP + p;
        const bf16* pr = F.P + qrow * DINP;
        for (int i = lane; i < 512; i += 64) qs[i] = bf2f(pr[OFF_QI + i]);
        float ch[8];
#pragma unroll
        for (int h = 0; h < 8; ++h) ch[h] = bf2f(pr[OFF_WI + h]) * 0.35355339059327373f;
        __builtin_amdgcn_s_waitcnt(0); __builtin_amdgcn_wave_barrier();
        const int nt = p / 64 + 1;
        for (int i = 0; i < NW64; ++i) {
            const int s = 64 * i + lane; unsigned key = 0u;
            if (i < nt && s >= NMETA && s <= p) {
                const v4u* kr = (const v4u*)(F.P + ((size_t)b * LP + s) * DINP + OFF_KI);
                float kf[64];
#pragma unroll
                for (int c = 0; c < 8; ++c) { const v4u v = kr[c];
#pragma unroll
                    for (int j = 0; j < 4; ++j) { kf[8 * c + 2 * j] = __uint_as_float(v[j] << 16); kf[8 * c + 2 * j + 1] = __uint_as_float(v[j] & 0xffff0000u); } }
                float sc = 0.f;
#pragma unroll
                for (int h = 0; h < 8; ++h) { float a = 0.f;
#pragma unroll
                    for (int d = 0; d < 64; ++d) a += qs[64 * h + d] * kf[d];
                    sc += fmaxf(a * 0.125f, 0.f) * ch[h]; }
                key = fkey(sc);
            }
            ks[s] = key;
        }
        __builtin_amdgcn_s_waitcnt(0); __builtin_amdgcn_wave_barrier();
        unsigned thr = 0u;
        for (int bit = 31; bit >= 0; --bit) {
            const unsigned cand = thr | (1u << bit); int c = 0;
            for (int i = 0; i < nt; ++i) c += (ks[64 * i + lane] >= cand) ? 1 : 0;
            c = wave_isum(c);
            if (c >= KSEL) thr = cand;
        }
        int sstar = LP;
        if (thr != 0u) {
            int cge = 0, cgt = 0;
            for (int i = 0; i < nt; ++i) { const unsigned k = ks[64 * i + lane]; cge += (k >= thr); cgt += (k > thr); }
            cge = wave_isum(cge); cgt = wave_isum(cgt);
            if (cge > KSEL) {
                const int need = KSEL - cgt; int lo = 0, hi = LP - 1;
                while (lo < hi) { const int mid = (lo + hi) >> 1; int c = 0;
                    for (int i = 0; i < nt; ++i) { const int s = 64 * i + lane; c += (ks[s] == thr && s <= mid); }
                    c = wave_isum(c); if (c >= need) hi = mid; else lo = mid + 1; }
                sstar = lo;
            }
        }
        const unsigned te = thr == 0u ? 1u : thr;
        u64* bm = F.BM + (size_t)qi * NW64;
        for (int i = 0; i < NW64; ++i) {
            const int s = 64 * i + lane; const unsigned k = ks[s];
            const bool sel = (s < NMETA) || (k >= te && (k > thr || s <= sstar));
            const u64 w = __ballot(sel);
            if (lane == 0) bm[i] = w;
        }
        __builtin_amdgcn_s_waitcnt(0); __builtin_amdgcn_wave_barrier();
    }
}

__device__ __forceinline__ void ph_attn_naive(const Frame& F, unsigned char* lds, const float* inv_freq) {
    float* sc = (float*)(lds) + F.wave * (LP + 96); float* qs = sc + LP;
    const int gw = F.bid * 8 + F.wave, NGW = F.G * 8, lane = F.lane;
    const int NTASK = 2 * BATCH * 8 * SEQ;
    for (int task = gw; task < NTASK; task += NGW) {
        const int tq = task % SEQ, h = (task / SEQ) % 8, b = (task / (SEQ * 8)) % BATCH, mixer = task / (SEQ * 8 * BATCH);
        const int p = NMETA + tq; const size_t qrow = (size_t)b * LP + p; const int nt = p / 64 + 1;
        float mx = -INFINITY;
        if (mixer == 0) {
            qs[lane] = bf2f(F.P[qrow * DINP + OFF_QA + 64 * h + lane]);
            __builtin_amdgcn_s_waitcnt(0); __builtin_amdgcn_wave_barrier();
            const u64* bm = F.BM + ((size_t)b * SEQ + tq) * NW64;
            for (int i = 0; i < nt; ++i) {
                const int s = 64 * i + lane; const u64 w = bm[i]; float v = -INFINITY;
                if ((w >> lane) & 1ull) {
                    const v4u* kr = (const v4u*)(F.P + ((size_t)b * LP + s) * DINP + OFF_KA + 64 * h); float a = 0.f;
#pragma unroll
                    for (int c = 0; c < 8; ++c) { const v4u kv = kr[c];
#pragma unroll
                        for (int j = 0; j < 4; ++j) { a += qs[8 * c + 2 * j] * __uint_as_float(kv[j] << 16); a += qs[8 * c + 2 * j + 1] * __uint_as_float(kv[j] & 0xffff0000u); } }
                    v = a * 0.125f + F.rel_bias[t5_bucket(p - s) * 8 + h];
                }
                sc[s] = v; mx = fmaxf(mx, v);
            }
        } else {
            for (int i = lane; i < 96; i += 64) qs[i] = bf2f(F.QKVB[qrow * NMLA + 96 * h + i]);
            __builtin_amdgcn_s_waitcnt(0); __builtin_amdgcn_wave_barrier();
            if (lane < 16) { const float x1 = qs[64 + lane], x2 = qs[80 + lane]; const float ang = (float)p * inv_freq[lane]; const float cs = cosf(ang), sn = sinf(ang);
                qs[64 + lane] = x1 * cs - x2 * sn; qs[80 + lane] = x2 * cs + x1 * sn; }
            __builtin_amdgcn_s_waitcnt(0); __builtin_amdgcn_wave_barrier();
            for (int i = 0; i < nt; ++i) {
                const int s = 64 * i + lane; float v = -INFINITY;
                if (s <= p) {
                    const size_t srow = (size_t)b * LP + s;
                    const v4u* kr = (const v4u*)(F.QKVB + srow * NMLA + 768 + 128 * h); const v4u* pe = (const v4u*)(F.KPER + srow * 32); float a = 0.f;
#pragma unroll
                    for (int c = 0; c < 12; ++c) { const v4u kv = c < 8 ? kr[c] : pe[c - 8];
#pragma unroll
                        for (int j = 0; j < 4; ++j) { a += qs[8 * c + 2 * j] * __uint_as_float(kv[j] << 16); a += qs[8 * c + 2 * j + 1] * __uint_as_float(kv[j] & 0xffff0000u); } }
                    v = a * 0.10206207261596577f;
                }
                sc[s] = v; mx = fmaxf(mx, v);
            }
        }
        mx = wave_max(mx);
        float sum = 0.f;
        for (int i = 0; i < nt; ++i) { const int s = 64 * i + lane; const float e = __expf(sc[s] - mx); sc[s] = e; sum += e; }
        sum = wave_sum(sum);
        __builtin_amdgcn_s_waitcnt(0); __builtin_amdgcn_wave_barrier();
        float o = 0.f;
        const bf16* vb = mixer == 0 ? F.P + (size_t)b * LP * DINP + OFF_VA + 64 * h + lane : F.QKVB + (size_t)b * LP * NMLA + 768 + 128 * h + 64 + lane;
        const size_t vp = mixer == 0 ? DINP : NMLA;
        if (mixer == 0) {
            const u64* bm = F.BM + ((size_t)b * SEQ + tq) * NW64;
            for (int i = 0; i < nt; ++i) {
                const u64 wl = bm[i];
                unsigned wlo = __builtin_amdgcn_readfirstlane((unsigned)wl), whi = __builtin_amdgcn_readfirstlane((unsigned)(wl >> 32));
                while (wlo) { const int j = __builtin_ctz(wlo); wlo &= wlo - 1u; const int s = 64 * i + j; o += sc[s] * bf2f(vb[(size_t)s * vp]); }
                while (whi) { const int j = __builtin_ctz(whi); whi &= whi - 1u; const int s = 64 * i + 32 + j; o += sc[s] * bf2f(vb[(size_t)s * vp]); }
            }
        } else {
            for (int s = 0; s < 64 * nt; s += 8) {
#pragma unroll
                for (int j = 0; j < 8; ++j) o += sc[s + j] * bf2f(vb[(size_t)(s + j) * vp]);
            }
        }
        o /= sum;
        const float g = bf2f(F.P[qrow * DINP + (mixer == 0 ? OFF_GA : OFF_GB) + 64 * h + lane]);
        const float sg = g / (1.f + __expf(-g));
        F.MIX[((size_t)b * SEQ + tq) * DM + mixer * 512 + 64 * h + lane] = (bf16)f2bf(o * sg);
        __builtin_amdgcn_s_waitcnt(0); __builtin_amdgcn_wave_barrier();
    }
}

__device__ __forceinline__ void ph_final(const Frame& F) {
    const int gw = F.bid * 8 + F.wave, NGW = F.G * 8, lane = F.lane;
    for (int m = gw; m < MQ; m += NGW) {
        const f32x4* xr = (const f32x4*)(F.x + (size_t)m * DM) + lane; const f32x4* zr = (const f32x4*)(F.Z + (size_t)m * DM) + lane;
        f32x4 v[4]; float s = 0.f;
#pragma unroll
        for (int j = 0; j < 4; ++j) { v[j] = xr[64 * j]; s += (v[j].x + v[j].y) + (v[j].z + v[j].w); }
        const float mean = wave_sum(s) * (1.f / DM); float s2 = 0.f;
#pragma unroll
        for (int j = 0; j < 4; ++j) { v[j] = v[j] - mean; s2 += (v[j].x * v[j].x + v[j].y * v[j].y) + (v[j].z * v[j].z + v[j].w * v[j].w); }
        const float rstd = 1.f / sqrtf(wave_sum(s2) * (1.f / DM) + LN_EPS);
        float t = 0.f;
#pragma unroll
        for (int j = 0; j < 4; ++j) {
            const f32x4 g = ((const f32x4*)F.lne_g)[lane + 64 * j], bb = ((const f32x4*)F.lne_b)[lane + 64 * j];
            v[j] = (v[j] * rstd * g + bb) * ALPHA + zr[64 * j];
            t += (v[j].x + v[j].y) + (v[j].z + v[j].w);
        }
        const float mean2 = wave_sum(t) * (1.f / DM); float t2 = 0.f;
#pragma unroll
        for (int j = 0; j < 4; ++j) { v[j] = v[j] - mean2; t2 += (v[j].x * v[j].x + v[j].y * v[j].y) + (v[j].z * v[j].z + v[j].w * v[j].w); }
        const float rstd2 = 1.f / sqrtf(wave_sum(t2) * (1.f / DM) + LN_EPS);
        f32x4* o = (f32x4*)(F.out + (size_t)m * DM) + lane;
#pragma unroll
        for (int j = 0; j < 4; ++j) {
            const f32x4 g = ((const f32x4*)F.lnp_g)[lane + 64 * j], bb = ((const f32x4*)F.lnp_b)[lane + 64 * j];
            o[64 * j] = v[j] * rstd2 * g + bb;
        }
    }
}

constexpr int LDS_BYTES = 155648;
__global__ void __launch_bounds__(512, 2) fwd(Args args) {
    extern __shared__ __attribute__((aligned(16))) unsigned char lds[];
    Frame F;
    F.tid = threadIdx.x; F.lane = F.tid & 63; F.wave = __builtin_amdgcn_readfirstlane(F.tid >> 6); F.G = gridDim.x; F.bid = blockIdx.x;
    F.x = args.in[0]; F.meta = args.in[1]; F.lne_g = args.in[2]; F.lne_b = args.in[3]; F.w_in = args.in[4]; F.w_uq = args.in[5]; F.qn_g = args.in[6];
    F.w_ukv = args.in[7]; F.kvn_g = args.in[8]; F.rel_bias = args.in[9]; F.w_out = args.in[10]; F.lnp_g = args.in[11]; F.lnp_b = args.in[12];
    F.out = args.out;
    unsigned char* ws = args.ws;
    F.Win_t = (bf16*)(ws + WS_WIN); F.Wmla_t = (bf16*)(ws + WS_WMLA); F.Wout_t = (bf16*)(ws + WS_WOUT); F.KPER = (bf16*)(ws + WS_KPER);
    F.BM = (u64*)(ws + WS_BM); F.CQKVN = (bf16*)(ws + WS_CQKVN); F.XN = (bf16*)(ws + WS_XN); F.MIX = (bf16*)(ws + WS_XN);
    F.QKVB = (bf16*)(ws + WS_QKVB); F.P = (bf16*)(ws + WS_P); F.Z = (float*)(ws + WS_P);
    const int lo = args.ph_lo, hi = args.ph_hi;
#define IN(k) (lo <= (k) && (k) < hi)
    if (IN(0)) ph_prologue(F, (float*)lds);
    if (IN(1)) ph_gemm_naive(F, F.XN, DM, F.Win_t, DM, MROWS, DINP, DM, F.P, nullptr, DINP);
    if (IN(2)) ph_rms(F, args.inv_freq);
    if (IN(3)) { ph_gemm_naive(F, F.CQKVN, KMLA, F.Wmla_t, KMLA, MROWS, NMLA, KMLA, F.QKVB, nullptr, NMLA); ph_index_naive(F, lds); }
    if (IN(4)) ph_attn_naive(F, lds, args.inv_freq);
    if (IN(5)) ph_gemm_naive(F, F.MIX, DM, F.Wout_t, DM, MQ, DM, DM, nullptr, F.Z, DM);
    if (IN(6)) ph_final(F);
#undef IN
}

extern "C" void kernel_launch(void* const* d_in, const int* in_sizes, int n_in, void* d_out, int out_size, void* d_ws, size_t ws_size, hipStream_t stream) {
    static int ready = 0;
    if (!ready) {
        if (n_in != 13 || out_size != MQ * DM || ws_size < WS_END) { fprintf(stderr, "kernel_launch: unexpected shapes (n_in %d out %d ws %zu)\n", n_in, out_size, ws_size); ready = -1; return; }
        if (hipFuncSetAttribute((const void*)fwd, hipFuncAttributeMaxDynamicSharedMemorySize, LDS_BYTES) != hipSuccess) { fprintf(stderr, "kernel_launch: hipFuncSetAttribute failed\n"); ready = -1; return; }
        ready = 1;
    }
    if (ready < 0) return;
    Args a{};
    for (int i = 0; i < 13; ++i) a.in[i] = (const float*)d_in[i];
    a.out = (float*)d_out; a.ws = (unsigned char*)d_ws;
    for (int i = 0; i < 16; ++i) a.inv_freq[i] = (float)pow(10000.0, -(double)(2 * i) / 32.0);
    for (int ph = 0; ph < 7; ++ph) {
        a.ph_lo = ph; a.ph_hi = ph + 1;
        hipLaunchKernelGGL(fwd, dim3(256), dim3(512), LDS_BYTES, stream, a);
    }
}
```

```cpp
#include <hip/hip_runtime.h>
#include <hip/hip_cooperative_groups.h>
#include <cstdio>
#include <cstdint>
#include <cmath>

constexpr int BATCH = 4, SEQ = 4096, DM = 1024, NMETA = 16;
constexpr int LTOK = NMETA + SEQ;
constexpr int LP = 4160;
constexpr int MROWS = BATCH * LP;
constexpr int MQ = BATCH * SEQ;
constexpr int DIN = 3560, DINP = 3584;
constexpr int OFF_QA = 0, OFF_KA = 512, OFF_VA = 1024, OFF_GA = 1536, OFF_QI = 2048, OFF_KI = 2560, OFF_WI = 2624,
              OFF_CQ = 2632, OFF_CKV = 2888, OFF_KPE = 3016, OFF_GB = 3048;
constexpr int KMLA = 384, NMLA = 1792;
constexpr int TOPK = 256, KSEL = TOPK - NMETA;
constexpr int NW64 = LP / 64;
constexpr float LN_EPS = 1e-5f, RMS_EPS = 1e-6f;
constexpr float ALPHA = 1.189207115002721f;

constexpr size_t MiB = 1u << 20;
constexpr size_t WS_CTL = 0;
constexpr size_t WS_WIN = 2 * MiB;
constexpr size_t WS_WMLA = 9 * MiB;
constexpr size_t WS_WOUT = 11 * MiB;
constexpr size_t WS_KPER = 13 * MiB;
constexpr size_t WS_BM = 15 * MiB;
constexpr size_t WS_CQKVN = 24 * MiB;
constexpr size_t WS_XN = 37 * MiB;
constexpr size_t WS_QKVB = 70 * MiB;
constexpr size_t WS_P = 127 * MiB;
constexpr size_t WS_END = 241 * MiB;

typedef unsigned short bf16;
typedef unsigned long long u64;
typedef unsigned v4u __attribute__((ext_vector_type(4)));
typedef float f32x4 __attribute__((ext_vector_type(4)));

__device__ __forceinline__ float bf2f(bf16 v) { return __uint_as_float((unsigned)v << 16); }
__device__ __forceinline__ unsigned f2bf(float f) { unsigned u = __float_as_uint(f); return (u + 0x7fffu + ((u >> 16) & 1u)) >> 16; }
__device__ __forceinline__ unsigned pk2(float lo, float hi) { return f2bf(lo) | (f2bf(hi) << 16); }
__device__ __forceinline__ float wave_sum(float v) {
#pragma unroll
    for (int o = 1; o < 64; o <<= 1) v += __shfl_xor(v, o);
    return v;
}
__device__ __forceinline__ float wave_max(float v) {
#pragma unroll
    for (int o = 1; o < 64; o <<= 1) v = fmaxf(v, __shfl_xor(v, o));
    return v;
}
__device__ __forceinline__ int wave_isum(int v) {
#pragma unroll
    for (int o = 1; o < 64; o <<= 1) v += __shfl_xor(v, o);
    return v;
}
__device__ __forceinline__ int t5_bucket(int d) {
    if (d < 16) return d < 0 ? 0 : d;
    return 16 + (d >= 19) + (d >= 21) + (d >= 24) + (d >= 27) + (d >= 31) + (d >= 35) + (d >= 40) + (d >= 46) + (d >= 52) + (d >= 59) + (d >= 67) + (d >= 77) + (d >= 87) + (d >= 99) + (d >= 113);
}
__device__ __forceinline__ unsigned fkey(float f) { unsigned u = __float_as_uint(f); return (u & 0x80000000u) ? ~u : (u | 0x80000000u); }

struct Args {
    const float* in[13];
    float* out;
    unsigned char* ws;
    float inv_freq[16];
    int ph_lo, ph_hi;
};

struct Frame {
    int tid, lane, wave, G, bid;
    const float *x, *meta, *lne_g, *lne_b, *w_in, *w_uq, *qn_g, *w_ukv, *kvn_g, *rel_bias, *w_out, *lnp_g, *lnp_b;
    float* out;
    bf16 *Win_t, *Wmla_t, *Wout_t, *KPER, *CQKVN, *XN, *MIX, *QKVB, *P;
    u64* BM;
    float* Z;
};

template <class F> __device__ __forceinline__ void transpose_tile(F src, bf16* dst, int ldk, int n0, int k0, float* scr, int tid) {
    const int ty = tid >> 6, tx = tid & 63;
#pragma unroll
    for (int i = 0; i < 8; ++i) { const int k = ty + 8 * i; scr[k * 65 + tx] = src(k0 + k, n0 + tx); }
    __syncthreads();
    const int nn = tid >> 3, kc = tid & 7;
    v4u o; o.x = pk2(scr[(8 * kc + 0) * 65 + nn], scr[(8 * kc + 1) * 65 + nn]); o.y = pk2(scr[(8 * kc + 2) * 65 + nn], scr[(8 * kc + 3) * 65 + nn]);
    o.z = pk2(scr[(8 * kc + 4) * 65 + nn], scr[(8 * kc + 5) * 65 + nn]); o.w = pk2(scr[(8 * kc + 6) * 65 + nn], scr[(8 * kc + 7) * 65 + nn]);
    *(v4u*)(dst + (size_t)(n0 + nn) * ldk + k0 + 8 * kc) = o;
    __syncthreads();
}
__device__ __forceinline__ void ph_prologue(const Frame& F, float* lds) {
    constexpr int I_IN = (DINP / 64) * (DM / 64), I_MLA = (NMLA / 64) * (KMLA / 64), I_OUT = (DM / 64) * (DM / 64);
    for (int it = F.bid; it < I_IN + I_MLA + I_OUT; it += F.G) {
        if (it < I_IN) {
            const int n0 = (it / (DM / 64)) * 64, k0 = (it % (DM / 64)) * 64; const float* w = F.w_in;
            transpose_tile([=](int k, int n) { return n < DIN ? w[(size_t)k * DIN + n] : 0.f; }, F.Win_t, DM, n0, k0, lds, F.tid);
        } else if (it < I_IN + I_MLA) {
            const int r = it - I_IN, n0 = (r / (KMLA / 64)) * 64, k0 = (r % (KMLA / 64)) * 64;
            const float *wq = F.w_uq, *wkv = F.w_ukv, *gq = F.qn_g, *gkv = F.kvn_g;
            transpose_tile([=](int k, int n) {
                if (n < 768) return k < 256 ? wq[(size_t)k * 768 + n] * gq[k] : 0.f;
                return k >= 256 ? wkv[(size_t)(k - 256) * 1024 + (n - 768)] * gkv[k - 256] : 0.f; }, F.Wmla_t, KMLA, n0, k0, lds, F.tid);
        } else {
            const int r = it - I_IN - I_MLA, n0 = (r / (DM / 64)) * 64, k0 = (r % (DM / 64)) * 64; const float* w = F.w_out;
            transpose_tile([=](int k, int n) { return w[(size_t)k * DM + n]; }, F.Wout_t, DM, n0, k0, lds, F.tid);
        }
    }
    const int gw = F.bid * 8 + F.wave, NGW = F.G * 8;
    for (int m = gw; m < MROWS; m += NGW) {
        const int b = m / LP, p = m % LP;
        unsigned long long* o8 = (unsigned long long*)(F.XN + (size_t)m * DM) + F.lane;
        if (p >= LTOK) {
#pragma unroll
            for (int j = 0; j < 4; ++j) o8[64 * j] = 0ull;
            continue;
        }
        const float* src = p < NMETA ? F.meta + (size_t)p * DM : F.x + ((size_t)b * SEQ + (p - NMETA)) * DM;
        const f32x4* xr = (const f32x4*)src + F.lane;
        f32x4 v[4]; float s = 0.f;
#pragma unroll
        for (int j = 0; j < 4; ++j) { v[j] = xr[64 * j]; s += (v[j].x + v[j].y) + (v[j].z + v[j].w); }
        const float mean = wave_sum(s) * (1.f / DM); float s2 = 0.f;
#pragma unroll
        for (int j = 0; j < 4; ++j) { v[j] = v[j] - mean; s2 += (v[j].x * v[j].x + v[j].y * v[j].y) + (v[j].z * v[j].z + v[j].w * v[j].w); }
        const float rstd = 1.f / sqrtf(wave_sum(s2) * (1.f / DM) + LN_EPS);
#pragma unroll
        for (int j = 0; j < 4; ++j) {
            const f32x4 g = ((const f32x4*)F.lne_g)[F.lane + 64 * j], bb = ((const f32x4*)F.lne_b)[F.lane + 64 * j];
            const f32x4 y = v[j] * rstd * g + bb;
            o8[64 * j] = (unsigned long long)pk2(y.x, y.y) | ((unsigned long long)pk2(y.z, y.w) << 32);
        }
    }
}

__device__ __forceinline__ void ph_gemm_naive(const Frame& F, const bf16* A, int lda, const bf16* Bt, int ldb, int M, int N, int K, bf16* Cb, float* Cf, int ldc) {
    const int tn = F.tid & 63, tm = F.tid >> 6;
    const int ntn = N / 64, ntm = M / 8; const long nt = (long)ntn * ntm;
    for (long t = F.bid; t < nt; t += F.G) {
        const int m = (int)(t / ntn) * 8 + tm, n = (int)(t % ntn) * 64 + tn;
        const v4u* a = (const v4u*)(A + (size_t)m * lda); const v4u* b = (const v4u*)(Bt + (size_t)n * ldb);
        float acc = 0.f;
        for (int k = 0; k < K / 8; ++k) {
            const v4u av = a[k], bv = b[k];
#pragma unroll
            for (int j = 0; j < 4; ++j) { acc += __uint_as_float(av[j] << 16) * __uint_as_float(bv[j] << 16); acc += __uint_as_float(av[j] & 0xffff0000u) * __uint_as_float(bv[j] & 0xffff0000u); }
        }
        if (Cb) Cb[(size_t)m * ldc + n] = (bf16)f2bf(acc); else Cf[(size_t)m * ldc + n] = acc;
    }
}

__device__ __forceinline__ void ph_rms(const Frame& F, const float* inv_freq) {
    const int gw = F.bid * 8 + F.wave, NGW = F.G * 8, lane = F.lane;
    for (int m = gw; m < MROWS; m += NGW) {
        const bf16* pr = F.P + (size_t)m * DINP; const int p = m % LP;
        const unsigned long long cq4 = *(const unsigned long long*)(pr + OFF_CQ + 4 * lane);
        const unsigned ckv2 = *(const unsigned*)(pr + OFF_CKV + 2 * lane);
        float c[4] = {bf2f((bf16)(cq4 & 0xffff)), bf2f((bf16)((cq4 >> 16) & 0xffff)), bf2f((bf16)((cq4 >> 32) & 0xffff)), bf2f((bf16)(cq4 >> 48))};
        float d[2] = {bf2f((bf16)(ckv2 & 0xffff)), bf2f((bf16)(ckv2 >> 16))};
        const float sq = wave_sum(c[0] * c[0] + c[1] * c[1] + c[2] * c[2] + c[3] * c[3]), skv = wave_sum(d[0] * d[0] + d[1] * d[1]);
        const float rq = 1.f / sqrtf(sq * (1.f / 256.f) + RMS_EPS), rkv = 1.f / sqrtf(skv * (1.f / 128.f) + RMS_EPS);
        bf16* o = F.CQKVN + (size_t)m * KMLA;
        *(unsigned long long*)(o + 4 * lane) = (unsigned long long)pk2(c[0] * rq, c[1] * rq) | ((unsigned long long)pk2(c[2] * rq, c[3] * rq) << 32);
        *(unsigned*)(o + 256 + 2 * lane) = pk2(d[0] * rkv, d[1] * rkv);
        if (lane < 16) {
            const float x1 = bf2f(pr[OFF_KPE + lane]), x2 = bf2f(pr[OFF_KPE + 16 + lane]);
            const float ang = (float)p * inv_freq[lane]; const float cs = cosf(ang), sn = sinf(ang);
            F.KPER[(size_t)m * 32 + lane] = (bf16)f2bf(x1 * cs - x2 * sn); F.KPER[(size_t)m * 32 + 16 + lane] = (bf16)f2bf(x2 * cs + x1 * sn);
        }
    }
}

__device__ __forceinline__ void ph_index_naive(const Frame& F, unsigned char* lds) {
    unsigned* ks = (unsigned*)(lds) + F.wave * (LP + 512); float* qs = (float*)(ks + LP);
    const int gw = F.bid * 8 + F.wave, NGW = F.G * 8, lane = F.lane;
    for (int qi = gw; qi < MQ; qi += NGW) {
        const int b = qi / SEQ, tq = qi % SEQ, p = NMETA + tq; const size_t qrow = (size_t)b * LP + p;
        const bf16* pr = F.P + qrow * DINP;
        for (int i = lane; i < 512; i += 64) qs[i] = bf2f(pr[OFF_QI + i]);
        float ch[8];
#pragma unroll
        for (int h = 0; h < 8; ++h) ch[h] = bf2f(pr[OFF_WI + h]) * 0.35355339059327373f;
        __builtin_amdgcn_s_waitcnt(0); __builtin_amdgcn_wave_barrier();
        const int nt = p / 64 + 1;
        for (int i = 0; i < NW64; ++i) {
            const int s = 64 * i + lane; unsigned key = 0u;
            if (i < nt && s >= NMETA && s <= p) {
                const v4u* kr = (const v4u*)(F.P + ((size_t)b * LP + s) * DINP + OFF_KI);
                float kf[64];
#pragma unroll
                for (int c = 0; c < 8; ++c) { const v4u v = kr[c];
#pragma unroll
                    for (int j = 0; j < 4; ++j) { kf[8 * c + 2 * j] = __uint_as_float(v[j] << 16); kf[8 * c + 2 * j + 1] = __uint_as_float(v[j] & 0xffff0000u); } }
                float sc = 0.f;
#pragma unroll
                for (int h = 0; h < 8; ++h) { float a = 0.f;
#pragma unroll
                    for (int d = 0; d < 64; ++d) a += qs[64 * h + d] * kf[d];
                    sc += fmaxf(a * 0.125f, 0.f) * ch[h]; }
                key = fkey(sc);
            }
            ks[s] = key;
        }
        __builtin_amdgcn_s_waitcnt(0); __builtin_amdgcn_wave_barrier();
        unsigned thr = 0u;
        for (int bit = 31; bit >= 0; --bit) {
            const unsigned cand = thr | (1u << bit); int c = 0;
            for (int i = 0; i < nt; ++i) c += (ks[64 * i + lane] >= cand) ? 1 : 0;
            c = wave_isum(c);
            if (c >= KSEL) thr = cand;
        }
        int sstar = LP;
        if (thr != 0u) {
            int cge = 0, cgt = 0;
            for (int i = 0; i < nt; ++i) { const unsigned k = ks[64 * i + lane]; cge += (k >= thr); cgt += (k > thr); }
            cge = wave_isum(cge); cgt = wave_isum(cgt);
            if (cge > KSEL) {
                const int need = KSEL - cgt; int lo = 0, hi = LP - 1;
                while (lo < hi) { const int mid = (lo + hi) >> 1; int c = 0;
                    for (int i = 0; i < nt; ++i) { const int s = 64 * i + lane; c += (ks[s] == thr && s <= mid); }
                    c = wave_isum(c); if (c >= need) hi = mid; else lo = mid + 1; }
                sstar = lo;
            }
        }
        const unsigned te = thr == 0u ? 1u : thr;
        u64* bm = F.BM + (size_t)qi * NW64;
        for (int i = 0; i < NW64; ++i) {
            const int s = 64 * i + lane; const unsigned k = ks[s];
            const bool sel = (s < NMETA) || (k >= te && (k > thr || s <= sstar));
            const u64 w = __ballot(sel);
            if (lane == 0) bm[i] = w;
        }
        __builtin_amdgcn_s_waitcnt(0); __builtin_amdgcn_wave_barrier();
    }
}

__device__ __forceinline__ void ph_attn_naive(const Frame& F, unsigned char* lds, const float* inv_freq) {
    float* sc = (float*)(lds) + F.wave * (LP + 96); float* qs = sc + LP;
    const int gw = F.bid * 8 + F.wave, NGW = F.G * 8, lane = F.lane;
    const int NTASK = 2 * BATCH * 8 * SEQ;
    for (int task = gw; task < NTASK; task += NGW) {
        const int tq = task % SEQ, h = (task / SEQ) % 8, b = (task / (SEQ * 8)) % BATCH, mixer = task / (SEQ * 8 * BATCH);
        const int p = NMETA + tq; const size_t qrow = (size_t)b * LP + p; const int nt = p / 64 + 1;
        float mx = -INFINITY;
        if (mixer == 0) {
            qs[lane] = bf2f(F.P[qrow * DINP + OFF_QA + 64 * h + lane]);
            __builtin_amdgcn_s_waitcnt(0); __builtin_amdgcn_wave_barrier();
            const u64* bm = F.BM + ((size_t)b * SEQ + tq) * NW64;
            for (int i = 0; i < nt; ++i) {
                const int s = 64 * i + lane; const u64 w = bm[i]; float v = -INFINITY;
                if ((w >> lane) & 1ull) {
                    const v4u* kr = (const v4u*)(F.P + ((size_t)b * LP + s) * DINP + OFF_KA + 64 * h); float a = 0.f;
#pragma unroll
                    for (int c = 0; c < 8; ++c) { const v4u kv = kr[c];
#pragma unroll
                        for (int j = 0; j < 4; ++j) { a += qs[8 * c + 2 * j] * __uint_as_float(kv[j] << 16); a += qs[8 * c + 2 * j + 1] * __uint_as_float(kv[j] & 0xffff0000u); } }
                    v = a * 0.125f + F.rel_bias[t5_bucket(p - s) * 8 + h];
                }
                sc[s] = v; mx = fmaxf(mx, v);
            }
        } else {
            for (int i = lane; i < 96; i += 64) qs[i] = bf2f(F.QKVB[qrow * NMLA + 96 * h + i]);
            __builtin_amdgcn_s_waitcnt(0); __builtin_amdgcn_wave_barrier();
            if (lane < 16) { const float x1 = qs[64 + lane], x2 = qs[80 + lane]; const float ang = (float)p * inv_freq[lane]; const float cs = cosf(ang), sn = sinf(ang);
                qs[64 + lane] = x1 * cs - x2 * sn; qs[80 + lane] = x2 * cs + x1 * sn; }
            __builtin_amdgcn_s_waitcnt(0); __builtin_amdgcn_wave_barrier();
            for (int i = 0; i < nt; ++i) {
                const int s = 64 * i + lane; float v = -INFINITY;
                if (s <= p) {
                    const size_t srow = (size_t)b * LP + s;
                    const v4u* kr = (const v4u*)(F.QKVB + srow * NMLA + 768 + 128 * h); const v4u* pe = (const v4u*)(F.KPER + srow * 32); float a = 0.f;
#pragma unroll
                    for (int c = 0; c < 12; ++c) { const v4u kv = c < 8 ? kr[c] : pe[c - 8];
#pragma unroll
                        for (int j = 0; j < 4; ++j) { a += qs[8 * c + 2 * j] * __uint_as_float(kv[j] << 16); a += qs[8 * c + 2 * j + 1] * __uint_as_float(kv[j] & 0xffff0000u); } }
                    v = a * 0.10206207261596577f;
                }
                sc[s] = v; mx = fmaxf(mx, v);
            }
        }
        mx = wave_max(mx);
        float sum = 0.f;
        for (int i = 0; i < nt; ++i) { const int s = 64 * i + lane; const float e = __expf(sc[s] - mx); sc[s] = e; sum += e; }
        sum = wave_sum(sum);
        __builtin_amdgcn_s_waitcnt(0); __builtin_amdgcn_wave_barrier();
        float o = 0.f;
        const bf16* vb = mixer == 0 ? F.P + (size_t)b * LP * DINP + OFF_VA + 64 * h + lane : F.QKVB + (size_t)b * LP * NMLA + 768 + 128 * h + 64 + lane;
        const size_t vp = mixer == 0 ? DINP : NMLA;
        if (mixer == 0) {
            const u64* bm = F.BM + ((size_t)b * SEQ + tq) * NW64;
            for (int i = 0; i < nt; ++i) {
                const u64 wl = bm[i];
                unsigned wlo = __builtin_amdgcn_readfirstlane((unsigned)wl), whi = __builtin_amdgcn_readfirstlane((unsigned)(wl >> 32));
                while (wlo) { const int j = __builtin_ctz(wlo); wlo &= wlo - 1u; const int s = 64 * i + j; o += sc[s] * bf2f(vb[(size_t)s * vp]); }
                while (whi) { const int j = __builtin_ctz(whi); whi &= whi - 1u; const int s = 64 * i + 32 + j; o += sc[s] * bf2f(vb[(size_t)s * vp]); }
            }
        } else {
            for (int s = 0; s < 64 * nt; s += 8) {
#pragma unroll
                for (int j = 0; j < 8; ++j) o += sc[s + j] * bf2f(vb[(size_t)(s + j) * vp]);
            }
        }
        o /= sum;
        const float g = bf2f(F.P[qrow * DINP + (mixer == 0 ? OFF_GA : OFF_GB) + 64 * h + lane]);
        const float sg = g / (1.f + __expf(-g));
        F.MIX[((size_t)b * SEQ + tq) * DM + mixer * 512 + 64 * h + lane] = (bf16)f2bf(o * sg);
        __builtin_amdgcn_s_waitcnt(0); __builtin_amdgcn_wave_barrier();
    }
}

__device__ __forceinline__ void ph_final(const Frame& F) {
    const int gw = F.bid * 8 + F.wave, NGW = F.G * 8, lane = F.lane;
    for (int m = gw; m < MQ; m += NGW) {
        const f32x4* xr = (const f32x4*)(F.x + (size_t)m * DM) + lane; const f32x4* zr = (const f32x4*)(F.Z + (size_t)m * DM) + lane;
        f32x4 v[4]; float s = 0.f;
#pragma unroll
        for (int j = 0; j < 4; ++j) { v[j] = xr[64 * j]; s += (v[j].x + v[j].y) + (v[j].z + v[j].w); }
        const float mean = wave_sum(s) * (1.f / DM); float s2 = 0.f;
#pragma unroll
        for (int j = 0; j < 4; ++j) { v[j] = v[j] - mean; s2 += (v[j].x * v[j].x + v[j].y * v[j].y) + (v[j].z * v[j].z + v[j].w * v[j].w); }
        const float rstd = 1.f / sqrtf(wave_sum(s2) * (1.f / DM) + LN_EPS);
        float t = 0.f;
#pragma unroll
        for (int j = 0; j < 4; ++j) {
            const f32x4 g = ((const f32x4*)F.lne_g)[lane + 64 * j], bb = ((const f32x4*)F.lne_b)[lane + 64 * j];
            v[j] = (v[j] * rstd * g + bb) * ALPHA + zr[64 * j];
            t += (v[j].x + v[j].y) + (v[j].z + v[j].w);
        }
        const float mean2 = wave_sum(t) * (1.f / DM); float t2 = 0.f;
#pragma unroll
        for (int j = 0; j < 4; ++j) { v[j] = v[j] - mean2; t2 += (v[j].x * v[j].x + v[j].y * v[j].y) + (v[j].z * v[j].z + v[j].w * v[j].w); }
        const float rstd2 = 1.f / sqrtf(wave_sum(t2) * (1.f / DM) + LN_EPS);
        f32x4* o = (f32x4*)(F.out + (size_t)m * DM) + lane;
#pragma unroll
        for (int j = 0; j < 4; ++j) {
            const f32x4 g = ((const f32x4*)F.lnp_g)[lane + 64 * j], bb = ((const f32x4*)F.lnp_b)[lane + 64 * j];
            o[64 * j] = v[j] * rstd2 * g + bb;
        }
    }
}

constexpr int LDS_BYTES = 155648;
__global__ void __launch_bounds__(512, 2) fwd(Args args) {
    extern __shared__ __attribute__((aligned(16))) unsigned char lds[];
    Frame F;
    F.tid = threadIdx.x; F.lane = F.tid & 63; F.wave = __builtin_amdgcn_readfirstlane(F.tid >> 6); F.G = gridDim.x; F.bid = blockIdx.x;
    F.x = args.in[0]; F.meta = args.in[1]; F.lne_g = args.in[2]; F.lne_b = args.in[3]; F.w_in = args.in[4]; F.w_uq = args.in[5]; F.qn_g = args.in[6];
    F.w_ukv = args.in[7]; F.kvn_g = args.in[8]; F.rel_bias = args.in[9]; F.w_out = args.in[10]; F.lnp_g = args.in[11]; F.lnp_b = args.in[12];
    F.out = args.out;
    unsigned char* ws = args.ws;
    F.Win_t = (bf16*)(ws + WS_WIN); F.Wmla_t = (bf16*)(ws + WS_WMLA); F.Wout_t = (bf16*)(ws + WS_WOUT); F.KPER = (bf16*)(ws + WS_KPER);
    F.BM = (u64*)(ws + WS_BM); F.CQKVN = (bf16*)(ws + WS_CQKVN); F.XN = (bf16*)(ws + WS_XN); F.MIX = (bf16*)(ws + WS_XN);
    F.QKVB = (bf16*)(ws + WS_QKVB); F.P = (bf16*)(ws + WS_P); F.Z = (float*)(ws + WS_P);
    const int lo = args.ph_lo, hi = args.ph_hi;
    cooperative_groups::grid_group grid = cooperative_groups::this_grid();
#define IN(k) (lo <= (k) && (k) < hi)
#define SEAM(k) do { if (IN(k) && IN((k) + 1)) grid.sync(); } while (0)
    if (IN(0)) ph_prologue(F, (float*)lds);
    SEAM(0);
    if (IN(1)) ph_gemm_naive(F, F.XN, DM, F.Win_t, DM, MROWS, DINP, DM, F.P, nullptr, DINP);
    SEAM(1);
    if (IN(2)) ph_rms(F, args.inv_freq);
    SEAM(2);
    if (IN(3)) { ph_gemm_naive(F, F.CQKVN, KMLA, F.Wmla_t, KMLA, MROWS, NMLA, KMLA, F.QKVB, nullptr, NMLA); ph_index_naive(F, lds); }
    SEAM(3);
    if (IN(4)) ph_attn_naive(F, lds, args.inv_freq);
    SEAM(4);
    if (IN(5)) ph_gemm_naive(F, F.MIX, DM, F.Wout_t, DM, MQ, DM, DM, nullptr, F.Z, DM);
    SEAM(5);
    if (IN(6)) ph_final(F);
#undef IN
#undef SEAM
}

#ifndef MK_N_LAUNCHES
#define MK_N_LAUNCHES 1
#endif
extern "C" void kernel_launch(void* const* d_in, const int* in_sizes, int n_in, void* d_out, int out_size, void* d_ws, size_t ws_size, hipStream_t stream) {
    static int grid_blocks = 0;
    if (!grid_blocks) {
        if (n_in != 13 || out_size != MQ * DM || ws_size < WS_END) { fprintf(stderr, "kernel_launch: unexpected shapes (n_in %d out %d ws %zu)\n", n_in, out_size, ws_size); grid_blocks = -1; return; }
        if (hipFuncSetAttribute((const void*)fwd, hipFuncAttributeMaxDynamicSharedMemorySize, LDS_BYTES) != hipSuccess) { fprintf(stderr, "kernel_launch: hipFuncSetAttribute failed\n"); grid_blocks = -1; return; }
        int dev = 0, cus = 0, per_cu = 0;
        hipGetDevice(&dev);
        hipDeviceGetAttribute(&cus, hipDeviceAttributeMultiprocessorCount, dev);
        hipOccupancyMaxActiveBlocksPerMultiprocessor(&per_cu, (const void*)fwd, 512, LDS_BYTES);
        if (per_cu < 1 || cus < 1) { fprintf(stderr, "kernel_launch: occupancy query says %d blocks/CU on %d CUs\n", per_cu, cus); grid_blocks = -1; return; }
        grid_blocks = cus;
    }
    if (grid_blocks < 0) return;
    Args a{};
    for (int i = 0; i < 13; ++i) a.in[i] = (const float*)d_in[i];
    a.out = (float*)d_out; a.ws = (unsigned char*)d_ws;
    for (int i = 0; i < 16; ++i) a.inv_freq[i] = (float)pow(10000.0, -(double)(2 * i) / 32.0);
    if (MK_N_LAUNCHES == 1) {
        a.ph_lo = 0; a.ph_hi = 7;
        void* kargs[] = {&a};
        hipError_t e = hipLaunchCooperativeKernel((const void*)fwd, dim3(grid_blocks), dim3(512), kargs, LDS_BYTES, stream);
        if (e != hipSuccess) fprintf(stderr, "kernel_launch: cooperative launch failed: %s (grid %d)\n", hipGetErrorString(e), grid_blocks);
    } else {
        for (int ph = 0; ph < 7; ++ph) {
            a.ph_lo = ph; a.ph_hi = ph + 1;
            hipLaunchKernelGGL(fwd, dim3(grid_blocks), dim3(512), LDS_BYTES, stream, a);
        }
    }
}
```

```cpp
#include <hip/hip_runtime.h>
#include <hip/hip_cooperative_groups.h>
#include <cstdio>
#include <cstdint>
#include <cmath>

constexpr int BATCH = 4, SEQ = 4096, DM = 1024, NMETA = 16;
constexpr int LTOK = NMETA + SEQ;
constexpr int LP = 4160;
constexpr int MROWS = BATCH * LP;
constexpr int MQ = BATCH * SEQ;
constexpr int DIN = 3560, DINP = 3584;
constexpr int OFF_QA = 0, OFF_KA = 512, OFF_VA = 1024, OFF_GA = 1536, OFF_QI = 2048, OFF_KI = 2560, OFF_WI = 2624,
              OFF_CQ = 2632, OFF_CKV = 2888, OFF_KPE = 3016, OFF_GB = 3048;
constexpr int KMLA = 384, NMLA = 1792;
constexpr int TOPK = 256, KSEL = TOPK - NMETA;
constexpr int NW64 = LP / 64;
constexpr float LN_EPS = 1e-5f, RMS_EPS = 1e-6f;
constexpr float ALPHA = 1.189207115002721f;

constexpr size_t MiB = 1u << 20;
constexpr size_t WS_CTL = 0;
constexpr size_t WS_WIN = 2 * MiB;
constexpr size_t WS_WMLA = 9 * MiB;
constexpr size_t WS_WOUT = 11 * MiB;
constexpr size_t WS_KPER = 13 * MiB;
constexpr size_t WS_BM = 15 * MiB;
constexpr size_t WS_CQKVN = 24 * MiB;
constexpr size_t WS_XN = 37 * MiB;
constexpr size_t WS_QKVB = 70 * MiB;
constexpr size_t WS_P = 127 * MiB;
constexpr size_t WS_END = 241 * MiB;

typedef unsigned short bf16;
typedef unsigned long long u64;
typedef unsigned v4u __attribute__((ext_vector_type(4)));
typedef float f32x4 __attribute__((ext_vector_type(4)));

__device__ __forceinline__ float bf2f(bf16 v) { return __uint_as_float((unsigned)v << 16); }
__device__ __forceinline__ unsigned f2bf(float f) { unsigned u = __float_as_uint(f); return (u + 0x7fffu + ((u >> 16) & 1u)) >> 16; }
__device__ __forceinline__ unsigned pk2(float lo, float hi) { return f2bf(lo) | (f2bf(hi) << 16); }
__device__ __forceinline__ float wave_sum(float v) {
#pragma unroll
    for (int o = 1; o < 64; o <<= 1) v += __shfl_xor(v, o);
    return v;
}
__device__ __forceinline__ float wave_max(float v) {
#pragma unroll
    for (int o = 1; o < 64; o <<= 1) v = fmaxf(v, __shfl_xor(v, o));
    return v;
}
__device__ __forceinline__ int wave_isum(int v) {
#pragma unroll
    for (int o = 1; o < 64; o <<= 1) v += __shfl_xor(v, o);
    return v;
}
__device__ __forceinline__ int t5_bucket(int d) {
    if (d < 16) return d < 0 ? 0 : d;
    return 16 + (d >= 19) + (d >= 21) + (d >= 24) + (d >= 27) + (d >= 31) + (d >= 35) + (d >= 40) + (d >= 46) + (d >= 52) + (d >= 59) + (d >= 67) + (d >= 77) + (d >= 87) + (d >= 99) + (d >= 113);
}
__device__ __forceinline__ unsigned fkey(float f) { unsigned u = __float_as_uint(f); return (u & 0x80000000u) ? ~u : (u | 0x80000000u); }

struct Args {
    const float* in[13];
    float* out;
    unsigned char* ws;
    float inv_freq[16];
    int ph_lo, ph_hi;
};

struct Frame {
    int tid, lane, wave, G, bid;
    const float *x, *meta, *lne_g, *lne_b, *w_in, *w_uq, *qn_g, *w_ukv, *kvn_g, *rel_bias, *w_out, *lnp_g, *lnp_b;
    float* out;
    bf16 *Win_t, *Wmla_t, *Wout_t, *KPER, *CQKVN, *XN, *MIX, *QKVB, *P;
    u64* BM;
    float* Z;
};

template <class F> __device__ __forceinline__ void transpose_tile(F src, bf16* dst, int ldk, int n0, int k0, float* scr, int tid) {
    const int ty = tid >> 6, tx = tid & 63;
#pragma unroll
    for (int i = 0; i < 8; ++i) { const int k = ty + 8 * i; scr[k * 65 + tx] = src(k0 + k, n0 + tx); }
    __syncthreads();
    const int nn = tid >> 3, kc = tid & 7;
    v4u o; o.x = pk2(scr[(8 * kc + 0) * 65 + nn], scr[(8 * kc + 1) * 65 + nn]); o.y = pk2(scr[(8 * kc + 2) * 65 + nn], scr[(8 * kc + 3) * 65 + nn]);
    o.z = pk2(scr[(8 * kc + 4) * 65 + nn], scr[(8 * kc + 5) * 65 + nn]); o.w = pk2(scr[(8 * kc + 6) * 65 + nn], scr[(8 * kc + 7) * 65 + nn]);
    *(v4u*)(dst + (size_t)(n0 + nn) * ldk + k0 + 8 * kc) = o;
    __syncthreads();
}
__device__ __forceinline__ void ph_prologue(const Frame& F, float* lds) {
    constexpr int I_IN = (DINP / 64) * (DM / 64), I_MLA = (NMLA / 64) * (KMLA / 64), I_OUT = (DM / 64) * (DM / 64);
    for (int it = F.bid; it < I_IN + I_MLA + I_OUT; it += F.G) {
        if (it < I_IN) {
            const int n0 = (it / (DM / 64)) * 64, k0 = (it % (DM / 64)) * 64; const float* w = F.w_in;
            transpose_tile([=](int k, int n) { return n < DIN ? w[(size_t)k * DIN + n] : 0.f; }, F.Win_t, DM, n0, k0, lds, F.tid);
        } else if (it < I_IN + I_MLA) {
            const int r = it - I_IN, n0 = (r / (KMLA / 64)) * 64, k0 = (r % (KMLA / 64)) * 64;
            const float *wq = F.w_uq, *wkv = F.w_ukv, *gq = F.qn_g, *gkv = F.kvn_g;
            transpose_tile([=](int k, int n) {
                if (n < 768) return k < 256 ? wq[(size_t)k * 768 + n] * gq[k] : 0.f;
                return k >= 256 ? wkv[(size_t)(k - 256) * 1024 + (n - 768)] * gkv[k - 256] : 0.f; }, F.Wmla_t, KMLA, n0, k0, lds, F.tid);
        } else {
            const int r = it - I_IN - I_MLA, n0 = (r / (DM / 64)) * 64, k0 = (r % (DM / 64)) * 64; const float* w = F.w_out;
            transpose_tile([=](int k, int n) { return w[(size_t)k * DM + n]; }, F.Wout_t, DM, n0, k0, lds, F.tid);
        }
    }
    const int gw = F.bid * 8 + F.wave, NGW = F.G * 8;
    for (int m = gw; m < MROWS; m += NGW) {
        const int b = m / LP, p = m % LP;
        unsigned long long* o8 = (unsigned long long*)(F.XN + (size_t)m * DM) + F.lane;
        if (p >= LTOK) {
#pragma unroll
            for (int j = 0; j < 4; ++j) o8[64 * j] = 0ull;
            continue;
        }
        const float* src = p < NMETA ? F.meta + (size_t)p * DM : F.x + ((size_t)b * SEQ + (p - NMETA)) * DM;
        const f32x4* xr = (const f32x4*)src + F.lane;
        f32x4 v[4]; float s = 0.f;
#pragma unroll
        for (int j = 0; j < 4; ++j) { v[j] = xr[64 * j]; s += (v[j].x + v[j].y) + (v[j].z + v[j].w); }
        const float mean = wave_sum(s) * (1.f / DM); float s2 = 0.f;
#pragma unroll
        for (int j = 0; j < 4; ++j) { v[j] = v[j] - mean; s2 += (v[j].x * v[j].x + v[j].y * v[j].y) + (v[j].z * v[j].z + v[j].w * v[j].w); }
        const float rstd = 1.f / sqrtf(wave_sum(s2) * (1.f / DM) + LN_EPS);
#pragma unroll
        for (int j = 0; j < 4; ++j) {
            const f32x4 g = ((const f32x4*)F.lne_g)[F.lane + 64 * j], bb = ((const f32x4*)F.lne_b)[F.lane + 64 * j];
            const f32x4 y = v[j] * rstd * g + bb;
            o8[64 * j] = (unsigned long long)pk2(y.x, y.y) | ((unsigned long long)pk2(y.z, y.w) << 32);
        }
    }
}

__device__ __forceinline__ void ph_gemm_naive(const Frame& F, const bf16* A, int lda, const bf16* Bt, int ldb, int M, int N, int K, bf16* Cb, float* Cf, int ldc) {
    const int tn = F.tid & 63, tm = F.tid >> 6;
    const int ntn = N / 64, ntm = M / 8; const long nt = (long)ntn * ntm;
    for (long t = F.bid; t < nt; t += F.G) {
        const int m = (int)(t / ntn) * 8 + tm, n = (int)(t % ntn) * 64 + tn;
        const v4u* a = (const v4u*)(A + (size_t)m * lda); const v4u* b = (const v4u*)(Bt + (size_t)n * ldb);
        float acc = 0.f;
        for (int k = 0; k < K / 8; ++k) {
            const v4u av = a[k], bv = b[k];
#pragma unroll
            for (int j = 0; j < 4; ++j) { acc += __uint_as_float(av[j] << 16) * __uint_as_float(bv[j] << 16); acc += __uint_as_float(av[j] & 0xffff0000u) * __uint_as_float(bv[j] & 0xffff0000u); }
        }
        if (Cb) Cb[(size_t)m * ldc + n] = (bf16)f2bf(acc); else Cf[(size_t)m * ldc + n] = acc;
    }
}

__device__ __forceinline__ void ph_rms(const Frame& F, const float* inv_freq) {
    const int gw = F.bid * 8 + F.wave, NGW = F.G * 8, lane = F.lane;
    for (int m = gw; m < MROWS; m += NGW) {
        const bf16* pr = F.P + (size_t)m * DINP; const int p = m % LP;
        const unsigned long long cq4 = *(const unsigned long long*)(pr + OFF_CQ + 4 * lane);
        const unsigned ckv2 = *(const unsigned*)(pr + OFF_CKV + 2 * lane);
        float c[4] = {bf2f((bf16)(cq4 & 0xffff)), bf2f((bf16)((cq4 >> 16) & 0xffff)), bf2f((bf16)((cq4 >> 32) & 0xffff)), bf2f((bf16)(cq4 >> 48))};
        float d[2] = {bf2f((bf16)(ckv2 & 0xffff)), bf2f((bf16)(ckv2 >> 16))};
        const float sq = wave_sum(c[0] * c[0] + c[1] * c[1] + c[2] * c[2] + c[3] * c[3]), skv = wave_sum(d[0] * d[0] + d[1] * d[1]);
        const float rq = 1.f / sqrtf(sq * (1.f / 256.f) + RMS_EPS), rkv = 1.f / sqrtf(skv * (1.f / 128.f) + RMS_EPS);
        bf16* o = F.CQKVN + (size_t)m * KMLA;
        *(unsigned long long*)(o + 4 * lane) = (unsigned long long)pk2(c[0] * rq, c[1] * rq) | ((unsigned long long)pk2(c[2] * rq, c[3] * rq) << 32);
        *(unsigned*)(o + 256 + 2 * lane) = pk2(d[0] * rkv, d[1] * rkv);
        if (lane < 16) {
            const float x1 = bf2f(pr[OFF_KPE + lane]), x2 = bf2f(pr[OFF_KPE + 16 + lane]);
            const float ang = (float)p * inv_freq[lane]; const float cs = cosf(ang), sn = sinf(ang);
            F.KPER[(size_t)m * 32 + lane] = (bf16)f2bf(x1 * cs - x2 * sn); F.KPER[(size_t)m * 32 + 16 + lane] = (bf16)f2bf(x2 * cs + x1 * sn);
        }
    }
}

__device__ __forceinline__ void ph_index_naive(const Frame& F, unsigned char* lds) {
    unsigned* ks = (unsigned*)(lds) + F.wave * (LP + 512); float* qs = (float*)(ks + LP);
    const int gw = F.bid * 8 + F.wave, NGW = F.G * 8, lane = F.lane;
    for (int qi = gw; qi < MQ; qi += NGW) {
        const int b = qi / SEQ, tq = qi % SEQ, p = NMETA + tq; const size_t qrow = (size_t)b * LP + p;
        const bf16* pr = F.P + qrow * DINP;
        for (int i = lane; i < 512; i += 64) qs[i] = bf2f(pr[OFF_QI + i]);
        float ch[8];
#pragma unroll
        for (int h = 0; h < 8; ++h) ch[h] = bf2f(pr[OFF_WI + h]) * 0.35355339059327373f;
        __builtin_amdgcn_s_waitcnt(0); __builtin_amdgcn_wave_barrier();
        const int nt = p / 64 + 1;
        for (int i = 0; i < NW64; ++i) {
            const int s = 64 * i + lane; unsigned key = 0u;
            if (i < nt && s >= NMETA && s <= p) {
                const v4u* kr = (const v4u*)(F.P + ((size_t)b * LP + s) * DINP + OFF_KI);
                float kf[64];
#pragma unroll
                for (int c = 0; c < 8; ++c) { const v4u v = kr[c];
#pragma unroll
                    for (int j = 0; j < 4; ++j) { kf[8 * c + 2 * j] = __uint_as_float(v[j] << 16); kf[8 * c + 2 * j + 1] = __uint_as_float(v[j] & 0xffff0000u); } }
                float sc = 0.f;
#pragma unroll
                for (int h = 0; h < 8; ++h) { float a = 0.f;
#pragma unroll
                    for (int d = 0; d < 64; ++d) a += qs[64 * h + d] * kf[d];
                    sc += fmaxf(a * 0.125f, 0.f) * ch[h]; }
                key = fkey(sc);
            }
            ks[s] = key;
        }
        __builtin_amdgcn_s_waitcnt(0); __builtin_amdgcn_wave_barrier();
        unsigned thr = 0u;
        for (int bit = 31; bit >= 0; --bit) {
            const unsigned cand = thr | (1u << bit); int c = 0;
            for (int i = 0; i < nt; ++i) c += (ks[64 * i + lane] >= cand) ? 1 : 0;
            c = wave_isum(c);
            if (c >= KSEL) thr = cand;
        }
        int sstar = LP;
        if (thr != 0u) {
            int cge = 0, cgt = 0;
            for (int i = 0; i < nt; ++i) { const unsigned k = ks[64 * i + lane]; cge += (k >= thr); cgt += (k > thr); }
            cge = wave_isum(cge); cgt = wave_isum(cgt);
            if (cge > KSEL) {
                const int need = KSEL - cgt; int lo = 0, hi = LP - 1;
                while (lo < hi) { const int mid = (lo + hi) >> 1; int c = 0;
                    for (int i = 0; i < nt; ++i) { const int s = 64 * i + lane; c += (ks[s] == thr && s <= mid); }
                    c = wave_isum(c); if (c >= need) hi = mid; else lo = mid + 1; }
                sstar = lo;
            }
        }
        const unsigned te = thr == 0u ? 1u : thr;
        u64* bm = F.BM + (size_t)qi * NW64;
        for (int i = 0; i < NW64; ++i) {
            const int s = 64 * i + lane; const unsigned k = ks[s];
            const bool sel = (s < NMETA) || (k >= te && (k > thr || s <= sstar));
            const u64 w = __ballot(sel);
            if (lane == 0) bm[i] = w;
        }
        __builtin_amdgcn_s_waitcnt(0); __builtin_amdgcn_wave_barrier();
    }
}

__device__ __forceinline__ void ph_attn_naive(const Frame& F, unsigned char* lds, const float* inv_freq) {
    float* sc = (float*)(lds) + F.wave * (LP + 96); float* qs = sc + LP;
    const int gw = F.bid * 8 + F.wave, NGW = F.G * 8, lane = F.lane;
    const int NTASK = 2 * BATCH * 8 * SEQ;
    for (int task = gw; task < NTASK; task += NGW) {
        const int tq = task % SEQ, h = (task / SEQ) % 8, b = (task / (SEQ * 8)) % BATCH, mixer = task / (SEQ * 8 * BATCH);
        const int p = NMETA + tq; const size_t qrow = (size_t)b * LP + p; const int nt = p / 64 + 1;
        float mx = -INFINITY;
        if (mixer == 0) {
            qs[lane] = bf2f(F.P[qrow * DINP + OFF_QA + 64 * h + lane]);
            __builtin_amdgcn_s_waitcnt(0); __builtin_amdgcn_wave_barrier();
            const u64* bm = F.BM + ((size_t)b * SEQ + tq) * NW64;
            for (int i = 0; i < nt; ++i) {
                const int s = 64 * i + lane; const u64 w = bm[i]; float v = -INFINITY;
                if ((w >> lane) & 1ull) {
                    const v4u* kr = (const v4u*)(F.P + ((size_t)b * LP + s) * DINP + OFF_KA + 64 * h); float a = 0.f;
#pragma unroll
                    for (int c = 0; c < 8; ++c) { const v4u kv = kr[c];
#pragma unroll
                        for (int j = 0; j < 4; ++j) { a += qs[8 * c + 2 * j] * __uint_as_float(kv[j] << 16); a += qs[8 * c + 2 * j + 1] * __uint_as_float(kv[j] & 0xffff0000u); } }
                    v = a * 0.125f + F.rel_bias[t5_bucket(p - s) * 8 + h];
                }
                sc[s] = v; mx = fmaxf(mx, v);
            }
        } else {
            for (int i = lane; i < 96; i += 64) qs[i] = bf2f(F.QKVB[qrow * NMLA + 96 * h + i]);
            __builtin_amdgcn_s_waitcnt(0); __builtin_amdgcn_wave_barrier();
            if (lane < 16) { const float x1 = qs[64 + lane], x2 = qs[80 + lane]; const float ang = (float)p * inv_freq[lane]; const float cs = cosf(ang), sn = sinf(ang);
                qs[64 + lane] = x1 * cs - x2 * sn; qs[80 + lane] = x2 * cs + x1 * sn; }
            __builtin_amdgcn_s_waitcnt(0); __builtin_amdgcn_wave_barrier();
            for (int i = 0; i < nt; ++i) {
                const int s = 64 * i + lane; float v = -INFINITY;
                if (s <= p) {
                    const size_t srow = (size_t)b * LP + s;
                    const v4u* kr = (const v4u*)(F.QKVB + srow * NMLA + 768 + 128 * h); const v4u* pe = (const v4u*)(F.KPER + srow * 32); float a = 0.f;
#pragma unroll
                    for (int c = 0; c < 12; ++c) { const v4u kv = c < 8 ? kr[c] : pe[c - 8];
#pragma unroll
                        for (int j = 0; j < 4; ++j) { a += qs[8 * c + 2 * j] * __uint_as_float(kv[j] << 16); a += qs[8 * c + 2 * j + 1] * __uint_as_float(kv[j] & 0xffff0000u); } }
                    v = a * 0.10206207261596577f;
                }
                sc[s] = v; mx = fmaxf(mx, v);
            }
        }
        mx = wave_max(mx);
        float sum = 0.f;
        for (int i = 0; i < nt; ++i) { const int s = 64 * i + lane; const float e = __expf(sc[s] - mx); sc[s] = e; sum += e; }
        sum = wave_sum(sum);
        __builtin_amdgcn_s_waitcnt(0); __builtin_amdgcn_wave_barrier();
        float o = 0.f;
        const bf16* vb = mixer == 0 ? F.P + (size_t)b * LP * DINP + OFF_VA + 64 * h + lane : F.QKVB + (size_t)b * LP * NMLA + 768 + 128 * h + 64 + lane;
        const size_t vp = mixer == 0 ? DINP : NMLA;
        if (mixer == 0) {
            const u64* bm = F.BM + ((size_t)b * SEQ + tq) * NW64;
            for (int i = 0; i < nt; ++i) {
                const u64 wl = bm[i];
                unsigned wlo = __builtin_amdgcn_readfirstlane((unsigned)wl), whi = __builtin_amdgcn_readfirstlane((unsigned)(wl >> 32));
                while (wlo) { const int j = __builtin_ctz(wlo); wlo &= wlo - 1u; const int s = 64 * i + j; o += sc[s] * bf2f(vb[(size_t)s * vp]); }
                while (whi) { const int j = __builtin_ctz(whi); whi &= whi - 1u; const int s = 64 * i + 32 + j; o += sc[s] * bf2f(vb[(size_t)s * vp]); }
            }
        } else {
            for (int s = 0; s < 64 * nt; s += 8) {
#pragma unroll
                for (int j = 0; j < 8; ++j) o += sc[s + j] * bf2f(vb[(size_t)(s + j) * vp]);
            }
        }
        o /= sum;
        const float g = bf2f(F.P[qrow * DINP + (mixer == 0 ? OFF_GA : OFF_GB) + 64 * h + lane]);
        const float sg = g / (1.f + __expf(-g));
        F.MIX[((size_t)b * SEQ + tq) * DM + mixer * 512 + 64 * h + lane] = (bf16)f2bf(o * sg);
        __builtin_amdgcn_s_waitcnt(0); __builtin_amdgcn_wave_barrier();
    }
}

__device__ __forceinline__ void ph_final(const Frame& F) {
    const int gw = F.bid * 8 + F.wave, NGW = F.G * 8, lane = F.lane;
    for (int m = gw; m < MQ; m += NGW) {
        const f32x4* xr = (const f32x4*)(F.x + (size_t)m * DM) + lane; const f32x4* zr = (const f32x4*)(F.Z + (size_t)m * DM) + lane;
        f32x4 v[4]; float s = 0.f;
#pragma unroll
        for (int j = 0; j < 4; ++j) { v[j] = xr[64 * j]; s += (v[j].x + v[j].y) + (v[j].z + v[j].w); }
        const float mean = wave_sum(s) * (1.f / DM); float s2 = 0.f;
#pragma unroll
        for (int j = 0; j < 4; ++j) { v[j] = v[j] - mean; s2 += (v[j].x * v[j].x + v[j].y * v[j].y) + (v[j].z * v[j].z + v[j].w * v[j].w); }
        const float rstd = 1.f / sqrtf(wave_sum(s2) * (1.f / DM) + LN_EPS);
        float t = 0.f;
#pragma unroll
        for (int j = 0; j < 4; ++j) {
            const f32x4 g = ((const f32x4*)F.lne_g)[lane + 64 * j], bb = ((const f32x4*)F.lne_b)[lane + 64 * j];
            v[j] = (v[j] * rstd * g + bb) * ALPHA + zr[64 * j];
            t += (v[j].x + v[j].y) + (v[j].z + v[j].w);
        }
        const float mean2 = wave_sum(t) * (1.f / DM); float t2 = 0.f;
#pragma unroll
        for (int j = 0; j < 4; ++j) { v[j] = v[j] - mean2; t2 += (v[j].x * v[j].x + v[j].y * v[j].y) + (v[j].z * v[j].z + v[j].w * v[j].w); }
        const float rstd2 = 1.f / sqrtf(wave_sum(t2) * (1.f / DM) + LN_EPS);
        f32x4* o = (f32x4*)(F.out + (size_t)m * DM) + lane;
#pragma unroll
        for (int j = 0; j < 4; ++j) {
            const f32x4 g = ((const f32x4*)F.lnp_g)[lane + 64 * j], bb = ((const f32x4*)F.lnp_b)[lane + 64 * j];
            o[64 * j] = v[j] * rstd2 * g + bb;
        }
    }
}

namespace pg8 {
#define PG8_LAS __attribute__((address_space(3)))
typedef unsigned short bf16_t;
typedef short bf16x8 __attribute__((ext_vector_type(8)));
typedef float f32x4 __attribute__((ext_vector_type(4)));
typedef unsigned u32x4 __attribute__((ext_vector_type(4)));
constexpr int BM = 256, BK = 64, HALF = 128, HTB = HALF * BK * 2  , STAGE_BYTES = 8 * HTB, NXCD = 8, WGM = 8;

__host__ __device__ __forceinline__ int lds_byte(int r, int c) { const int st = (r >> 4) * 2 + (c >> 5), rr = r & 15, cc = c & 31, ob = rr * 64 + cc * 2; return st * 1024 + (ob ^ (((ob >> 9) & 1) << 5)); }
__host__ __device__ __forceinline__ void stage_rc(int b, int& R, int& C) { const int st = b / 1024, sb = b % 1024, swz = sb ^ (((sb >> 9) & 1) << 5); R = (st >> 1) * 16 + swz / 64; C = (st & 1) * 32 + (swz % 64) / 2; }
__host__ __device__ __forceinline__ int perm32(int rho) { const int n = rho >> 4, i = rho & 15; return 8 * (i >> 2) + 4 * n + (i & 3); }

struct Unit { int pm, pn; };
struct Gemm { const bf16_t* A; const bf16_t* Bt; int M, N, K; };

struct StaticOrder {
    int nM, nN, nwg, G, c;
    __host__ __device__ void init(int M, int N, int G_, int c_) { nM = M / BM; nN = N / BM; nwg = nM * nN; G = G_; c = c_; }
    __host__ __device__ bool next(int i, Unit& u) const {
        const long L = (long)i * G + c; if (L >= nwg) return false;
        int wgid = (int)L; { const int q = nwg / NXCD, r = nwg % NXCD, xcd = wgid % NXCD, off = wgid / NXCD; wgid = (xcd < r ? xcd * (q + 1) : r * (q + 1) + (xcd - r) * q) + off; }
        const int nig = WGM * nN, gid = wgid / nig, fm = gid * WGM, gsz = (nM - fm) < WGM ? (nM - fm) : WGM;
        u.pm = fm + ((wgid % nig) % gsz); u.pn = (wgid % nig) / gsz; return true;
    }
    __device__ __forceinline__ void a_ready(const Unit&) const {}
    __device__ __forceinline__ void done(const Unit&) const {}
};

__device__ __forceinline__ unsigned cvt_pk_bf16(float lo, float hi) { unsigned r; asm volatile("v_cvt_pk_bf16_f32 %0, %1, %2" : "=v"(r) : "v"(lo), "v"(hi)); return r; }

struct EpiBf16 {
    static constexpr bool PERM = true, AFTER_DRAIN = false;
    bf16_t* O; int ldc;
    __device__ __forceinline__ void operator()(const f32x4 (&acc)[2][2][4][2], const Unit& u, int wr, int wc, int fr, int fq) const {
        const int row0 = u.pm * BM + wr * 64 + fr, col0 = u.pn * BM + wc * 32 + 8 * fq;
#pragma unroll
        for (int ai = 0; ai < 2; ++ai)
#pragma unroll
            for (int m = 0; m < 4; ++m) { bf16_t* rowp = O + (size_t)(row0 + ai * HALF + m * 16) * ldc + col0;
#pragma unroll
                for (int bj = 0; bj < 2; ++bj) { const f32x4 v0 = acc[ai][bj][m][0], v1 = acc[ai][bj][m][1];
                    u32x4 w; w.x = cvt_pk_bf16(v0[0], v0[1]); w.y = cvt_pk_bf16(v0[2], v0[3]); w.z = cvt_pk_bf16(v1[0], v1[1]); w.w = cvt_pk_bf16(v1[2], v1[3]);
                    *(u32x4*)(rowp + bj * HALF) = w; } }
    }
};
struct EpiF32 {
    static constexpr bool PERM = false, AFTER_DRAIN = false;
    float* C; int ldc; const float* bias;
    __device__ __forceinline__ void operator()(const f32x4 (&acc)[2][2][4][2], const Unit& u, int wr, int wc, int fr, int fq) const {
        const int row0 = u.pm * BM + wr * 64 + fr, col0 = u.pn * BM + wc * 32 + 4 * fq;
        f32x4 bv[2][2];
#pragma unroll
        for (int bj = 0; bj < 2; ++bj)
#pragma unroll
            for (int n = 0; n < 2; ++n) bv[bj][n] = bias ? *(const f32x4*)(bias + col0 + bj * HALF + n * 16) : (f32x4){0.f, 0.f, 0.f, 0.f};
#pragma unroll
        for (int ai = 0; ai < 2; ++ai)
#pragma unroll
            for (int m = 0; m < 4; ++m) { float* rowp = C + (size_t)(row0 + ai * HALF + m * 16) * ldc + col0;
#pragma unroll
                for (int bj = 0; bj < 2; ++bj)
#pragma unroll
                    for (int n = 0; n < 2; ++n) *(f32x4*)(rowp + bj * HALF + n * 16) = acc[ai][bj][m][n] + bv[bj][n]; }
    }
};
template <class Epi, class Sched, bool ALIGN_EPI = false, bool SP2 = false>
__device__ __forceinline__ void gemm_phase(PG8_LAS unsigned char* lds, const Gemm g, const Sched& S, const Epi& E) {
    const int tid = threadIdx.x, wid = __builtin_amdgcn_readfirstlane(tid >> 6), lane = tid & 63, wr = wid >> 2, wc = wid & 3, fr = lane & 15, fq = lane >> 4;
    const int K = g.K, nt = K / BK;
    unsigned voffA[2], voffB[2];
#pragma unroll
    for (int i = 0; i < 2; ++i) { int R, C; stage_rc(tid * 16 + i * 8192, R, C); const int Rb = Epi::PERM ? ((R & ~31) + perm32(R & 31)) : R;
        voffA[i] = (unsigned)(R * K + C) * 2u; voffB[i] = (unsigned)(Rb * K + C) * 2u; }
    const size_t kstep = (size_t)(BK * 2);
    const size_t hstep = (size_t)HALF * K * 2;
    const size_t tstep = 2 * hstep;
    const unsigned ldsw = (unsigned)wid * 1024u;
    const int aoff = lds_byte(wr * 64 + fr, fq * 8), boff = lds_byte(wc * 32 + fr, fq * 8);
#define PG8_SA(b, h) (((b) * 2 + (h)) * HTB)
#define PG8_SB(b, h) ((4 + (b) * 2 + (h)) * HTB)
#define PG8_STAGE(bufoff, gbase, voff) do { _Pragma("unroll") for (int _i = 0; _i < 2; ++_i) \
        __builtin_amdgcn_global_load_lds((const unsigned*)((const char*)(gbase) + (voff)[_i]), (PG8_LAS unsigned*)(lds + (bufoff) + ldsw + _i * 8192), 16, 0, 0); } while (0)
#define PG8_LDA(dst, b, h) do { _Pragma("unroll") for (int m = 0; m < 4; ++m) _Pragma("unroll") for (int k = 0; k < 2; ++k) dst[m][k] = *(const PG8_LAS bf16x8*)(lds + PG8_SA(b, h) + aoff + m * 2048 + k * 1024); } while (0)
#define PG8_LDB(dst, b, h) do { _Pragma("unroll") for (int n = 0; n < 2; ++n) _Pragma("unroll") for (int k = 0; k < 2; ++k) dst[n][k] = *(const PG8_LAS bf16x8*)(lds + PG8_SB(b, h) + boff + n * 2048 + k * 1024); } while (0)
#define PG8_MMA(ai, bj, At, Bt) do { __builtin_amdgcn_s_setprio(1); _Pragma("unroll") for (int m = 0; m < 4; ++m) _Pragma("unroll") for (int n = 0; n < 2; ++n) _Pragma("unroll") for (int k = 0; k < 2; ++k) \
        acc[ai][bj][m][n] = __builtin_amdgcn_mfma_f32_16x16x32_bf16(Bt[n][k], At[m][k], acc[ai][bj][m][n], 0, 0, 0); __builtin_amdgcn_s_setprio(0); } while (0)
#define PG8_WAIT_V(n) asm volatile("s_waitcnt vmcnt(" #n ")" ::: "memory")
#define PG8_WAIT_L(n) asm volatile("s_waitcnt lgkmcnt(" #n ")" ::: "memory")
#define PG8_BAR __builtin_amdgcn_s_barrier()
#define PG8_SCHED __builtin_amdgcn_sched_barrier(0)
    Unit cur, nxt; int ui = 0;
    if (!S.next(0, cur)) return;
    f32x4 acc[2][2][4][2];
#pragma unroll
    for (int a = 0; a < 2; ++a)
#pragma unroll
        for (int b = 0; b < 2; ++b)
#pragma unroll
            for (int m = 0; m < 4; ++m)
#pragma unroll
                for (int n = 0; n < 2; ++n) acc[a][b][m][n] = (f32x4){0.f, 0.f, 0.f, 0.f};
    bf16x8 At[4][2], B0[2][2], B1[2][2];
    const char* cA = (const char*)g.A + (size_t)cur.pm * tstep; const char* cB = (const char*)g.Bt + (size_t)cur.pn * tstep;
    S.a_ready(cur);
    if constexpr (SP2) {
        PG8_STAGE(PG8_SB(0, 0), cB, voffB); PG8_STAGE(PG8_SB(0, 1), cB + hstep, voffB); PG8_STAGE(PG8_SA(0, 0), cA, voffA); PG8_STAGE(PG8_SA(0, 1), cA + hstep, voffA);
        if (wr == 1) PG8_BAR;
        PG8_WAIT_V(2); PG8_BAR;
        PG8_STAGE(PG8_SB(1, 0), cB + kstep, voffB); PG8_STAGE(PG8_SA(1, 0), cA + kstep, voffA); PG8_STAGE(PG8_SB(1, 1), cB + hstep + kstep, voffB);
        PG8_WAIT_V(6); PG8_BAR;
    } else {
        PG8_STAGE(PG8_SB(0, 0), cB, voffB); PG8_STAGE(PG8_SA(0, 0), cA, voffA); PG8_STAGE(PG8_SB(0, 1), cB + hstep, voffB); PG8_STAGE(PG8_SA(0, 1), cA + hstep, voffA);
        if (wr == 1) PG8_BAR;
        PG8_WAIT_V(4); PG8_BAR;
        PG8_STAGE(PG8_SB(1, 0), cB + kstep, voffB); PG8_STAGE(PG8_SA(1, 0), cA + kstep, voffA); PG8_STAGE(PG8_SB(1, 1), cB + hstep + kstep, voffB);
        PG8_WAIT_V(6); PG8_BAR;
    }
    for (;;) {
        const bool has_next = S.next(ui + 1, nxt);
        const char* nA = has_next ? (const char*)g.A + (size_t)nxt.pm * tstep : cA; const char* nB = has_next ? (const char*)g.Bt + (size_t)nxt.pn * tstep : cB;
        for (int t = 0; t < nt; t += 2) {
            const bool last = (t == nt - 2);
            const char* a1 = cA + (size_t)(t + 1) * kstep;
            const char* a2 = last ? nA : cA + (size_t)(t + 2) * kstep; const char* b2 = last ? nB : cB + (size_t)(t + 2) * kstep;
            const char* a3 = a2 + kstep; const char* b3 = b2 + kstep;
            if (last && has_next) S.a_ready(nxt);
            if constexpr (SP2) {
            PG8_LDB(B0, 0, 0); PG8_LDB(B1, 0, 1); PG8_SCHED; PG8_LDA(At, 0, 0); PG8_STAGE(PG8_SA(1, 1), a1 + hstep, voffA);
            PG8_WAIT_V(8); PG8_WAIT_L(0); PG8_BAR; PG8_MMA(0, 0, At, B0); PG8_MMA(0, 1, At, B1); PG8_BAR; PG8_SCHED;
            PG8_LDA(At, 0, 1); PG8_STAGE(PG8_SB(0, 0), b2, voffB); PG8_STAGE(PG8_SB(0, 1), b2 + hstep, voffB); PG8_STAGE(PG8_SA(0, 0), a2, voffA);
            PG8_WAIT_V(8); PG8_WAIT_L(0); PG8_BAR; PG8_MMA(1, 0, At, B0); PG8_MMA(1, 1, At, B1); PG8_BAR; PG8_SCHED;
            PG8_LDB(B0, 1, 0); PG8_LDB(B1, 1, 1); PG8_SCHED; PG8_LDA(At, 1, 0); PG8_STAGE(PG8_SA(0, 1), a2 + hstep, voffA);
            PG8_WAIT_V(8); PG8_WAIT_L(0); PG8_BAR; PG8_MMA(0, 0, At, B0); PG8_MMA(0, 1, At, B1); PG8_BAR; PG8_SCHED;
            PG8_LDA(At, 1, 1); PG8_STAGE(PG8_SB(1, 0), b3, voffB); PG8_STAGE(PG8_SB(1, 1), b3 + hstep, voffB); PG8_STAGE(PG8_SA(1, 0), a3, voffA);
            PG8_WAIT_V(8); PG8_WAIT_L(0); PG8_BAR; PG8_MMA(1, 0, At, B0); PG8_MMA(1, 1, At, B1); PG8_BAR; PG8_SCHED;
            } else {
            PG8_LDB(B0, 0, 0); PG8_SCHED; PG8_LDA(At, 0, 0); PG8_STAGE(PG8_SA(1, 1), a1 + hstep, voffA);
            PG8_WAIT_L(8); PG8_BAR; PG8_WAIT_L(0); PG8_MMA(0, 0, At, B0); PG8_BAR; PG8_SCHED;
            PG8_LDB(B1, 0, 1); PG8_STAGE(PG8_SB(0, 0), b2, voffB);
            PG8_BAR; PG8_WAIT_L(0); PG8_MMA(0, 1, At, B1); PG8_BAR;
            PG8_LDA(At, 0, 1); PG8_STAGE(PG8_SA(0, 0), a2, voffA);
            PG8_BAR; PG8_WAIT_L(0); PG8_MMA(1, 0, At, B0); PG8_BAR; PG8_SCHED;
            PG8_STAGE(PG8_SB(0, 1), b2 + hstep, voffB);
            PG8_WAIT_V(6); PG8_BAR; PG8_MMA(1, 1, At, B1); PG8_BAR;
            PG8_LDB(B0, 1, 0); PG8_SCHED; PG8_LDA(At, 1, 0); PG8_STAGE(PG8_SA(0, 1), a2 + hstep, voffA);
            PG8_WAIT_L(8); PG8_BAR; PG8_WAIT_L(0); PG8_MMA(0, 0, At, B0); PG8_BAR; PG8_SCHED;
            PG8_LDB(B1, 1, 1); PG8_STAGE(PG8_SB(1, 0), b3, voffB);
            PG8_BAR; PG8_WAIT_L(0); PG8_MMA(0, 1, At, B1); PG8_BAR;
            PG8_LDA(At, 1, 1); PG8_STAGE(PG8_SA(1, 0), a3, voffA);
            PG8_BAR; PG8_WAIT_L(0); PG8_MMA(1, 0, At, B0); PG8_BAR; PG8_SCHED;
            PG8_STAGE(PG8_SB(1, 1), b3 + hstep, voffB);
            PG8_WAIT_V(6); PG8_BAR; PG8_MMA(1, 1, At, B1); PG8_BAR;
            }
        }
        if constexpr (ALIGN_EPI) { if (wr == 0) PG8_BAR; }
        if constexpr (!Epi::AFTER_DRAIN) { E(acc, cur, wr, wc, fr, fq); S.done(cur); }
        if (!has_next) break;
#pragma unroll
        for (int a = 0; a < 2; ++a)
#pragma unroll
            for (int b = 0; b < 2; ++b)
#pragma unroll
                for (int m = 0; m < 4; ++m)
#pragma unroll
                    for (int n = 0; n < 2; ++n) acc[a][b][m][n] = (f32x4){0.f, 0.f, 0.f, 0.f};
        cur = nxt; cA = nA; cB = nB; ++ui;
        if constexpr (ALIGN_EPI) { if (wr == 1) PG8_BAR; }
    }
    PG8_WAIT_V(0);
    if constexpr (!ALIGN_EPI) { if (wr == 0) PG8_BAR; }
    PG8_BAR;
    if constexpr (Epi::AFTER_DRAIN) { E.fused(acc, cur, wr, wc, fr, fq, lds, wid, lane); S.done(cur); }
#undef PG8_SA
#undef PG8_SB
#undef PG8_STAGE
#undef PG8_LDA
#undef PG8_LDB
#undef PG8_MMA
#undef PG8_WAIT_V
#undef PG8_WAIT_L
#undef PG8_BAR
#undef PG8_SCHED
}
}

constexpr int LDS_BYTES = 155648;
__global__ void __launch_bounds__(512, 2) fwd(Args args) {
    extern __shared__ __attribute__((aligned(16))) unsigned char lds[];
    Frame F;
    F.tid = threadIdx.x; F.lane = F.tid & 63; F.wave = __builtin_amdgcn_readfirstlane(F.tid >> 6); F.G = gridDim.x; F.bid = blockIdx.x;
    F.x = args.in[0]; F.meta = args.in[1]; F.lne_g = args.in[2]; F.lne_b = args.in[3]; F.w_in = args.in[4]; F.w_uq = args.in[5]; F.qn_g = args.in[6];
    F.w_ukv = args.in[7]; F.kvn_g = args.in[8]; F.rel_bias = args.in[9]; F.w_out = args.in[10]; F.lnp_g = args.in[11]; F.lnp_b = args.in[12];
    F.out = args.out;
    unsigned char* ws = args.ws;
    F.Win_t = (bf16*)(ws + WS_WIN); F.Wmla_t = (bf16*)(ws + WS_WMLA); F.Wout_t = (bf16*)(ws + WS_WOUT); F.KPER = (bf16*)(ws + WS_KPER);
    F.BM = (u64*)(ws + WS_BM); F.CQKVN = (bf16*)(ws + WS_CQKVN); F.XN = (bf16*)(ws + WS_XN); F.MIX = (bf16*)(ws + WS_XN);
    F.QKVB = (bf16*)(ws + WS_QKVB); F.P = (bf16*)(ws + WS_P); F.Z = (float*)(ws + WS_P);
    const int lo = args.ph_lo, hi = args.ph_hi;
    cooperative_groups::grid_group grid = cooperative_groups::this_grid();
#define IN(k) (lo <= (k) && (k) < hi)
#define SEAM(k) do { if (IN(k) && IN((k) + 1)) grid.sync(); } while (0)
    if (IN(0)) ph_prologue(F, (float*)lds);
    SEAM(0);
    PG8_LAS unsigned char* ring = (PG8_LAS unsigned char*)lds;
    if (IN(1)) { pg8::Gemm g{F.XN, F.Win_t, MROWS, DINP, DM}; pg8::StaticOrder S; S.init(MROWS, DINP, F.G, F.bid); pg8::EpiBf16 E{F.P, DINP};
        pg8::gemm_phase<pg8::EpiBf16, pg8::StaticOrder, true, true>(ring, g, S, E); }
    SEAM(1);
    if (IN(2)) ph_rms(F, args.inv_freq);
    SEAM(2);
    if (IN(3)) { { pg8::Gemm g{F.CQKVN, F.Wmla_t, MROWS, NMLA, KMLA}; pg8::StaticOrder S; S.init(MROWS, NMLA, F.G, F.bid); pg8::EpiBf16 E{F.QKVB, NMLA};
        pg8::gemm_phase<pg8::EpiBf16, pg8::StaticOrder, true, true>(ring, g, S, E); }
        __syncthreads(); ph_index_naive(F, lds); }
    SEAM(3);
    if (IN(4)) ph_attn_naive(F, lds, args.inv_freq);
    SEAM(4);
    if (IN(5)) { pg8::Gemm g{F.MIX, F.Wout_t, MQ, DM, DM}; pg8::StaticOrder S; S.init(MQ, DM, F.G, F.bid); pg8::EpiF32 E{F.Z, DM, nullptr};
        pg8::gemm_phase<pg8::EpiF32, pg8::StaticOrder, true, true>(ring, g, S, E); }
    SEAM(5);
    if (IN(6)) ph_final(F);
#undef IN
#undef SEAM
}

#ifndef MK_N_LAUNCHES
#define MK_N_LAUNCHES 1
#endif
extern "C" void kernel_launch(void* const* d_in, const int* in_sizes, int n_in, void* d_out, int out_size, void* d_ws, size_t ws_size, hipStream_t stream) {
    static int grid_blocks = 0;
    if (!grid_blocks) {
        if (n_in != 13 || out_size != MQ * DM || ws_size < WS_END) { fprintf(stderr, "kernel_launch: unexpected shapes (n_in %d out %d ws %zu)\n", n_in, out_size, ws_size); grid_blocks = -1; return; }
        if (hipFuncSetAttribute((const void*)fwd, hipFuncAttributeMaxDynamicSharedMemorySize, LDS_BYTES) != hipSuccess) { fprintf(stderr, "kernel_launch: hipFuncSetAttribute failed\n"); grid_blocks = -1; return; }
        int dev = 0, cus = 0, per_cu = 0;
        (void)hipGetDevice(&dev);
        (void)hipDeviceGetAttribute(&cus, hipDeviceAttributeMultiprocessorCount, dev);
        (void)hipOccupancyMaxActiveBlocksPerMultiprocessor(&per_cu, (const void*)fwd, 512, LDS_BYTES);
        if (per_cu < 1 || cus < 1) { fprintf(stderr, "kernel_launch: occupancy query says %d blocks/CU on %d CUs\n", per_cu, cus); grid_blocks = -1; return; }
        grid_blocks = cus;
    }
    if (grid_blocks < 0) return;
    Args a{};
    for (int i = 0; i < 13; ++i) a.in[i] = (const float*)d_in[i];
    a.out = (float*)d_out; a.ws = (unsigned char*)d_ws;
    for (int i = 0; i < 16; ++i) a.inv_freq[i] = (float)pow(10000.0, -(double)(2 * i) / 32.0);
    if (MK_N_LAUNCHES == 1) {
        a.ph_lo = 0; a.ph_hi = 7;
        void* kargs[] = {&a};
        hipError_t e = hipLaunchCooperativeKernel((const void*)fwd, dim3(grid_blocks), dim3(512), kargs, LDS_BYTES, stream);
        if (e != hipSuccess) fprintf(stderr, "kernel_launch: cooperative launch failed: %s (grid %d)\n", hipGetErrorString(e), grid_blocks);
    } else {
        for (int ph = 0; ph < 7; ++ph) {
            a.ph_lo = ph; a.ph_hi = ph + 1;
            hipLaunchKernelGGL(fwd, dim3(grid_blocks), dim3(512), LDS_BYTES, stream, a);
        }
    }
}
```

```cpp
#include <hip/hip_runtime.h>
#include <hip/hip_cooperative_groups.h>
#include <cstdio>
#include <cstdint>
#include <cmath>

constexpr int BATCH = 4, SEQ = 4096, DM = 1024, NMETA = 16;
constexpr int LTOK = NMETA + SEQ;
constexpr int LP = 4160;
constexpr int MROWS = BATCH * LP;
constexpr int MQ = BATCH * SEQ;
constexpr int DIN = 3560, DINP = 3584;
constexpr int OFF_QA = 0, OFF_KA = 512, OFF_VA = 1024, OFF_GA = 1536, OFF_QI = 2048, OFF_KI = 2560, OFF_WI = 2624,
              OFF_CQ = 2632, OFF_CKV = 2888, OFF_KPE = 3016, OFF_GB = 3048;
constexpr int KMLA = 384, NMLA = 1792;
constexpr int TOPK = 256, KSEL = TOPK - NMETA;
constexpr int NW64 = LP / 64;
constexpr float LN_EPS = 1e-5f, RMS_EPS = 1e-6f;
constexpr float ALPHA = 1.189207115002721f;

constexpr size_t MiB = 1u << 20;
constexpr size_t WS_CTL = 0;
constexpr size_t WS_WIN = 2 * MiB;
constexpr size_t WS_WMLA = 9 * MiB;
constexpr size_t WS_WOUT = 11 * MiB;
constexpr size_t WS_KPER = 13 * MiB;
constexpr size_t WS_BM = 15 * MiB;
constexpr size_t WS_CQKVN = 24 * MiB;
constexpr size_t WS_XN = 37 * MiB;
constexpr size_t WS_QKVB = 70 * MiB;
constexpr size_t WS_P = 127 * MiB;
constexpr size_t WS_END = 241 * MiB;

typedef unsigned short bf16;
typedef unsigned long long u64;
typedef unsigned v4u __attribute__((ext_vector_type(4)));
typedef float f32x4 __attribute__((ext_vector_type(4)));

__device__ __forceinline__ float bf2f(bf16 v) { return __uint_as_float((unsigned)v << 16); }
__device__ __forceinline__ unsigned f2bf(float f) { unsigned u = __float_as_uint(f); return (u + 0x7fffu + ((u >> 16) & 1u)) >> 16; }
__device__ __forceinline__ unsigned pk2(float lo, float hi) { return f2bf(lo) | (f2bf(hi) << 16); }
__device__ __forceinline__ float wave_sum(float v) {
#pragma unroll
    for (int o = 1; o < 64; o <<= 1) v += __shfl_xor(v, o);
    return v;
}
__device__ __forceinline__ float wave_max(float v) {
#pragma unroll
    for (int o = 1; o < 64; o <<= 1) v = fmaxf(v, __shfl_xor(v, o));
    return v;
}
__device__ __forceinline__ int wave_isum(int v) {
#pragma unroll
    for (int o = 1; o < 64; o <<= 1) v += __shfl_xor(v, o);
    return v;
}
__device__ __forceinline__ int t5_bucket(int d) {
    if (d < 16) return d < 0 ? 0 : d;
    return 16 + (d >= 19) + (d >= 21) + (d >= 24) + (d >= 27) + (d >= 31) + (d >= 35) + (d >= 40) + (d >= 46) + (d >= 52) + (d >= 59) + (d >= 67) + (d >= 77) + (d >= 87) + (d >= 99) + (d >= 113);
}
__device__ __forceinline__ unsigned fkey(float f) { unsigned u = __float_as_uint(f); return (u & 0x80000000u) ? ~u : (u | 0x80000000u); }

struct Args {
    const float* in[13];
    float* out;
    unsigned char* ws;
    float inv_freq[16];
    int ph_lo, ph_hi;
};

struct Frame {
    int tid, lane, wave, G, bid;
    const float *x, *meta, *lne_g, *lne_b, *w_in, *w_uq, *qn_g, *w_ukv, *kvn_g, *rel_bias, *w_out, *lnp_g, *lnp_b;
    float* out;
    bf16 *Win_t, *Wmla_t, *Wout_t, *KPER, *CQKVN, *XN, *MIX, *QKVB, *P;
    u64* BM;
    float* Z;
};

template <class F> __device__ __forceinline__ void transpose_tile(F src, bf16* dst, int ldk, int n0, int k0, float* scr, int tid) {
    const int ty = tid >> 6, tx = tid & 63;
#pragma unroll
    for (int i = 0; i < 8; ++i) { const int k = ty + 8 * i; scr[k * 65 + tx] = src(k0 + k, n0 + tx); }
    __syncthreads();
    const int nn = tid >> 3, kc = tid & 7;
    v4u o; o.x = pk2(scr[(8 * kc + 0) * 65 + nn], scr[(8 * kc + 1) * 65 + nn]); o.y = pk2(scr[(8 * kc + 2) * 65 + nn], scr[(8 * kc + 3) * 65 + nn]);
    o.z = pk2(scr[(8 * kc + 4) * 65 + nn], scr[(8 * kc + 5) * 65 + nn]); o.w = pk2(scr[(8 * kc + 6) * 65 + nn], scr[(8 * kc + 7) * 65 + nn]);
    *(v4u*)(dst + (size_t)(n0 + nn) * ldk + k0 + 8 * kc) = o;
    __syncthreads();
}
__device__ __forceinline__ void ph_prologue(const Frame& F, float* lds) {
    constexpr int I_IN = (DINP / 64) * (DM / 64), I_MLA = (NMLA / 64) * (KMLA / 64), I_OUT = (DM / 64) * (DM / 64);
    for (int it = F.bid; it < I_IN + I_MLA + I_OUT; it += F.G) {
        if (it < I_IN) {
            const int n0 = (it / (DM / 64)) * 64, k0 = (it % (DM / 64)) * 64; const float* w = F.w_in;
            transpose_tile([=](int k, int n) { return n < DIN ? w[(size_t)k * DIN + n] : 0.f; }, F.Win_t, DM, n0, k0, lds, F.tid);
        } else if (it < I_IN + I_MLA) {
            const int r = it - I_IN, n0 = (r / (KMLA / 64)) * 64, k0 = (r % (KMLA / 64)) * 64;
            const float *wq = F.w_uq, *wkv = F.w_ukv, *gq = F.qn_g, *gkv = F.kvn_g;
            transpose_tile([=](int k, int n) {
                if (n < 768) return k < 256 ? wq[(size_t)k * 768 + n] * gq[k] : 0.f;
                return k >= 256 ? wkv[(size_t)(k - 256) * 1024 + (n - 768)] * gkv[k - 256] : 0.f; }, F.Wmla_t, KMLA, n0, k0, lds, F.tid);
        } else {
            const int r = it - I_IN - I_MLA, n0 = (r / (DM / 64)) * 64, k0 = (r % (DM / 64)) * 64; const float* w = F.w_out;
            transpose_tile([=](int k, int n) { return w[(size_t)k * DM + n]; }, F.Wout_t, DM, n0, k0, lds, F.tid);
        }
    }
    const int gw = F.bid * 8 + F.wave, NGW = F.G * 8;
    for (int m = gw; m < MROWS; m += NGW) {
        const int b = m / LP, p = m % LP;
        unsigned long long* o8 = (unsigned long long*)(F.XN + (size_t)m * DM) + F.lane;
        if (p >= LTOK) {
#pragma unroll
            for (int j = 0; j < 4; ++j) o8[64 * j] = 0ull;
            continue;
        }
        const float* src = p < NMETA ? F.meta + (size_t)p * DM : F.x + ((size_t)b * SEQ + (p - NMETA)) * DM;
        const f32x4* xr = (const f32x4*)src + F.lane;
        f32x4 v[4]; float s = 0.f;
#pragma unroll
        for (int j = 0; j < 4; ++j) { v[j] = xr[64 * j]; s += (v[j].x + v[j].y) + (v[j].z + v[j].w); }
        const float mean = wave_sum(s) * (1.f / DM); float s2 = 0.f;
#pragma unroll
        for (int j = 0; j < 4; ++j) { v[j] = v[j] - mean; s2 += (v[j].x * v[j].x + v[j].y * v[j].y) + (v[j].z * v[j].z + v[j].w * v[j].w); }
        const float rstd = 1.f / sqrtf(wave_sum(s2) * (1.f / DM) + LN_EPS);
#pragma unroll
        for (int j = 0; j < 4; ++j) {
            const f32x4 g = ((const f32x4*)F.lne_g)[F.lane + 64 * j], bb = ((const f32x4*)F.lne_b)[F.lane + 64 * j];
            const f32x4 y = v[j] * rstd * g + bb;
            o8[64 * j] = (unsigned long long)pk2(y.x, y.y) | ((unsigned long long)pk2(y.z, y.w) << 32);
        }
    }
}

__device__ __forceinline__ void ph_gemm_naive(const Frame& F, const bf16* A, int lda, const bf16* Bt, int ldb, int M, int N, int K, bf16* Cb, float* Cf, int ldc) {
    const int tn = F.tid & 63, tm = F.tid >> 6;
    const int ntn = N / 64, ntm = M / 8; const long nt = (long)ntn * ntm;
    for (long t = F.bid; t < nt; t += F.G) {
        const int m = (int)(t / ntn) * 8 + tm, n = (int)(t % ntn) * 64 + tn;
        const v4u* a = (const v4u*)(A + (size_t)m * lda); const v4u* b = (const v4u*)(Bt + (size_t)n * ldb);
        float acc = 0.f;
        for (int k = 0; k < K / 8; ++k) {
            const v4u av = a[k], bv = b[k];
#pragma unroll
            for (int j = 0; j < 4; ++j) { acc += __uint_as_float(av[j] << 16) * __uint_as_float(bv[j] << 16); acc += __uint_as_float(av[j] & 0xffff0000u) * __uint_as_float(bv[j] & 0xffff0000u); }
        }
        if (Cb) Cb[(size_t)m * ldc + n] = (bf16)f2bf(acc); else Cf[(size_t)m * ldc + n] = acc;
    }
}

__device__ __forceinline__ void ph_rms(const Frame& F, const float* inv_freq) {
    const int gw = F.bid * 8 + F.wave, NGW = F.G * 8, lane = F.lane;
    for (int m = gw; m < MROWS; m += NGW) {
        const bf16* pr = F.P + (size_t)m * DINP; const int p = m % LP;
        const unsigned long long cq4 = *(const unsigned long long*)(pr + OFF_CQ + 4 * lane);
        const unsigned ckv2 = *(const unsigned*)(pr + OFF_CKV + 2 * lane);
        float c[4] = {bf2f((bf16)(cq4 & 0xffff)), bf2f((bf16)((cq4 >> 16) & 0xffff)), bf2f((bf16)((cq4 >> 32) & 0xffff)), bf2f((bf16)(cq4 >> 48))};
        float d[2] = {bf2f((bf16)(ckv2 & 0xffff)), bf2f((bf16)(ckv2 >> 16))};
        const float sq = wave_sum(c[0] * c[0] + c[1] * c[1] + c[2] * c[2] + c[3] * c[3]), skv = wave_sum(d[0] * d[0] + d[1] * d[1]);
        const float rq = 1.f / sqrtf(sq * (1.f / 256.f) + RMS_EPS), rkv = 1.f / sqrtf(skv * (1.f / 128.f) + RMS_EPS);
        bf16* o = F.CQKVN + (size_t)m * KMLA;
        *(unsigned long long*)(o + 4 * lane) = (unsigned long long)pk2(c[0] * rq, c[1] * rq) | ((unsigned long long)pk2(c[2] * rq, c[3] * rq) << 32);
        *(unsigned*)(o + 256 + 2 * lane) = pk2(d[0] * rkv, d[1] * rkv);
        if (lane < 16) {
            const float x1 = bf2f(pr[OFF_KPE + lane]), x2 = bf2f(pr[OFF_KPE + 16 + lane]);
            const float ang = (float)p * inv_freq[lane]; const float cs = cosf(ang), sn = sinf(ang);
            F.KPER[(size_t)m * 32 + lane] = (bf16)f2bf(x1 * cs - x2 * sn); F.KPER[(size_t)m * 32 + 16 + lane] = (bf16)f2bf(x2 * cs + x1 * sn);
        }
    }
}

__device__ __forceinline__ void ph_index_naive(const Frame& F, unsigned char* lds) {
    unsigned* ks = (unsigned*)(lds) + F.wave * (LP + 512); float* qs = (float*)(ks + LP);
    const int gw = F.bid * 8 + F.wave, NGW = F.G * 8, lane = F.lane;
    for (int qi = gw; qi < MQ; qi += NGW) {
        const int b = qi / SEQ, tq = qi % SEQ, p = NMETA + tq; const size_t qrow = (size_t)b * LP + p;
        const bf16* pr = F.P + qrow * DINP;
        for (int i = lane; i < 512; i += 64) qs[i] = bf2f(pr[OFF_QI + i]);
        float ch[8];
#pragma unroll
        for (int h = 0; h < 8; ++h) ch[h] = bf2f(pr[OFF_WI + h]) * 0.35355339059327373f;
        __builtin_amdgcn_s_waitcnt(0); __builtin_amdgcn_wave_barrier();
        const int nt = p / 64 + 1;
        for (int i = 0; i < NW64; ++i) {
            const int s = 64 * i + lane; unsigned key = 0u;
            if (i < nt && s >= NMETA && s <= p) {
                const v4u* kr = (const v4u*)(F.P + ((size_t)b * LP + s) * DINP + OFF_KI);
                float kf[64];
#pragma unroll
                for (int c = 0; c < 8; ++c) { const v4u v = kr[c];
#pragma unroll
                    for (int j = 0; j < 4; ++j) { kf[8 * c + 2 * j] = __uint_as_float(v[j] << 16); kf[8 * c + 2 * j + 1] = __uint_as_float(v[j] & 0xffff0000u); } }
                float sc = 0.f;
#pragma unroll
                for (int h = 0; h < 8; ++h) { float a = 0.f;
#pragma unroll
                    for (int d = 0; d < 64; ++d) a += qs[64 * h + d] * kf[d];
                    sc += fmaxf(a * 0.125f, 0.f) * ch[h]; }
                key = fkey(sc);
            }
            ks[s] = key;
        }
        __builtin_amdgcn_s_waitcnt(0); __builtin_amdgcn_wave_barrier();
        unsigned thr = 0u;
        for (int bit = 31; bit >= 0; --bit) {
            const unsigned cand = thr | (1u << bit); int c = 0;
            for (int i = 0; i < nt; ++i) c += (ks[64 * i + lane] >= cand) ? 1 : 0;
            c = wave_isum(c);
            if (c >= KSEL) thr = cand;
        }
        int sstar = LP;
        if (thr != 0u) {
            int cge = 0, cgt = 0;
            for (int i = 0; i < nt; ++i) { const unsigned k = ks[64 * i + lane]; cge += (k >= thr); cgt += (k > thr); }
            cge = wave_isum(cge); cgt = wave_isum(cgt);
            if (cge > KSEL) {
                const int need = KSEL - cgt; int lo = 0, hi = LP - 1;
                while (lo < hi) { const int mid = (lo + hi) >> 1; int c = 0;
                    for (int i = 0; i < nt; ++i) { const int s = 64 * i + lane; c += (ks[s] == thr && s <= mid); }
                    c = wave_isum(c); if (c >= need) hi = mid; else lo = mid + 1; }
                sstar = lo;
            }
        }
        const unsigned te = thr == 0u ? 1u : thr;
        u64* bm = F.BM + (size_t)qi * NW64;
        for (int i = 0; i < NW64; ++i) {
            const int s = 64 * i + lane; const unsigned k = ks[s];
            const bool sel = (s < NMETA) || (k >= te && (k > thr || s <= sstar));
            const u64 w = __ballot(sel);
            if (lane == 0) bm[i] = w;
        }
        __builtin_amdgcn_s_waitcnt(0); __builtin_amdgcn_wave_barrier();
    }
}

__device__ __forceinline__ void ph_attn_naive(const Frame& F, unsigned char* lds, const float* inv_freq) {
    float* sc = (float*)(lds) + F.wave * (LP + 96); float* qs = sc + LP;
    const int gw = F.bid * 8 + F.wave, NGW = F.G * 8, lane = F.lane;
    const int NTASK = 2 * BATCH * 8 * SEQ;
    for (int task = gw; task < NTASK; task += NGW) {
        const int tq = task % SEQ, h = (task / SEQ) % 8, b = (task / (SEQ * 8)) % BATCH, mixer = task / (SEQ * 8 * BATCH);
        const int p = NMETA + tq; const size_t qrow = (size_t)b * LP + p; const int nt = p / 64 + 1;
        float mx = -INFINITY;
        if (mixer == 0) {
            qs[lane] = bf2f(F.P[qrow * DINP + OFF_QA + 64 * h + lane]);
            __builtin_amdgcn_s_waitcnt(0); __builtin_amdgcn_wave_barrier();
            const u64* bm = F.BM + ((size_t)b * SEQ + tq) * NW64;
            for (int i = 0; i < nt; ++i) {
                const int s = 64 * i + lane; const u64 w = bm[i]; float v = -INFINITY;
                if ((w >> lane) & 1ull) {
                    const v4u* kr = (const v4u*)(F.P + ((size_t)b * LP + s) * DINP + OFF_KA + 64 * h); float a = 0.f;
#pragma unroll
                    for (int c = 0; c < 8; ++c) { const v4u kv = kr[c];
#pragma unroll
                        for (int j = 0; j < 4; ++j) { a += qs[8 * c + 2 * j] * __uint_as_float(kv[j] << 16); a += qs[8 * c + 2 * j + 1] * __uint_as_float(kv[j] & 0xffff0000u); } }
                    v = a * 0.125f + F.rel_bias[t5_bucket(p - s) * 8 + h];
                }
                sc[s] = v; mx = fmaxf(mx, v);
            }
        } else {
            for (int i = lane; i < 96; i += 64) qs[i] = bf2f(F.QKVB[qrow * NMLA + 96 * h + i]);
            __builtin_amdgcn_s_waitcnt(0); __builtin_amdgcn_wave_barrier();
            if (lane < 16) { const float x1 = qs[64 + lane], x2 = qs[80 + lane]; const float ang = (float)p * inv_freq[lane]; const float cs = cosf(ang), sn = sinf(ang);
                qs[64 + lane] = x1 * cs - x2 * sn; qs[80 + lane] = x2 * cs + x1 * sn; }
            __builtin_amdgcn_s_waitcnt(0); __builtin_amdgcn_wave_barrier();
            for (int i = 0; i < nt; ++i) {
                const int s = 64 * i + lane; float v = -INFINITY;
                if (s <= p) {
                    const size_t srow = (size_t)b * LP + s;
                    const v4u* kr = (const v4u*)(F.QKVB + srow * NMLA + 768 + 128 * h); const v4u* pe = (const v4u*)(F.KPER + srow * 32); float a = 0.f;
#pragma unroll
                    for (int c = 0; c < 12; ++c) { const v4u kv = c < 8 ? kr[c] : pe[c - 8];
#pragma unroll
                        for (int j = 0; j < 4; ++j) { a += qs[8 * c + 2 * j] * __uint_as_float(kv[j] << 16); a += qs[8 * c + 2 * j + 1] * __uint_as_float(kv[j] & 0xffff0000u); } }
                    v = a * 0.10206207261596577f;
                }
                sc[s] = v; mx = fmaxf(mx, v);
            }
        }
        mx = wave_max(mx);
        float sum = 0.f;
        for (int i = 0; i < nt; ++i) { const int s = 64 * i + lane; const float e = __expf(sc[s] - mx); sc[s] = e; sum += e; }
        sum = wave_sum(sum);
        __builtin_amdgcn_s_waitcnt(0); __builtin_amdgcn_wave_barrier();
        float o = 0.f;
        const bf16* vb = mixer == 0 ? F.P + (size_t)b * LP * DINP + OFF_VA + 64 * h + lane : F.QKVB + (size_t)b * LP * NMLA + 768 + 128 * h + 64 + lane;
        const size_t vp = mixer == 0 ? DINP : NMLA;
        if (mixer == 0) {
            const u64* bm = F.BM + ((size_t)b * SEQ + tq) * NW64;
            for (int i = 0; i < nt; ++i) {
                const u64 wl = bm[i];
                unsigned wlo = __builtin_amdgcn_readfirstlane((unsigned)wl), whi = __builtin_amdgcn_readfirstlane((unsigned)(wl >> 32));
                while (wlo) { const int j = __builtin_ctz(wlo); wlo &= wlo - 1u; const int s = 64 * i + j; o += sc[s] * bf2f(vb[(size_t)s * vp]); }
                while (whi) { const int j = __builtin_ctz(whi); whi &= whi - 1u; const int s = 64 * i + 32 + j; o += sc[s] * bf2f(vb[(size_t)s * vp]); }
            }
        } else {
            for (int s = 0; s < 64 * nt; s += 8) {
#pragma unroll
                for (int j = 0; j < 8; ++j) o += sc[s + j] * bf2f(vb[(size_t)(s + j) * vp]);
            }
        }
        o /= sum;
        const float g = bf2f(F.P[qrow * DINP + (mixer == 0 ? OFF_GA : OFF_GB) + 64 * h + lane]);
        const float sg = g / (1.f + __expf(-g));
        F.MIX[((size_t)b * SEQ + tq) * DM + mixer * 512 + 64 * h + lane] = (bf16)f2bf(o * sg);
        __builtin_amdgcn_s_waitcnt(0); __builtin_amdgcn_wave_barrier();
    }
}

__device__ __forceinline__ void ph_final(const Frame& F) {
    const int gw = F.bid * 8 + F.wave, NGW = F.G * 8, lane = F.lane;
    for (int m = gw; m < MQ; m += NGW) {
        const f32x4* xr = (const f32x4*)(F.x + (size_t)m * DM) + lane; const f32x4* zr = (const f32x4*)(F.Z + (size_t)m * DM) + lane;
        f32x4 v[4]; float s = 0.f;
#pragma unroll
        for (int j = 0; j < 4; ++j) { v[j] = xr[64 * j]; s += (v[j].x + v[j].y) + (v[j].z + v[j].w); }
        const float mean = wave_sum(s) * (1.f / DM); float s2 = 0.f;
#pragma unroll
        for (int j = 0; j < 4; ++j) { v[j] = v[j] - mean; s2 += (v[j].x * v[j].x + v[j].y * v[j].y) + (v[j].z * v[j].z + v[j].w * v[j].w); }
        const float rstd = 1.f / sqrtf(wave_sum(s2) * (1.f / DM) + LN_EPS);
        float t = 0.f;
#pragma unroll
        for (int j = 0; j < 4; ++j) {
            const f32x4 g = ((const f32x4*)F.lne_g)[lane + 64 * j], bb = ((const f32x4*)F.lne_b)[lane + 64 * j];
            v[j] = (v[j] * rstd * g + bb) * ALPHA + zr[64 * j];
            t += (v[j].x + v[j].y) + (v[j].z + v[j].w);
        }
        const float mean2 = wave_sum(t) * (1.f / DM); float t2 = 0.f;
#pragma unroll
        for (int j = 0; j < 4; ++j) { v[j] = v[j] - mean2; t2 += (v[j].x * v[j].x + v[j].y * v[j].y) + (v[j].z * v[j].z + v[j].w * v[j].w); }
        const float rstd2 = 1.f / sqrtf(wave_sum(t2) * (1.f / DM) + LN_EPS);
        f32x4* o = (f32x4*)(F.out + (size_t)m * DM) + lane;
#pragma unroll
        for (int j = 0; j < 4; ++j) {
            const f32x4 g = ((const f32x4*)F.lnp_g)[lane + 64 * j], bb = ((const f32x4*)F.lnp_b)[lane + 64 * j];
            o[64 * j] = v[j] * rstd2 * g + bb;
        }
    }
}

namespace pg8 {
#define PG8_LAS __attribute__((address_space(3)))
typedef unsigned short bf16_t;
typedef short bf16x8 __attribute__((ext_vector_type(8)));
typedef float f32x4 __attribute__((ext_vector_type(4)));
typedef unsigned u32x4 __attribute__((ext_vector_type(4)));
constexpr int BM = 256, BK = 64, HALF = 128, HTB = HALF * BK * 2  , STAGE_BYTES = 8 * HTB, NXCD = 8, WGM = 8;

__host__ __device__ __forceinline__ int lds_byte(int r, int c) { const int st = (r >> 4) * 2 + (c >> 5), rr = r & 15, cc = c & 31, ob = rr * 64 + cc * 2; return st * 1024 + (ob ^ (((ob >> 9) & 1) << 5)); }
__host__ __device__ __forceinline__ void stage_rc(int b, int& R, int& C) { const int st = b / 1024, sb = b % 1024, swz = sb ^ (((sb >> 9) & 1) << 5); R = (st >> 1) * 16 + swz / 64; C = (st & 1) * 32 + (swz % 64) / 2; }
__host__ __device__ __forceinline__ int perm32(int rho) { const int n = rho >> 4, i = rho & 15; return 8 * (i >> 2) + 4 * n + (i & 3); }

struct Unit { int pm, pn; };
struct Gemm { const bf16_t* A; const bf16_t* Bt; int M, N, K; };

struct StaticOrder {
    int nM, nN, nwg, G, c;
    __host__ __device__ void init(int M, int N, int G_, int c_) { nM = M / BM; nN = N / BM; nwg = nM * nN; G = G_; c = c_; }
    __host__ __device__ bool next(int i, Unit& u) const {
        const long L = (long)i * G + c; if (L >= nwg) return false;
        int wgid = (int)L; { const int q = nwg / NXCD, r = nwg % NXCD, xcd = wgid % NXCD, off = wgid / NXCD; wgid = (xcd < r ? xcd * (q + 1) : r * (q + 1) + (xcd - r) * q) + off; }
        const int nig = WGM * nN, gid = wgid / nig, fm = gid * WGM, gsz = (nM - fm) < WGM ? (nM - fm) : WGM;
        u.pm = fm + ((wgid % nig) % gsz); u.pn = (wgid % nig) / gsz; return true;
    }
    __device__ __forceinline__ void a_ready(const Unit&) const {}
    __device__ __forceinline__ void done(const Unit&) const {}
};

__device__ __forceinline__ unsigned cvt_pk_bf16(float lo, float hi) { unsigned r; asm volatile("v_cvt_pk_bf16_f32 %0, %1, %2" : "=v"(r) : "v"(lo), "v"(hi)); return r; }

struct EpiBf16 {
    static constexpr bool PERM = true, AFTER_DRAIN = false;
    bf16_t* O; int ldc;
    __device__ __forceinline__ void operator()(const f32x4 (&acc)[2][2][4][2], const Unit& u, int wr, int wc, int fr, int fq) const {
        const int row0 = u.pm * BM + wr * 64 + fr, col0 = u.pn * BM + wc * 32 + 8 * fq;
#pragma unroll
        for (int ai = 0; ai < 2; ++ai)
#pragma unroll
            for (int m = 0; m < 4; ++m) { bf16_t* rowp = O + (size_t)(row0 + ai * HALF + m * 16) * ldc + col0;
#pragma unroll
                for (int bj = 0; bj < 2; ++bj) { const f32x4 v0 = acc[ai][bj][m][0], v1 = acc[ai][bj][m][1];
                    u32x4 w; w.x = cvt_pk_bf16(v0[0], v0[1]); w.y = cvt_pk_bf16(v0[2], v0[3]); w.z = cvt_pk_bf16(v1[0], v1[1]); w.w = cvt_pk_bf16(v1[2], v1[3]);
                    *(u32x4*)(rowp + bj * HALF) = w; } }
    }
};
struct EpiF32 {
    static constexpr bool PERM = false, AFTER_DRAIN = false;
    float* C; int ldc; const float* bias;
    __device__ __forceinline__ void operator()(const f32x4 (&acc)[2][2][4][2], const Unit& u, int wr, int wc, int fr, int fq) const {
        const int row0 = u.pm * BM + wr * 64 + fr, col0 = u.pn * BM + wc * 32 + 4 * fq;
        f32x4 bv[2][2];
#pragma unroll
        for (int bj = 0; bj < 2; ++bj)
#pragma unroll
            for (int n = 0; n < 2; ++n) bv[bj][n] = bias ? *(const f32x4*)(bias + col0 + bj * HALF + n * 16) : (f32x4){0.f, 0.f, 0.f, 0.f};
#pragma unroll
        for (int ai = 0; ai < 2; ++ai)
#pragma unroll
            for (int m = 0; m < 4; ++m) { float* rowp = C + (size_t)(row0 + ai * HALF + m * 16) * ldc + col0;
#pragma unroll
                for (int bj = 0; bj < 2; ++bj)
#pragma unroll
                    for (int n = 0; n < 2; ++n) *(f32x4*)(rowp + bj * HALF + n * 16) = acc[ai][bj][m][n] + bv[bj][n]; }
    }
};
template <class Epi, class Sched, bool ALIGN_EPI = false, bool SP2 = false>
__device__ __forceinline__ void gemm_phase(PG8_LAS unsigned char* lds, const Gemm g, const Sched& S, const Epi& E) {
    const int tid = threadIdx.x, wid = __builtin_amdgcn_readfirstlane(tid >> 6), lane = tid & 63, wr = wid >> 2, wc = wid & 3, fr = lane & 15, fq = lane >> 4;
    const int K = g.K, nt = K / BK;
    unsigned voffA[2], voffB[2];
#pragma unroll
    for (int i = 0; i < 2; ++i) { int R, C; stage_rc(tid * 16 + i * 8192, R, C); const int Rb = Epi::PERM ? ((R & ~31) + perm32(R & 31)) : R;
        voffA[i] = (unsigned)(R * K + C) * 2u; voffB[i] = (unsigned)(Rb * K + C) * 2u; }
    const size_t kstep = (size_t)(BK * 2);
    const size_t hstep = (size_t)HALF * K * 2;
    const size_t tstep = 2 * hstep;
    const unsigned ldsw = (unsigned)wid * 1024u;
    const int aoff = lds_byte(wr * 64 + fr, fq * 8), boff = lds_byte(wc * 32 + fr, fq * 8);
#define PG8_SA(b, h) (((b) * 2 + (h)) * HTB)
#define PG8_SB(b, h) ((4 + (b) * 2 + (h)) * HTB)
#define PG8_STAGE(bufoff, gbase, voff) do { _Pragma("unroll") for (int _i = 0; _i < 2; ++_i) \
        __builtin_amdgcn_global_load_lds((const unsigned*)((const char*)(gbase) + (voff)[_i]), (PG8_LAS unsigned*)(lds + (bufoff) + ldsw + _i * 8192), 16, 0, 0); } while (0)
#define PG8_LDA(dst, b, h) do { _Pragma("unroll") for (int m = 0; m < 4; ++m) _Pragma("unroll") for (int k = 0; k < 2; ++k) dst[m][k] = *(const PG8_LAS bf16x8*)(lds + PG8_SA(b, h) + aoff + m * 2048 + k * 1024); } while (0)
#define PG8_LDB(dst, b, h) do { _Pragma("unroll") for (int n = 0; n < 2; ++n) _Pragma("unroll") for (int k = 0; k < 2; ++k) dst[n][k] = *(const PG8_LAS bf16x8*)(lds + PG8_SB(b, h) + boff + n * 2048 + k * 1024); } while (0)
#define PG8_MMA(ai, bj, At, Bt) do { __builtin_amdgcn_s_setprio(1); _Pragma("unroll") for (int m = 0; m < 4; ++m) _Pragma("unroll") for (int n = 0; n < 2; ++n) _Pragma("unroll") for (int k = 0; k < 2; ++k) \
        acc[ai][bj][m][n] = __builtin_amdgcn_mfma_f32_16x16x32_bf16(Bt[n][k], At[m][k], acc[ai][bj][m][n], 0, 0, 0); __builtin_amdgcn_s_setprio(0); } while (0)
#define PG8_WAIT_V(n) asm volatile("s_waitcnt vmcnt(" #n ")" ::: "memory")
#define PG8_WAIT_L(n) asm volatile("s_waitcnt lgkmcnt(" #n ")" ::: "memory")
#define PG8_BAR __builtin_amdgcn_s_barrier()
#define PG8_SCHED __builtin_amdgcn_sched_barrier(0)
    Unit cur, nxt; int ui = 0;
    if (!S.next(0, cur)) return;
    f32x4 acc[2][2][4][2];
#pragma unroll
    for (int a = 0; a < 2; ++a)
#pragma unroll
        for (int b = 0; b < 2; ++b)
#pragma unroll
            for (int m = 0; m < 4; ++m)
#pragma unroll
                for (int n = 0; n < 2; ++n) acc[a][b][m][n] = (f32x4){0.f, 0.f, 0.f, 0.f};
    bf16x8 At[4][2], B0[2][2], B1[2][2];
    const char* cA = (const char*)g.A + (size_t)cur.pm * tstep; const char* cB = (const char*)g.Bt + (size_t)cur.pn * tstep;
    S.a_ready(cur);
    if constexpr (SP2) {
        PG8_STAGE(PG8_SB(0, 0), cB, voffB); PG8_STAGE(PG8_SB(0, 1), cB + hstep, voffB); PG8_STAGE(PG8_SA(0, 0), cA, voffA); PG8_STAGE(PG8_SA(0, 1), cA + hstep, voffA);
        if (wr == 1) PG8_BAR;
        PG8_WAIT_V(2); PG8_BAR;
        PG8_STAGE(PG8_SB(1, 0), cB + kstep, voffB); PG8_STAGE(PG8_SA(1, 0), cA + kstep, voffA); PG8_STAGE(PG8_SB(1, 1), cB + hstep + kstep, voffB);
        PG8_WAIT_V(6); PG8_BAR;
    } else {
        PG8_STAGE(PG8_SB(0, 0), cB, voffB); PG8_STAGE(PG8_SA(0, 0), cA, voffA); PG8_STAGE(PG8_SB(0, 1), cB + hstep, voffB); PG8_STAGE(PG8_SA(0, 1), cA + hstep, voffA);
        if (wr == 1) PG8_BAR;
        PG8_WAIT_V(4); PG8_BAR;
        PG8_STAGE(PG8_SB(1, 0), cB + kstep, voffB); PG8_STAGE(PG8_SA(1, 0), cA + kstep, voffA); PG8_STAGE(PG8_SB(1, 1), cB + hstep + kstep, voffB);
        PG8_WAIT_V(6); PG8_BAR;
    }
    for (;;) {
        const bool has_next = S.next(ui + 1, nxt);
        const char* nA = has_next ? (const char*)g.A + (size_t)nxt.pm * tstep : cA; const char* nB = has_next ? (const char*)g.Bt + (size_t)nxt.pn * tstep : cB;
        for (int t = 0; t < nt; t += 2) {
            const bool last = (t == nt - 2);
            const char* a1 = cA + (size_t)(t + 1) * kstep;
            const char* a2 = last ? nA : cA + (size_t)(t + 2) * kstep; const char* b2 = last ? nB : cB + (size_t)(t + 2) * kstep;
            const char* a3 = a2 + kstep; const char* b3 = b2 + kstep;
            if (last && has_next) S.a_ready(nxt);
            if constexpr (SP2) {
            PG8_LDB(B0, 0, 0); PG8_LDB(B1, 0, 1); PG8_SCHED; PG8_LDA(At, 0, 0); PG8_STAGE(PG8_SA(1, 1), a1 + hstep, voffA);
            PG8_WAIT_V(8); PG8_WAIT_L(0); PG8_BAR; PG8_MMA(0, 0, At, B0); PG8_MMA(0, 1, At, B1); PG8_BAR; PG8_SCHED;
            PG8_LDA(At, 0, 1); PG8_STAGE(PG8_SB(0, 0), b2, voffB); PG8_STAGE(PG8_SB(0, 1), b2 + hstep, voffB); PG8_STAGE(PG8_SA(0, 0), a2, voffA);
            PG8_WAIT_V(8); PG8_WAIT_L(0); PG8_BAR; PG8_MMA(1, 0, At, B0); PG8_MMA(1, 1, At, B1); PG8_BAR; PG8_SCHED;
            PG8_LDB(B0, 1, 0); PG8_LDB(B1, 1, 1); PG8_SCHED; PG8_LDA(At, 1, 0); PG8_STAGE(PG8_SA(0, 1), a2 + hstep, voffA);
            PG8_WAIT_V(8); PG8_WAIT_L(0); PG8_BAR; PG8_MMA(0, 0, At, B0); PG8_MMA(0, 1, At, B1); PG8_BAR; PG8_SCHED;
            PG8_LDA(At, 1, 1); PG8_STAGE(PG8_SB(1, 0), b3, voffB); PG8_STAGE(PG8_SB(1, 1), b3 + hstep, voffB); PG8_STAGE(PG8_SA(1, 0), a3, voffA);
            PG8_WAIT_V(8); PG8_WAIT_L(0); PG8_BAR; PG8_MMA(1, 0, At, B0); PG8_MMA(1, 1, At, B1); PG8_BAR; PG8_SCHED;
            } else {
            PG8_LDB(B0, 0, 0); PG8_SCHED; PG8_LDA(At, 0, 0); PG8_STAGE(PG8_SA(1, 1), a1 + hstep, voffA);
            PG8_WAIT_L(8); PG8_BAR; PG8_WAIT_L(0); PG8_MMA(0, 0, At, B0); PG8_BAR; PG8_SCHED;
            PG8_LDB(B1, 0, 1); PG8_STAGE(PG8_SB(0, 0), b2, voffB);
            PG8_BAR; PG8_WAIT_L(0); PG8_MMA(0, 1, At, B1); PG8_BAR;
            PG8_LDA(At, 0, 1); PG8_STAGE(PG8_SA(0, 0), a2, voffA);
            PG8_BAR; PG8_WAIT_L(0); PG8_MMA(1, 0, At, B0); PG8_BAR; PG8_SCHED;
            PG8_STAGE(PG8_SB(0, 1), b2 + hstep, voffB);
            PG8_WAIT_V(6); PG8_BAR; PG8_MMA(1, 1, At, B1); PG8_BAR;
            PG8_LDB(B0, 1, 0); PG8_SCHED; PG8_LDA(At, 1, 0); PG8_STAGE(PG8_SA(0, 1), a2 + hstep, voffA);
            PG8_WAIT_L(8); PG8_BAR; PG8_WAIT_L(0); PG8_MMA(0, 0, At, B0); PG8_BAR; PG8_SCHED;
            PG8_LDB(B1, 1, 1); PG8_STAGE(PG8_SB(1, 0), b3, voffB);
            PG8_BAR; PG8_WAIT_L(0); PG8_MMA(0, 1, At, B1); PG8_BAR;
            PG8_LDA(At, 1, 1); PG8_STAGE(PG8_SA(1, 0), a3, voffA);
            PG8_BAR; PG8_WAIT_L(0); PG8_MMA(1, 0, At, B0); PG8_BAR; PG8_SCHED;
            PG8_STAGE(PG8_SB(1, 1), b3 + hstep, voffB);
            PG8_WAIT_V(6); PG8_BAR; PG8_MMA(1, 1, At, B1); PG8_BAR;
            }
        }
        if constexpr (ALIGN_EPI) { if (wr == 0) PG8_BAR; }
        if constexpr (!Epi::AFTER_DRAIN) { E(acc, cur, wr, wc, fr, fq); S.done(cur); }
        if (!has_next) break;
#pragma unroll
        for (int a = 0; a < 2; ++a)
#pragma unroll
            for (int b = 0; b < 2; ++b)
#pragma unroll
                for (int m = 0; m < 4; ++m)
#pragma unroll
                    for (int n = 0; n < 2; ++n) acc[a][b][m][n] = (f32x4){0.f, 0.f, 0.f, 0.f};
        cur = nxt; cA = nA; cB = nB; ++ui;
        if constexpr (ALIGN_EPI) { if (wr == 1) PG8_BAR; }
    }
    PG8_WAIT_V(0);
    if constexpr (!ALIGN_EPI) { if (wr == 0) PG8_BAR; }
    PG8_BAR;
    if constexpr (Epi::AFTER_DRAIN) { E.fused(acc, cur, wr, wc, fr, fq, lds, wid, lane); S.done(cur); }
#undef PG8_SA
#undef PG8_SB
#undef PG8_STAGE
#undef PG8_LDA
#undef PG8_LDB
#undef PG8_MMA
#undef PG8_WAIT_V
#undef PG8_WAIT_L
#undef PG8_BAR
#undef PG8_SCHED
}
}

namespace att {
#define ALAS __attribute__((address_space(3)))
typedef short bf16x8 __attribute__((ext_vector_type(8)));
typedef short s16x4 __attribute__((ext_vector_type(4)));
typedef float f32x16 __attribute__((ext_vector_type(16)));
typedef unsigned u32x4 __attribute__((ext_vector_type(4)));
constexpr int KSLOT = 12288, VSLOT = 8192, KOFF = 0, VOFF = 2 * KSLOT, TABOFF = VOFF + 2 * VSLOT, SCROFF = TABOFF + 512, ATT_LDS = SCROFF + 8 * 128;
constexpr float LOG2E = 1.4426950408889634f;
__device__ __forceinline__ s16x4 vtr(const ALAS unsigned char* p) { return __builtin_bit_cast(s16x4, __builtin_amdgcn_ds_read_tr16_b64_v4i16((ALAS s16x4*)p)); }
__device__ __forceinline__ void glds16(const void* g, ALAS unsigned char* l) { __builtin_amdgcn_global_load_lds((const unsigned*)g, (ALAS unsigned*)l, 16, 0, 0); }
__device__ __forceinline__ int crow(int r, int hi) { return (r & 3) + 8 * (r >> 2) + 4 * hi; }

template <int MIXER> __device__ __forceinline__ void attn_unit(const Frame& F, unsigned char* ldsg, int b, int h, int j, const float* inv_freq) {
    constexpr int DQK = MIXER == 0 ? 64 : 96, ND0 = DQK / 16;
    const int lane = F.lane, w = F.wave, r32 = lane & 31, hi = lane >> 5;
    ALAS unsigned char* lds = (ALAS unsigned char*)ldsg;
    const int NT = 4 * j + 5;
    const int p0q = NMETA + 256 * j + 32 * w, p = p0q + r32, Tmax = (p0q + 31) >> 6;
    const size_t rowb = (size_t)b * LP;
    const bf16* Vb = MIXER == 0 ? F.P + OFF_VA + 64 * h : F.QKVB + 768 + 128 * h + 64;
    const int vpitch = MIXER == 0 ? DINP : NMLA;
    const float cs = (MIXER == 0 ? 0.125f : 0.10206207261596577f) * LOG2E;
    ALAS float* tab = (ALAS float*)(lds + TABOFF); ALAS float* scr = (ALAS float*)(lds + SCROFF + w * 128);
    if (MIXER == 0 && F.tid < 128) tab[F.tid] = F.rel_bias[t5_bucket(F.tid) * 8 + h] * LOG2E;
    const float b31 = MIXER == 0 ? F.rel_bias[31 * 8 + h] * LOG2E : 0.f;
    const bf16* Kg = MIXER == 0 ? F.P + OFF_KA + 64 * h : F.QKVB + 768 + 128 * h;
    const unsigned kpitch = MIXER == 0 ? DINP : NMLA;
    const unsigned koff = (unsigned)(rowb + lane) * kpitch + 8u * w, peoff = (unsigned)(rowb + lane) * 32u + 8u * w;
    const unsigned voff = (unsigned)(rowb + 16 * (w & 3) + (lane >> 2)) * (unsigned)vpitch + (unsigned)((w >> 2) * 32 + (lane & 3) * 8);
#define ISSUE_TILE(T, slot) do { \
        glds16(Kg + (koff + (unsigned)(64 * (T)) * kpitch), lds + KOFF + (slot) * KSLOT + w * 1024); \
        if (MIXER == 1 && w < 4) glds16(F.KPER + (peoff + (unsigned)(64 * (T)) * 32u), lds + KOFF + (slot) * KSLOT + (8 + w) * 1024); \
        glds16(Vb + (voff + (unsigned)(64 * (T)) * (unsigned)vpitch), lds + VOFF + (slot) * VSLOT + w * 1024); } while (0)
    ISSUE_TILE(0, 0);
    bf16x8 qf[ND0];
    { const size_t qrow = rowb + p;
      const bf16* qp = MIXER == 0 ? F.P + qrow * DINP + OFF_QA + 64 * h : F.QKVB + qrow * NMLA + 96 * h;
#pragma unroll
      for (int d0 = 0; d0 < ND0; ++d0) qf[d0] = *(const bf16x8*)(qp + 16 * d0 + 8 * hi);
      if (MIXER == 1) {
        bf16x8 a = qf[4], c = qf[5];
#pragma unroll
        for (int jj = 0; jj < 8; ++jj) { const float x1 = bf2f((bf16)a[jj]), x2 = bf2f((bf16)c[jj]); const float ang = (float)p * inv_freq[8 * hi + jj]; const float co = cosf(ang), sn = sinf(ang);
            a[jj] = (short)f2bf(x1 * co - x2 * sn); c[jj] = (short)f2bf(x2 * co + x1 * sn); }
        qf[4] = a; qf[5] = c; } }
    const u64* bmrow = F.BM + ((size_t)b * SEQ + 256 * j + 32 * w + r32) * NW64;
    u64 mw_next = 0ull; if (MIXER == 0) mw_next = bmrow[0];
    f32x16 o0 = {}, o1 = {};
    float m = -1e30f, l = 0.f;
    for (int T = 0; T < NT; ++T) {
        const int slot = T & 1;
        asm volatile("s_waitcnt vmcnt(0)" ::: "memory");
        __syncthreads();
        const u64 mw = mw_next;
        if (T + 1 < NT) { ISSUE_TILE(T + 1, slot ^ 1); if (MIXER == 0 && T + 1 <= Tmax) mw_next = bmrow[T + 1]; }
        if (T <= Tmax) {
            f32x16 s0 = {}, s1 = {};
            const ALAS unsigned char* kp = lds + KOFF + slot * KSLOT + hi * 1024 + r32 * 16;
#pragma unroll
            for (int d0 = 0; d0 < ND0; ++d0) {
                const bf16x8 k0 = *(const ALAS bf16x8*)(kp + d0 * 2048), k1 = *(const ALAS bf16x8*)(kp + d0 * 2048 + 512);
                s0 = __builtin_amdgcn_mfma_f32_32x32x16_bf16(k0, qf[d0], s0, 0, 0, 0);
                s1 = __builtin_amdgcn_mfma_f32_32x32x16_bf16(k1, qf[d0], s1, 0, 0, 0);
            }
            const int dl = p - 64 * T - 4 * hi;
            const bool nearb = 64 * T + 63 > p0q - (MIXER == 0 ? 113 : 0);
            if (MIXER == 0) {
                const unsigned wl = (unsigned)mw >> (4 * hi), wh = (unsigned)(mw >> 32) >> (4 * hi);
                if (nearb) {
#pragma unroll
                    for (int r = 0; r < 16; ++r) { const int c = (r & 3) + 8 * (r >> 2);
                        const int i0 = min(max(dl - c, 0), 127), i1 = min(max(dl - c - 32, 0), 127);
                        s0[r] = ((wl >> c) & 1u) ? __builtin_fmaf(s0[r], cs, tab[i0]) : -INFINITY;
                        s1[r] = ((wh >> c) & 1u) ? __builtin_fmaf(s1[r], cs, tab[i1]) : -INFINITY; }
                } else {
#pragma unroll
                    for (int r = 0; r < 16; ++r) { const int c = (r & 3) + 8 * (r >> 2);
                        s0[r] = ((wl >> c) & 1u) ? __builtin_fmaf(s0[r], cs, b31) : -INFINITY;
                        s1[r] = ((wh >> c) & 1u) ? __builtin_fmaf(s1[r], cs, b31) : -INFINITY; }
                }
            } else {
                if (nearb) {
#pragma unroll
                    for (int r = 0; r < 16; ++r) { const int c = (r & 3) + 8 * (r >> 2);
                        s0[r] = (c > dl) ? -INFINITY : s0[r] * cs; s1[r] = (c + 32 > dl) ? -INFINITY : s1[r] * cs; }
                } else {
#pragma unroll
                    for (int r = 0; r < 16; ++r) { s0[r] *= cs; s1[r] *= cs; }
                }
            }
            float tmax = fmaxf(s0[0], s1[0]);
#pragma unroll
            for (int r = 1; r < 16; ++r) tmax = fmaxf(tmax, fmaxf(s0[r], s1[r]));
            tmax = fmaxf(tmax, __shfl_xor(tmax, 32));
            if (__any(tmax > m + 8.f)) {
                const float mn = fmaxf(m, tmax), al = __builtin_amdgcn_exp2f(m - mn);
                m = mn; l *= al;
                if (hi == 0) scr[r32] = al;
                asm volatile("s_waitcnt lgkmcnt(0)" ::: "memory");
#pragma unroll
                for (int r = 0; r < 16; ++r) { const float a = scr[crow(r, hi)]; o0[r] *= a; o1[r] *= a; }
            }
            float rs = 0.f;
#pragma unroll
            for (int r = 0; r < 16; ++r) { s0[r] = __builtin_amdgcn_exp2f(s0[r] - m); s1[r] = __builtin_amdgcn_exp2f(s1[r] - m); rs += s0[r] + s1[r]; }
            l += rs;
            bf16x8 pa[4];
#pragma unroll
            for (int ks = 0; ks < 4; ++ks) { u32x4 t;
#pragma unroll
                for (int i = 0; i < 4; ++i) { const float lo = (ks < 2) ? s0[8 * (ks & 1) + 2 * i] : s1[8 * (ks & 1) + 2 * i], hh = (ks < 2) ? s0[8 * (ks & 1) + 2 * i + 1] : s1[8 * (ks & 1) + 2 * i + 1]; t[i] = pg8::cvt_pk_bf16(lo, hh); }
                pa[ks] = __builtin_bit_cast(bf16x8, t); }
            const ALAS unsigned char* vb = lds + VOFF + slot * VSLOT + ((lane >> 4) & 1) * 32 + (lane & 3) * 8 + (4 * hi + ((lane & 15) >> 2)) * 64;
#pragma unroll
            for (int ks = 0; ks < 4; ++ks) {
                const s16x4 a0 = vtr(vb + ks * 1024), a1 = vtr(vb + ks * 1024 + 512), c0 = vtr(vb + 4096 + ks * 1024), c1 = vtr(vb + 4096 + ks * 1024 + 512);
                const bf16x8 v0 = (bf16x8){a0[0], a0[1], a0[2], a0[3], a1[0], a1[1], a1[2], a1[3]}, v1 = (bf16x8){c0[0], c0[1], c0[2], c0[3], c1[0], c1[1], c1[2], c1[3]};
                o0 = __builtin_amdgcn_mfma_f32_32x32x16_bf16(pa[ks], v0, o0, 0, 0, 0);
                o1 = __builtin_amdgcn_mfma_f32_32x32x16_bf16(pa[ks], v1, o1, 0, 0, 0);
            }
        }
    }
#undef ISSUE_TILE
    l += __shfl_xor(l, 32);
    if (hi == 0) scr[r32] = 1.f / l;
    asm volatile("s_waitcnt lgkmcnt(0)" ::: "memory");
    const int gcol = (MIXER == 0 ? OFF_GA : OFF_GB) + 64 * h + r32;
#pragma unroll
    for (int r = 0; r < 16; ++r) {
        const int q = crow(r, hi); const float rl = scr[q];
        const bf16* gp = F.P + (rowb + p0q + q) * DINP + gcol;
        const float g0 = bf2f(gp[0]), g1 = bf2f(gp[32]);
        const float y0 = o0[r] * rl * (g0 / (1.f + __expf(-g0))), y1 = o1[r] * rl * (g1 / (1.f + __expf(-g1)));
        bf16* op = F.MIX + ((size_t)b * SEQ + 256 * j + 32 * w + q) * DM + MIXER * 512 + 64 * h + r32;
        op[0] = (bf16)f2bf(y0); op[32] = (bf16)f2bf(y1);
        if ((r & 3) == 3) asm volatile("" ::: "memory");
    }
    asm volatile("s_waitcnt lgkmcnt(0)" ::: "memory");
    __syncthreads();
}
#undef ALAS
}

__device__ __forceinline__ void ph_attn_mfma(const Frame& F, unsigned char* lds, const float* inv_freq) {
    if (F.G == 256) {
        const int vcu = (F.bid % 8) * 32 + F.bid / 8, bh = vcu >> 3, s = vcu & 7, b = bh >> 3, h = bh & 7;
        for (int i = 0; i < 4; ++i) {
            const int j = i < 2 ? 15 - s : s;
            if ((i & 1) == 0) att::attn_unit<0>(F, lds, b, h, j, inv_freq); else att::attn_unit<1>(F, lds, b, h, j, inv_freq);
        }
    } else {
        for (int u = F.bid; u < 1024; u += F.G) {
            const int j = u & 15, h = (u >> 4) & 7, b = (u >> 7) & 3, mixer = u >> 9;
            if (mixer == 0) att::attn_unit<0>(F, lds, b, h, j, inv_freq); else att::attn_unit<1>(F, lds, b, h, j, inv_freq);
        }
    }
}

constexpr int LDS_BYTES = 155648;
__global__ void __launch_bounds__(512, 2) fwd(Args args) {
    extern __shared__ __attribute__((aligned(16))) unsigned char lds[];
    Frame F;
    F.tid = threadIdx.x; F.lane = F.tid & 63; F.wave = __builtin_amdgcn_readfirstlane(F.tid >> 6); F.G = gridDim.x; F.bid = blockIdx.x;
    F.x = args.in[0]; F.meta = args.in[1]; F.lne_g = args.in[2]; F.lne_b = args.in[3]; F.w_in = args.in[4]; F.w_uq = args.in[5]; F.qn_g = args.in[6];
    F.w_ukv = args.in[7]; F.kvn_g = args.in[8]; F.rel_bias = args.in[9]; F.w_out = args.in[10]; F.lnp_g = args.in[11]; F.lnp_b = args.in[12];
    F.out = args.out;
    unsigned char* ws = args.ws;
    F.Win_t = (bf16*)(ws + WS_WIN); F.Wmla_t = (bf16*)(ws + WS_WMLA); F.Wout_t = (bf16*)(ws + WS_WOUT); F.KPER = (bf16*)(ws + WS_KPER);
    F.BM = (u64*)(ws + WS_BM); F.CQKVN = (bf16*)(ws + WS_CQKVN); F.XN = (bf16*)(ws + WS_XN); F.MIX = (bf16*)(ws + WS_XN);
    F.QKVB = (bf16*)(ws + WS_QKVB); F.P = (bf16*)(ws + WS_P); F.Z = (float*)(ws + WS_P);
    const int lo = args.ph_lo, hi = args.ph_hi;
    cooperative_groups::grid_group grid = cooperative_groups::this_grid();
#define IN(k) (lo <= (k) && (k) < hi)
#define SEAM(k) do { if (IN(k) && IN((k) + 1)) grid.sync(); } while (0)
    if (IN(0)) ph_prologue(F, (float*)lds);
    SEAM(0);
    PG8_LAS unsigned char* ring = (PG8_LAS unsigned char*)lds;
    if (IN(1)) { pg8::Gemm g{F.XN, F.Win_t, MROWS, DINP, DM}; pg8::StaticOrder S; S.init(MROWS, DINP, F.G, F.bid); pg8::EpiBf16 E{F.P, DINP};
        pg8::gemm_phase<pg8::EpiBf16, pg8::StaticOrder, true, true>(ring, g, S, E); }
    SEAM(1);
    if (IN(2)) ph_rms(F, args.inv_freq);
    SEAM(2);
    if (IN(3)) { { pg8::Gemm g{F.CQKVN, F.Wmla_t, MROWS, NMLA, KMLA}; pg8::StaticOrder S; S.init(MROWS, NMLA, F.G, F.bid); pg8::EpiBf16 E{F.QKVB, NMLA};
        pg8::gemm_phase<pg8::EpiBf16, pg8::StaticOrder, true, true>(ring, g, S, E); }
        __syncthreads(); ph_index_naive(F, lds); }
    SEAM(3);
    if (IN(4)) ph_attn_mfma(F, lds, args.inv_freq);
    SEAM(4);
    if (IN(5)) { pg8::Gemm g{F.MIX, F.Wout_t, MQ, DM, DM}; pg8::StaticOrder S; S.init(MQ, DM, F.G, F.bid); pg8::EpiF32 E{F.Z, DM, nullptr};
        pg8::gemm_phase<pg8::EpiF32, pg8::StaticOrder, true, true>(ring, g, S, E); }
    SEAM(5);
    if (IN(6)) ph_final(F);
#undef IN
#undef SEAM
}

#ifndef MK_N_LAUNCHES
#define MK_N_LAUNCHES 1
#endif
extern "C" void kernel_launch(void* const* d_in, const int* in_sizes, int n_in, void* d_out, int out_size, void* d_ws, size_t ws_size, hipStream_t stream) {
    static int grid_blocks = 0;
    if (!grid_blocks) {
        if (n_in != 13 || out_size != MQ * DM || ws_size < WS_END) { fprintf(stderr, "kernel_launch: unexpected shapes (n_in %d out %d ws %zu)\n", n_in, out_size, ws_size); grid_blocks = -1; return; }
        if (hipFuncSetAttribute((const void*)fwd, hipFuncAttributeMaxDynamicSharedMemorySize, LDS_BYTES) != hipSuccess) { fprintf(stderr, "kernel_launch: hipFuncSetAttribute failed\n"); grid_blocks = -1; return; }
        int dev = 0, cus = 0, per_cu = 0;
        (void)hipGetDevice(&dev);
        (void)hipDeviceGetAttribute(&cus, hipDeviceAttributeMultiprocessorCount, dev);
        (void)hipOccupancyMaxActiveBlocksPerMultiprocessor(&per_cu, (const void*)fwd, 512, LDS_BYTES);
        if (per_cu < 1 || cus < 1) { fprintf(stderr, "kernel_launch: occupancy query says %d blocks/CU on %d CUs\n", per_cu, cus); grid_blocks = -1; return; }
        grid_blocks = cus;
    }
    if (grid_blocks < 0) return;
    Args a{};
    for (int i = 0; i < 13; ++i) a.in[i] = (const float*)d_in[i];
    a.out = (float*)d_out; a.ws = (unsigned char*)d_ws;
    for (int i = 0; i < 16; ++i) a.inv_freq[i] = (float)pow(10000.0, -(double)(2 * i) / 32.0);
    if (MK_N_LAUNCHES == 1) {
        a.ph_lo = 0; a.ph_hi = 7;
        void* kargs[] = {&a};
        hipError_t e = hipLaunchCooperativeKernel((const void*)fwd, dim3(grid_blocks), dim3(512), kargs, LDS_BYTES, stream);
        if (e != hipSuccess) fprintf(stderr, "kernel_launch: cooperative launch failed: %s (grid %d)\n", hipGetErrorString(e), grid_blocks);
    } else {
        for (int ph = 0; ph < 7; ++ph) {
            a.ph_lo = ph; a.ph_hi = ph + 1;
            hipLaunchKernelGGL(fwd, dim3(grid_blocks), dim3(512), LDS_BYTES, stream, a);
        }
    }
}
```

```cpp
#include <hip/hip_runtime.h>
#include <hip/hip_cooperative_groups.h>
#include <cstdio>
#include <cstdint>
#include <cmath>

constexpr int BATCH = 4, SEQ = 4096, DM = 1024, NMETA = 16;
constexpr int LTOK = NMETA + SEQ;
constexpr int LP = 4160;
constexpr int MROWS = BATCH * LP;
constexpr int MQ = BATCH * SEQ;
constexpr int DIN = 3560, DINP = 3584;
constexpr int OFF_QA = 0, OFF_KA = 512, OFF_VA = 1024, OFF_GA = 1536, OFF_QI = 2048, OFF_KI = 2560, OFF_WI = 2624,
              OFF_CQ = 2632, OFF_CKV = 2888, OFF_KPE = 3016, OFF_GB = 3048;
constexpr int KMLA = 384, NMLA = 1792;
constexpr int TOPK = 256, KSEL = TOPK - NMETA;
constexpr int NW64 = LP / 64;
constexpr float LN_EPS = 1e-5f, RMS_EPS = 1e-6f;
constexpr float ALPHA = 1.189207115002721f;

constexpr size_t MiB = 1u << 20;
constexpr size_t WS_CTL = 0;
constexpr size_t WS_WIN = 2 * MiB;
constexpr size_t WS_WMLA = 9 * MiB;
constexpr size_t WS_WOUT = 11 * MiB;
constexpr size_t WS_KPER = 13 * MiB;
constexpr size_t WS_BM = 15 * MiB;
constexpr size_t WS_CQKVN = 24 * MiB;
constexpr size_t WS_XN = 37 * MiB;
constexpr size_t WS_QKVB = 70 * MiB;
constexpr size_t WS_P = 127 * MiB;
constexpr size_t WS_END = 241 * MiB;

typedef unsigned short bf16;
typedef unsigned long long u64;
typedef unsigned v4u __attribute__((ext_vector_type(4)));
typedef float f32x4 __attribute__((ext_vector_type(4)));

__device__ __forceinline__ float bf2f(bf16 v) { return __uint_as_float((unsigned)v << 16); }
__device__ __forceinline__ unsigned f2bf(float f) { unsigned u = __float_as_uint(f); return (u + 0x7fffu + ((u >> 16) & 1u)) >> 16; }
__device__ __forceinline__ unsigned pk2(float lo, float hi) { return f2bf(lo) | (f2bf(hi) << 16); }
__device__ __forceinline__ float wave_sum(float v) {
#pragma unroll
    for (int o = 1; o < 64; o <<= 1) v += __shfl_xor(v, o);
    return v;
}
__device__ __forceinline__ float wave_max(float v) {
#pragma unroll
    for (int o = 1; o < 64; o <<= 1) v = fmaxf(v, __shfl_xor(v, o));
    return v;
}
__device__ __forceinline__ int wave_isum(int v) {
#pragma unroll
    for (int o = 1; o < 64; o <<= 1) v += __shfl_xor(v, o);
    return v;
}
__device__ __forceinline__ int t5_bucket(int d) {
    if (d < 16) return d < 0 ? 0 : d;
    return 16 + (d >= 19) + (d >= 21) + (d >= 24) + (d >= 27) + (d >= 31) + (d >= 35) + (d >= 40) + (d >= 46) + (d >= 52) + (d >= 59) + (d >= 67) + (d >= 77) + (d >= 87) + (d >= 99) + (d >= 113);
}
__device__ __forceinline__ unsigned fkey(float f) { unsigned u = __float_as_uint(f); return (u & 0x80000000u) ? ~u : (u | 0x80000000u); }

struct Args {
    const float* in[13];
    float* out;
    unsigned char* ws;
    float inv_freq[16];
    int ph_lo, ph_hi;
};

struct Frame {
    int tid, lane, wave, G, bid;
    const float *x, *meta, *lne_g, *lne_b, *w_in, *w_uq, *qn_g, *w_ukv, *kvn_g, *rel_bias, *w_out, *lnp_g, *lnp_b;
    float* out;
    bf16 *Win_t, *Wmla_t, *Wout_t, *KPER, *CQKVN, *XN, *MIX, *QKVB, *P;
    u64* BM;
    float* Z;
};

template <class F> __device__ __forceinline__ void transpose_tile(F src, bf16* dst, int ldk, int n0, int k0, float* scr, int tid) {
    const int ty = tid >> 6, tx = tid & 63;
#pragma unroll
    for (int i = 0; i < 8; ++i) { const int k = ty + 8 * i; scr[k * 65 + tx] = src(k0 + k, n0 + tx); }
    __syncthreads();
    const int nn = tid >> 3, kc = tid & 7;
    v4u o; o.x = pk2(scr[(8 * kc + 0) * 65 + nn], scr[(8 * kc + 1) * 65 + nn]); o.y = pk2(scr[(8 * kc + 2) * 65 + nn], scr[(8 * kc + 3) * 65 + nn]);
    o.z = pk2(scr[(8 * kc + 4) * 65 + nn], scr[(8 * kc + 5) * 65 + nn]); o.w = pk2(scr[(8 * kc + 6) * 65 + nn], scr[(8 * kc + 7) * 65 + nn]);
    *(v4u*)(dst + (size_t)(n0 + nn) * ldk + k0 + 8 * kc) = o;
    __syncthreads();
}
__device__ __forceinline__ void ph_prologue(const Frame& F, float* lds) {
    constexpr int I_IN = (DINP / 64) * (DM / 64), I_MLA = (NMLA / 64) * (KMLA / 64), I_OUT = (DM / 64) * (DM / 64);
    for (int it = F.bid; it < I_IN + I_MLA + I_OUT; it += F.G) {
        if (it < I_IN) {
            const int n0 = (it / (DM / 64)) * 64, k0 = (it % (DM / 64)) * 64; const float* w = F.w_in;
            transpose_tile([=](int k, int n) { return n < DIN ? w[(size_t)k * DIN + n] : 0.f; }, F.Win_t, DM, n0, k0, lds, F.tid);
        } else if (it < I_IN + I_MLA) {
            const int r = it - I_IN, n0 = (r / (KMLA / 64)) * 64, k0 = (r % (KMLA / 64)) * 64;
            const float *wq = F.w_uq, *wkv = F.w_ukv, *gq = F.qn_g, *gkv = F.kvn_g;
            transpose_tile([=](int k, int n) {
                if (n < 768) return k < 256 ? wq[(size_t)k * 768 + n] * gq[k] : 0.f;
                return k >= 256 ? wkv[(size_t)(k - 256) * 1024 + (n - 768)] * gkv[k - 256] : 0.f; }, F.Wmla_t, KMLA, n0, k0, lds, F.tid);
        } else {
            const int r = it - I_IN - I_MLA, n0 = (r / (DM / 64)) * 64, k0 = (r % (DM / 64)) * 64; const float* w = F.w_out;
            transpose_tile([=](int k, int n) { return w[(size_t)k * DM + n]; }, F.Wout_t, DM, n0, k0, lds, F.tid);
        }
    }
    const int gw = F.bid * 8 + F.wave, NGW = F.G * 8;
    for (int m = gw; m < MROWS; m += NGW) {
        const int b = m / LP, p = m % LP;
        unsigned long long* o8 = (unsigned long long*)(F.XN + (size_t)m * DM) + F.lane;
        if (p >= LTOK) {
#pragma unroll
            for (int j = 0; j < 4; ++j) o8[64 * j] = 0ull;
            continue;
        }
        const float* src = p < NMETA ? F.meta + (size_t)p * DM : F.x + ((size_t)b * SEQ + (p - NMETA)) * DM;
        const f32x4* xr = (const f32x4*)src + F.lane;
        f32x4 v[4]; float s = 0.f;
#pragma unroll
        for (int j = 0; j < 4; ++j) { v[j] = xr[64 * j]; s += (v[j].x + v[j].y) + (v[j].z + v[j].w); }
        const float mean = wave_sum(s) * (1.f / DM); float s2 = 0.f;
#pragma unroll
        for (int j = 0; j < 4; ++j) { v[j] = v[j] - mean; s2 += (v[j].x * v[j].x + v[j].y * v[j].y) + (v[j].z * v[j].z + v[j].w * v[j].w); }
        const float rstd = 1.f / sqrtf(wave_sum(s2) * (1.f / DM) + LN_EPS);
#pragma unroll
        for (int j = 0; j < 4; ++j) {
            const f32x4 g = ((const f32x4*)F.lne_g)[F.lane + 64 * j], bb = ((const f32x4*)F.lne_b)[F.lane + 64 * j];
            const f32x4 y = v[j] * rstd * g + bb;
            o8[64 * j] = (unsigned long long)pk2(y.x, y.y) | ((unsigned long long)pk2(y.z, y.w) << 32);
        }
    }
}

__device__ __forceinline__ void ph_gemm_naive(const Frame& F, const bf16* A, int lda, const bf16* Bt, int ldb, int M, int N, int K, bf16* Cb, float* Cf, int ldc) {
    const int tn = F.tid & 63, tm = F.tid >> 6;
    const int ntn = N / 64, ntm = M / 8; const long nt = (long)ntn * ntm;
    for (long t = F.bid; t < nt; t += F.G) {
        const int m = (int)(t / ntn) * 8 + tm, n = (int)(t % ntn) * 64 + tn;
        const v4u* a = (const v4u*)(A + (size_t)m * lda); const v4u* b = (const v4u*)(Bt + (size_t)n * ldb);
        float acc = 0.f;
        for (int k = 0; k < K / 8; ++k) {
            const v4u av = a[k], bv = b[k];
#pragma unroll
            for (int j = 0; j < 4; ++j) { acc += __uint_as_float(av[j] << 16) * __uint_as_float(bv[j] << 16); acc += __uint_as_float(av[j] & 0xffff0000u) * __uint_as_float(bv[j] & 0xffff0000u); }
        }
        if (Cb) Cb[(size_t)m * ldc + n] = (bf16)f2bf(acc); else Cf[(size_t)m * ldc + n] = acc;
    }
}

__device__ __forceinline__ void ph_rms(const Frame& F, const float* inv_freq) {
    const int gw = F.bid * 8 + F.wave, NGW = F.G * 8, lane = F.lane;
    for (int m = gw; m < MROWS; m += NGW) {
        const bf16* pr = F.P + (size_t)m * DINP; const int p = m % LP;
        const unsigned long long cq4 = *(const unsigned long long*)(pr + OFF_CQ + 4 * lane);
        const unsigned ckv2 = *(const unsigned*)(pr + OFF_CKV + 2 * lane);
        float c[4] = {bf2f((bf16)(cq4 & 0xffff)), bf2f((bf16)((cq4 >> 16) & 0xffff)), bf2f((bf16)((cq4 >> 32) & 0xffff)), bf2f((bf16)(cq4 >> 48))};
        float d[2] = {bf2f((bf16)(ckv2 & 0xffff)), bf2f((bf16)(ckv2 >> 16))};
        const float sq = wave_sum(c[0] * c[0] + c[1] * c[1] + c[2] * c[2] + c[3] * c[3]), skv = wave_sum(d[0] * d[0] + d[1] * d[1]);
        const float rq = 1.f / sqrtf(sq * (1.f / 256.f) + RMS_EPS), rkv = 1.f / sqrtf(skv * (1.f / 128.f) + RMS_EPS);
        bf16* o = F.CQKVN + (size_t)m * KMLA;
        *(unsigned long long*)(o + 4 * lane) = (unsigned long long)pk2(c[0] * rq, c[1] * rq) | ((unsigned long long)pk2(c[2] * rq, c[3] * rq) << 32);
        *(unsigned*)(o + 256 + 2 * lane) = pk2(d[0] * rkv, d[1] * rkv);
        if (lane < 16) {
            const float x1 = bf2f(pr[OFF_KPE + lane]), x2 = bf2f(pr[OFF_KPE + 16 + lane]);
            const float ang = (float)p * inv_freq[lane]; const float cs = cosf(ang), sn = sinf(ang);
            F.KPER[(size_t)m * 32 + lane] = (bf16)f2bf(x1 * cs - x2 * sn); F.KPER[(size_t)m * 32 + 16 + lane] = (bf16)f2bf(x2 * cs + x1 * sn);
        }
    }
}

__device__ __forceinline__ void ph_index_naive(const Frame& F, unsigned char* lds) {
    unsigned* ks = (unsigned*)(lds) + F.wave * (LP + 512); float* qs = (float*)(ks + LP);
    const int gw = F.bid * 8 + F.wave, NGW = F.G * 8, lane = F.lane;
    for (int qi = gw; qi < MQ; qi += NGW) {
        const int b = qi / SEQ, tq = qi % SEQ, p = NMETA + tq; const size_t qrow = (size_t)b * LP + p;
        const bf16* pr = F.P + qrow * DINP;
        for (int i = lane; i < 512; i += 64) qs[i] = bf2f(pr[OFF_QI + i]);
        float ch[8];
#pragma unroll
        for (int h = 0; h < 8; ++h) ch[h] = bf2f(pr[OFF_WI + h]) * 0.35355339059327373f;
        __builtin_amdgcn_s_waitcnt(0); __builtin_amdgcn_wave_barrier();
        const int nt = p / 64 + 1;
        for (int i = 0; i < NW64; ++i) {
            const int s = 64 * i + lane; unsigned key = 0u;
            if (i < nt && s >= NMETA && s <= p) {
                const v4u* kr = (const v4u*)(F.P + ((size_t)b * LP + s) * DINP + OFF_KI);
                float kf[64];
#pragma unroll
                for (int c = 0; c < 8; ++c) { const v4u v = kr[c];
#pragma unroll
                    for (int j = 0; j < 4; ++j) { kf[8 * c + 2 * j] = __uint_as_float(v[j] << 16); kf[8 * c + 2 * j + 1] = __uint_as_float(v[j] & 0xffff0000u); } }
                float sc = 0.f;
#pragma unroll
                for (int h = 0; h < 8; ++h) { float a = 0.f;
#pragma unroll
                    for (int d = 0; d < 64; ++d) a += qs[64 * h + d] * kf[d];
                    sc += fmaxf(a * 0.125f, 0.f) * ch[h]; }
                key = fkey(sc);
            }
            ks[s] = key;
        }
        __builtin_amdgcn_s_waitcnt(0); __builtin_amdgcn_wave_barrier();
        unsigned thr = 0u;
        for (int bit = 31; bit >= 0; --bit) {
            const unsigned cand = thr | (1u << bit); int c = 0;
            for (int i = 0; i < nt; ++i) c += (ks[64 * i + lane] >= cand) ? 1 : 0;
            c = wave_isum(c);
            if (c >= KSEL) thr = cand;
        }
        int sstar = LP;
        if (thr != 0u) {
            int cge = 0, cgt = 0;
            for (int i = 0; i < nt; ++i) { const unsigned k = ks[64 * i + lane]; cge += (k >= thr); cgt += (k > thr); }
            cge = wave_isum(cge); cgt = wave_isum(cgt);
            if (cge > KSEL) {
                const int need = KSEL - cgt; int lo = 0, hi = LP - 1;
                while (lo < hi) { const int mid = (lo + hi) >> 1; int c = 0;
                    for (int i = 0; i < nt; ++i) { const int s = 64 * i + lane; c += (ks[s] == thr && s <= mid); }
                    c = wave_isum(c); if (c >= need) hi = mid; else lo = mid + 1; }
                sstar = lo;
            }
        }
        const unsigned te = thr == 0u ? 1u : thr;
        u64* bm = F.BM + (size_t)qi * NW64;
        for (int i = 0; i < NW64; ++i) {
            const int s = 64 * i + lane; const unsigned k = ks[s];
            const bool sel = (s < NMETA) || (k >= te && (k > thr || s <= sstar));
            const u64 w = __ballot(sel);
            if (lane == 0) bm[i] = w;
        }
        __builtin_amdgcn_s_waitcnt(0); __builtin_amdgcn_wave_barrier();
    }
}

__device__ __forceinline__ void ph_attn_naive(const Frame& F, unsigned char* lds, const float* inv_freq) {
    float* sc = (float*)(lds) + F.wave * (LP + 96); float* qs = sc + LP;
    const int gw = F.bid * 8 + F.wave, NGW = F.G * 8, lane = F.lane;
    const int NTASK = 2 * BATCH * 8 * SEQ;
    for (int task = gw; task < NTASK; task += NGW) {
        const int tq = task % SEQ, h = (task / SEQ) % 8, b = (task / (SEQ * 8)) % BATCH, mixer = task / (SEQ * 8 * BATCH);
        const int p = NMETA + tq; const size_t qrow = (size_t)b * LP + p; const int nt = p / 64 + 1;
        float mx = -INFINITY;
        if (mixer == 0) {
            qs[lane] = bf2f(F.P[qrow * DINP + OFF_QA + 64 * h + lane]);
            __builtin_amdgcn_s_waitcnt(0); __builtin_amdgcn_wave_barrier();
            const u64* bm = F.BM + ((size_t)b * SEQ + tq) * NW64;
            for (int i = 0; i < nt; ++i) {
                const int s = 64 * i + lane; const u64 w = bm[i]; float v = -INFINITY;
                if ((w >> lane) & 1ull) {
                    const v4u* kr = (const v4u*)(F.P + ((size_t)b * LP + s) * DINP + OFF_KA + 64 * h); float a = 0.f;
#pragma unroll
                    for (int c = 0; c < 8; ++c) { const v4u kv = kr[c];
#pragma unroll
                        for (int j = 0; j < 4; ++j) { a += qs[8 * c + 2 * j] * __uint_as_float(kv[j] << 16); a += qs[8 * c + 2 * j + 1] * __uint_as_float(kv[j] & 0xffff0000u); } }
                    v = a * 0.125f + F.rel_bias[t5_bucket(p - s) * 8 + h];
                }
                sc[s] = v; mx = fmaxf(mx, v);
            }
        } else {
            for (int i = lane; i < 96; i += 64) qs[i] = bf2f(F.QKVB[qrow * NMLA + 96 * h + i]);
            __builtin_amdgcn_s_waitcnt(0); __builtin_amdgcn_wave_barrier();
            if (lane < 16) { const float x1 = qs[64 + lane], x2 = qs[80 + lane]; const float ang = (float)p * inv_freq[lane]; const float cs = cosf(ang), sn = sinf(ang);
                qs[64 + lane] = x1 * cs - x2 * sn; qs[80 + lane] = x2 * cs + x1 * sn; }
            __builtin_amdgcn_s_waitcnt(0); __builtin_amdgcn_wave_barrier();
            for (int i = 0; i < nt; ++i) {
                const int s = 64 * i + lane; float v = -INFINITY;
                if (s <= p) {
                    const size_t srow = (size_t)b * LP + s;
                    const v4u* kr = (const v4u*)(F.QKVB + srow * NMLA + 768 + 128 * h); const v4u* pe = (const v4u*)(F.KPER + srow * 32); float a = 0.f;
#pragma unroll
                    for (int c = 0; c < 12; ++c) { const v4u kv = c < 8 ? kr[c] : pe[c - 8];
#pragma unroll
                        for (int j = 0; j < 4; ++j) { a += qs[8 * c + 2 * j] * __uint_as_float(kv[j] << 16); a += qs[8 * c + 2 * j + 1] * __uint_as_float(kv[j] & 0xffff0000u); } }
                    v = a * 0.10206207261596577f;
                }
                sc[s] = v; mx = fmaxf(mx, v);
            }
        }
        mx = wave_max(mx);
        float sum = 0.f;
        for (int i = 0; i < nt; ++i) { const int s = 64 * i + lane; const float e = __expf(sc[s] - mx); sc[s] = e; sum += e; }
        sum = wave_sum(sum);
        __builtin_amdgcn_s_waitcnt(0); __builtin_amdgcn_wave_barrier();
        float o = 0.f;
        const bf16* vb = mixer == 0 ? F.P + (size_t)b * LP * DINP + OFF_VA + 64 * h + lane : F.QKVB + (size_t)b * LP * NMLA + 768 + 128 * h + 64 + lane;
        const size_t vp = mixer == 0 ? DINP : NMLA;
        if (mixer == 0) {
            const u64* bm = F.BM + ((size_t)b * SEQ + tq) * NW64;
            for (int i = 0; i < nt; ++i) {
                const u64 wl = bm[i];
                unsigned wlo = __builtin_amdgcn_readfirstlane((unsigned)wl), whi = __builtin_amdgcn_readfirstlane((unsigned)(wl >> 32));
                while (wlo) { const int j = __builtin_ctz(wlo); wlo &= wlo - 1u; const int s = 64 * i + j; o += sc[s] * bf2f(vb[(size_t)s * vp]); }
                while (whi) { const int j = __builtin_ctz(whi); whi &= whi - 1u; const int s = 64 * i + 32 + j; o += sc[s] * bf2f(vb[(size_t)s * vp]); }
            }
        } else {
            for (int s = 0; s < 64 * nt; s += 8) {
#pragma unroll
                for (int j = 0; j < 8; ++j) o += sc[s + j] * bf2f(vb[(size_t)(s + j) * vp]);
            }
        }
        o /= sum;
        const float g = bf2f(F.P[qrow * DINP + (mixer == 0 ? OFF_GA : OFF_GB) + 64 * h + lane]);
        const float sg = g / (1.f + __expf(-g));
        F.MIX[((size_t)b * SEQ + tq) * DM + mixer * 512 + 64 * h + lane] = (bf16)f2bf(o * sg);
        __builtin_amdgcn_s_waitcnt(0); __builtin_amdgcn_wave_barrier();
    }
}

__device__ __forceinline__ void ph_final(const Frame& F) {
    const int gw = F.bid * 8 + F.wave, NGW = F.G * 8, lane = F.lane;
    for (int m = gw; m < MQ; m += NGW) {
        const f32x4* xr = (const f32x4*)(F.x + (size_t)m * DM) + lane; const f32x4* zr = (const f32x4*)(F.Z + (size_t)m * DM) + lane;
        f32x4 v[4]; float s = 0.f;
#pragma unroll
        for (int j = 0; j < 4; ++j) { v[j] = xr[64 * j]; s += (v[j].x + v[j].y) + (v[j].z + v[j].w); }
        const float mean = wave_sum(s) * (1.f / DM); float s2 = 0.f;
#pragma unroll
        for (int j = 0; j < 4; ++j) { v[j] = v[j] - mean; s2 += (v[j].x * v[j].x + v[j].y * v[j].y) + (v[j].z * v[j].z + v[j].w * v[j].w); }
        const float rstd = 1.f / sqrtf(wave_sum(s2) * (1.f / DM) + LN_EPS);
        float t = 0.f;
#pragma unroll
        for (int j = 0; j < 4; ++j) {
            const f32x4 g = ((const f32x4*)F.lne_g)[lane + 64 * j], bb = ((const f32x4*)F.lne_b)[lane + 64 * j];
            v[j] = (v[j] * rstd * g + bb) * ALPHA + zr[64 * j];
            t += (v[j].x + v[j].y) + (v[j].z + v[j].w);
        }
        const float mean2 = wave_sum(t) * (1.f / DM); float t2 = 0.f;
#pragma unroll
        for (int j = 0; j < 4; ++j) { v[j] = v[j] - mean2; t2 += (v[j].x * v[j].x + v[j].y * v[j].y) + (v[j].z * v[j].z + v[j].w * v[j].w); }
        const float rstd2 = 1.f / sqrtf(wave_sum(t2) * (1.f / DM) + LN_EPS);
        f32x4* o = (f32x4*)(F.out + (size_t)m * DM) + lane;
#pragma unroll
        for (int j = 0; j < 4; ++j) {
            const f32x4 g = ((const f32x4*)F.lnp_g)[lane + 64 * j], bb = ((const f32x4*)F.lnp_b)[lane + 64 * j];
            o[64 * j] = v[j] * rstd2 * g + bb;
        }
    }
}

namespace pg8 {
#define PG8_LAS __attribute__((address_space(3)))
typedef unsigned short bf16_t;
typedef short bf16x8 __attribute__((ext_vector_type(8)));
typedef float f32x4 __attribute__((ext_vector_type(4)));
typedef unsigned u32x4 __attribute__((ext_vector_type(4)));
constexpr int BM = 256, BK = 64, HALF = 128, HTB = HALF * BK * 2  , STAGE_BYTES = 8 * HTB, NXCD = 8, WGM = 8;

__host__ __device__ __forceinline__ int lds_byte(int r, int c) { const int st = (r >> 4) * 2 + (c >> 5), rr = r & 15, cc = c & 31, ob = rr * 64 + cc * 2; return st * 1024 + (ob ^ (((ob >> 9) & 1) << 5)); }
__host__ __device__ __forceinline__ void stage_rc(int b, int& R, int& C) { const int st = b / 1024, sb = b % 1024, swz = sb ^ (((sb >> 9) & 1) << 5); R = (st >> 1) * 16 + swz / 64; C = (st & 1) * 32 + (swz % 64) / 2; }
__host__ __device__ __forceinline__ int perm32(int rho) { const int n = rho >> 4, i = rho & 15; return 8 * (i >> 2) + 4 * n + (i & 3); }

struct Unit { int pm, pn; };
struct Gemm { const bf16_t* A; const bf16_t* Bt; int M, N, K; };

struct StaticOrder {
    int nM, nN, nwg, G, c;
    __host__ __device__ void init(int M, int N, int G_, int c_) { nM = M / BM; nN = N / BM; nwg = nM * nN; G = G_; c = c_; }
    __host__ __device__ bool next(int i, Unit& u) const {
        const long L = (long)i * G + c; if (L >= nwg) return false;
        int wgid = (int)L; { const int q = nwg / NXCD, r = nwg % NXCD, xcd = wgid % NXCD, off = wgid / NXCD; wgid = (xcd < r ? xcd * (q + 1) : r * (q + 1) + (xcd - r) * q) + off; }
        const int nig = WGM * nN, gid = wgid / nig, fm = gid * WGM, gsz = (nM - fm) < WGM ? (nM - fm) : WGM;
        u.pm = fm + ((wgid % nig) % gsz); u.pn = (wgid % nig) / gsz; return true;
    }
    __device__ __forceinline__ void a_ready(const Unit&) const {}
    __device__ __forceinline__ void done(const Unit&) const {}
};

__device__ __forceinline__ unsigned cvt_pk_bf16(float lo, float hi) { unsigned r; asm volatile("v_cvt_pk_bf16_f32 %0, %1, %2" : "=v"(r) : "v"(lo), "v"(hi)); return r; }

struct EpiBf16 {
    static constexpr bool PERM = true, AFTER_DRAIN = false;
    bf16_t* O; int ldc;
    __device__ __forceinline__ void operator()(const f32x4 (&acc)[2][2][4][2], const Unit& u, int wr, int wc, int fr, int fq) const {
        const int row0 = u.pm * BM + wr * 64 + fr, col0 = u.pn * BM + wc * 32 + 8 * fq;
#pragma unroll
        for (int ai = 0; ai < 2; ++ai)
#pragma unroll
            for (int m = 0; m < 4; ++m) { bf16_t* rowp = O + (size_t)(row0 + ai * HALF + m * 16) * ldc + col0;
#pragma unroll
                for (int bj = 0; bj < 2; ++bj) { const f32x4 v0 = acc[ai][bj][m][0], v1 = acc[ai][bj][m][1];
                    u32x4 w; w.x = cvt_pk_bf16(v0[0], v0[1]); w.y = cvt_pk_bf16(v0[2], v0[3]); w.z = cvt_pk_bf16(v1[0], v1[1]); w.w = cvt_pk_bf16(v1[2], v1[3]);
                    *(u32x4*)(rowp + bj * HALF) = w; } }
    }
};
struct EpiF32 {
    static constexpr bool PERM = false, AFTER_DRAIN = false;
    float* C; int ldc; const float* bias;
    __device__ __forceinline__ void operator()(const f32x4 (&acc)[2][2][4][2], const Unit& u, int wr, int wc, int fr, int fq) const {
        const int row0 = u.pm * BM + wr * 64 + fr, col0 = u.pn * BM + wc * 32 + 4 * fq;
        f32x4 bv[2][2];
#pragma unroll
        for (int bj = 0; bj < 2; ++bj)
#pragma unroll
            for (int n = 0; n < 2; ++n) bv[bj][n] = bias ? *(const f32x4*)(bias + col0 + bj * HALF + n * 16) : (f32x4){0.f, 0.f, 0.f, 0.f};
#pragma unroll
        for (int ai = 0; ai < 2; ++ai)
#pragma unroll
            for (int m = 0; m < 4; ++m) { float* rowp = C + (size_t)(row0 + ai * HALF + m * 16) * ldc + col0;
#pragma unroll
                for (int bj = 0; bj < 2; ++bj)
#pragma unroll
                    for (int n = 0; n < 2; ++n) *(f32x4*)(rowp + bj * HALF + n * 16) = acc[ai][bj][m][n] + bv[bj][n]; }
    }
};
template <class Epi, class Sched, bool ALIGN_EPI = false, bool SP2 = false>
__device__ __forceinline__ void gemm_phase(PG8_LAS unsigned char* lds, const Gemm g, const Sched& S, const Epi& E) {
    const int tid = threadIdx.x, wid = __builtin_amdgcn_readfirstlane(tid >> 6), lane = tid & 63, wr = wid >> 2, wc = wid & 3, fr = lane & 15, fq = lane >> 4;
    const int K = g.K, nt = K / BK;
    unsigned voffA[2], voffB[2];
#pragma unroll
    for (int i = 0; i < 2; ++i) { int R, C; stage_rc(tid * 16 + i * 8192, R, C); const int Rb = Epi::PERM ? ((R & ~31) + perm32(R & 31)) : R;
        voffA[i] = (unsigned)(R * K + C) * 2u; voffB[i] = (unsigned)(Rb * K + C) * 2u; }
    const size_t kstep = (size_t)(BK * 2);
    const size_t hstep = (size_t)HALF * K * 2;
    const size_t tstep = 2 * hstep;
    const unsigned ldsw = (unsigned)wid * 1024u;
    const int aoff = lds_byte(wr * 64 + fr, fq * 8), boff = lds_byte(wc * 32 + fr, fq * 8);
#define PG8_SA(b, h) (((b) * 2 + (h)) * HTB)
#define PG8_SB(b, h) ((4 + (b) * 2 + (h)) * HTB)
#define PG8_STAGE(bufoff, gbase, voff) do { _Pragma("unroll") for (int _i = 0; _i < 2; ++_i) \
        __builtin_amdgcn_global_load_lds((const unsigned*)((const char*)(gbase) + (voff)[_i]), (PG8_LAS unsigned*)(lds + (bufoff) + ldsw + _i * 8192), 16, 0, 0); } while (0)
#define PG8_LDA(dst, b, h) do { _Pragma("unroll") for (int m = 0; m < 4; ++m) _Pragma("unroll") for (int k = 0; k < 2; ++k) dst[m][k] = *(const PG8_LAS bf16x8*)(lds + PG8_SA(b, h) + aoff + m * 2048 + k * 1024); } while (0)
#define PG8_LDB(dst, b, h) do { _Pragma("unroll") for (int n = 0; n < 2; ++n) _Pragma("unroll") for (int k = 0; k < 2; ++k) dst[n][k] = *(const PG8_LAS bf16x8*)(lds + PG8_SB(b, h) + boff + n * 2048 + k * 1024); } while (0)
#define PG8_MMA(ai, bj, At, Bt) do { __builtin_amdgcn_s_setprio(1); _Pragma("unroll") for (int m = 0; m < 4; ++m) _Pragma("unroll") for (int n = 0; n < 2; ++n) _Pragma("unroll") for (int k = 0; k < 2; ++k) \
        acc[ai][bj][m][n] = __builtin_amdgcn_mfma_f32_16x16x32_bf16(Bt[n][k], At[m][k], acc[ai][bj][m][n], 0, 0, 0); __builtin_amdgcn_s_setprio(0); } while (0)
#define PG8_WAIT_V(n) asm volatile("s_waitcnt vmcnt(" #n ")" ::: "memory")
#define PG8_WAIT_L(n) asm volatile("s_waitcnt lgkmcnt(" #n ")" ::: "memory")
#define PG8_BAR __builtin_amdgcn_s_barrier()
#define PG8_SCHED __builtin_amdgcn_sched_barrier(0)
    Unit cur, nxt; int ui = 0;
    if (!S.next(0, cur)) return;
    f32x4 acc[2][2][4][2];
#pragma unroll
    for (int a = 0; a < 2; ++a)
#pragma unroll
        for (int b = 0; b < 2; ++b)
#pragma unroll
            for (int m = 0; m < 4; ++m)
#pragma unroll
                for (int n = 0; n < 2; ++n) acc[a][b][m][n] = (f32x4){0.f, 0.f, 0.f, 0.f};
    bf16x8 At[4][2], B0[2][2], B1[2][2];
    const char* cA = (const char*)g.A + (size_t)cur.pm * tstep; const char* cB = (const char*)g.Bt + (size_t)cur.pn * tstep;
    S.a_ready(cur);
    if constexpr (SP2) {
        PG8_STAGE(PG8_SB(0, 0), cB, voffB); PG8_STAGE(PG8_SB(0, 1), cB + hstep, voffB); PG8_STAGE(PG8_SA(0, 0), cA, voffA); PG8_STAGE(PG8_SA(0, 1), cA + hstep, voffA);
        if (wr == 1) PG8_BAR;
        PG8_WAIT_V(2); PG8_BAR;
        PG8_STAGE(PG8_SB(1, 0), cB + kstep, voffB); PG8_STAGE(PG8_SA(1, 0), cA + kstep, voffA); PG8_STAGE(PG8_SB(1, 1), cB + hstep + kstep, voffB);
        PG8_WAIT_V(6); PG8_BAR;
    } else {
        PG8_STAGE(PG8_SB(0, 0), cB, voffB); PG8_STAGE(PG8_SA(0, 0), cA, voffA); PG8_STAGE(PG8_SB(0, 1), cB + hstep, voffB); PG8_STAGE(PG8_SA(0, 1), cA + hstep, voffA);
        if (wr == 1) PG8_BAR;
        PG8_WAIT_V(4); PG8_BAR;
        PG8_STAGE(PG8_SB(1, 0), cB + kstep, voffB); PG8_STAGE(PG8_SA(1, 0), cA + kstep, voffA); PG8_STAGE(PG8_SB(1, 1), cB + hstep + kstep, voffB);
        PG8_WAIT_V(6); PG8_BAR;
    }
    for (;;) {
        const bool has_next = S.next(ui + 1, nxt);
        const char* nA = has_next ? (const char*)g.A + (size_t)nxt.pm * tstep : cA; const char* nB = has_next ? (const char*)g.Bt + (size_t)nxt.pn * tstep : cB;
        for (int t = 0; t < nt; t += 2) {
            const bool last = (t == nt - 2);
            const char* a1 = cA + (size_t)(t + 1) * kstep;
            const char* a2 = last ? nA : cA + (size_t)(t + 2) * kstep; const char* b2 = last ? nB : cB + (size_t)(t + 2) * kstep;
            const char* a3 = a2 + kstep; const char* b3 = b2 + kstep;
            if (last && has_next) S.a_ready(nxt);
            if constexpr (SP2) {
            PG8_LDB(B0, 0, 0); PG8_LDB(B1, 0, 1); PG8_SCHED; PG8_LDA(At, 0, 0); PG8_STAGE(PG8_SA(1, 1), a1 + hstep, voffA);
            PG8_WAIT_V(8); PG8_WAIT_L(0); PG8_BAR; PG8_MMA(0, 0, At, B0); PG8_MMA(0, 1, At, B1); PG8_BAR; PG8_SCHED;
            PG8_LDA(At, 0, 1); PG8_STAGE(PG8_SB(0, 0), b2, voffB); PG8_STAGE(PG8_SB(0, 1), b2 + hstep, voffB); PG8_STAGE(PG8_SA(0, 0), a2, voffA);
            PG8_WAIT_V(8); PG8_WAIT_L(0); PG8_BAR; PG8_MMA(1, 0, At, B0); PG8_MMA(1, 1, At, B1); PG8_BAR; PG8_SCHED;
            PG8_LDB(B0, 1, 0); PG8_LDB(B1, 1, 1); PG8_SCHED; PG8_LDA(At, 1, 0); PG8_STAGE(PG8_SA(0, 1), a2 + hstep, voffA);
            PG8_WAIT_V(8); PG8_WAIT_L(0); PG8_BAR; PG8_MMA(0, 0, At, B0); PG8_MMA(0, 1, At, B1); PG8_BAR; PG8_SCHED;
            PG8_LDA(At, 1, 1); PG8_STAGE(PG8_SB(1, 0), b3, voffB); PG8_STAGE(PG8_SB(1, 1), b3 + hstep, voffB); PG8_STAGE(PG8_SA(1, 0), a3, voffA);
            PG8_WAIT_V(8); PG8_WAIT_L(0); PG8_BAR; PG8_MMA(1, 0, At, B0); PG8_MMA(1, 1, At, B1); PG8_BAR; PG8_SCHED;
            } else {
            PG8_LDB(B0, 0, 0); PG8_SCHED; PG8_LDA(At, 0, 0); PG8_STAGE(PG8_SA(1, 1), a1 + hstep, voffA);
            PG8_WAIT_L(8); PG8_BAR; PG8_WAIT_L(0); PG8_MMA(0, 0, At, B0); PG8_BAR; PG8_SCHED;
            PG8_LDB(B1, 0, 1); PG8_STAGE(PG8_SB(0, 0), b2, voffB);
            PG8_BAR; PG8_WAIT_L(0); PG8_MMA(0, 1, At, B1); PG8_BAR;
            PG8_LDA(At, 0, 1); PG8_STAGE(PG8_SA(0, 0), a2, voffA);
            PG8_BAR; PG8_WAIT_L(0); PG8_MMA(1, 0, At, B0); PG8_BAR; PG8_SCHED;
            PG8_STAGE(PG8_SB(0, 1), b2 + hstep, voffB);
            PG8_WAIT_V(6); PG8_BAR; PG8_MMA(1, 1, At, B1); PG8_BAR;
            PG8_LDB(B0, 1, 0); PG8_SCHED; PG8_LDA(At, 1, 0); PG8_STAGE(PG8_SA(0, 1), a2 + hstep, voffA);
            PG8_WAIT_L(8); PG8_BAR; PG8_WAIT_L(0); PG8_MMA(0, 0, At, B0); PG8_BAR; PG8_SCHED;
            PG8_LDB(B1, 1, 1); PG8_STAGE(PG8_SB(1, 0), b3, voffB);
            PG8_BAR; PG8_WAIT_L(0); PG8_MMA(0, 1, At, B1); PG8_BAR;
            PG8_LDA(At, 1, 1); PG8_STAGE(PG8_SA(1, 0), a3, voffA);
            PG8_BAR; PG8_WAIT_L(0); PG8_MMA(1, 0, At, B0); PG8_BAR; PG8_SCHED;
            PG8_STAGE(PG8_SB(1, 1), b3 + hstep, voffB);
            PG8_WAIT_V(6); PG8_BAR; PG8_MMA(1, 1, At, B1); PG8_BAR;
            }
        }
        if constexpr (ALIGN_EPI) { if (wr == 0) PG8_BAR; }
        if constexpr (!Epi::AFTER_DRAIN) { E(acc, cur, wr, wc, fr, fq); S.done(cur); }
        if (!has_next) break;
#pragma unroll
        for (int a = 0; a < 2; ++a)
#pragma unroll
            for (int b = 0; b < 2; ++b)
#pragma unroll
                for (int m = 0; m < 4; ++m)
#pragma unroll
                    for (int n = 0; n < 2; ++n) acc[a][b][m][n] = (f32x4){0.f, 0.f, 0.f, 0.f};
        cur = nxt; cA = nA; cB = nB; ++ui;
        if constexpr (ALIGN_EPI) { if (wr == 1) PG8_BAR; }
    }
    PG8_WAIT_V(0);
    if constexpr (!ALIGN_EPI) { if (wr == 0) PG8_BAR; }
    PG8_BAR;
    if constexpr (Epi::AFTER_DRAIN) { E.fused(acc, cur, wr, wc, fr, fq, lds, wid, lane); S.done(cur); }
#undef PG8_SA
#undef PG8_SB
#undef PG8_STAGE
#undef PG8_LDA
#undef PG8_LDB
#undef PG8_MMA
#undef PG8_WAIT_V
#undef PG8_WAIT_L
#undef PG8_BAR
#undef PG8_SCHED
}
}

namespace att {
#define ALAS __attribute__((address_space(3)))
typedef short bf16x8 __attribute__((ext_vector_type(8)));
typedef short s16x4 __attribute__((ext_vector_type(4)));
typedef float f32x16 __attribute__((ext_vector_type(16)));
typedef unsigned u32x4 __attribute__((ext_vector_type(4)));
constexpr int KSLOT = 12288, VSLOT = 8192, KOFF = 0, VOFF = 2 * KSLOT, TABOFF = VOFF + 2 * VSLOT, SCROFF = TABOFF + 512, ATT_LDS = SCROFF + 8 * 128;
constexpr float LOG2E = 1.4426950408889634f;
__device__ __forceinline__ s16x4 vtr(const ALAS unsigned char* p) { return __builtin_bit_cast(s16x4, __builtin_amdgcn_ds_read_tr16_b64_v4i16((ALAS s16x4*)p)); }
__device__ __forceinline__ void glds16(const void* g, ALAS unsigned char* l) { __builtin_amdgcn_global_load_lds((const unsigned*)g, (ALAS unsigned*)l, 16, 0, 0); }
__device__ __forceinline__ int crow(int r, int hi) { return (r & 3) + 8 * (r >> 2) + 4 * hi; }

template <int MIXER> __device__ __forceinline__ void attn_unit(const Frame& F, unsigned char* ldsg, int b, int h, int j, const float* inv_freq) {
    constexpr int DQK = MIXER == 0 ? 64 : 96, ND0 = DQK / 16;
    const int lane = F.lane, w = F.wave, r32 = lane & 31, hi = lane >> 5;
    ALAS unsigned char* lds = (ALAS unsigned char*)ldsg;
    const int NT = 4 * j + 5;
    const int p0q = NMETA + 256 * j + 32 * w, p = p0q + r32, Tmax = (p0q + 31) >> 6;
    const size_t rowb = (size_t)b * LP;
    const bf16* Vb = MIXER == 0 ? F.P + OFF_VA + 64 * h : F.QKVB + 768 + 128 * h + 64;
    const int vpitch = MIXER == 0 ? DINP : NMLA;
    const float cs = (MIXER == 0 ? 0.125f : 0.10206207261596577f) * LOG2E;
    ALAS float* tab = (ALAS float*)(lds + TABOFF); ALAS float* scr = (ALAS float*)(lds + SCROFF + w * 128);
    if (MIXER == 0 && F.tid < 128) tab[F.tid] = F.rel_bias[t5_bucket(F.tid) * 8 + h] * LOG2E;
    const float b31 = MIXER == 0 ? F.rel_bias[31 * 8 + h] * LOG2E : 0.f;
    const bf16* Kg = MIXER == 0 ? F.P + OFF_KA + 64 * h : F.QKVB + 768 + 128 * h;
    const unsigned kpitch = MIXER == 0 ? DINP : NMLA;
    const unsigned koff = (unsigned)(rowb + lane) * kpitch + 8u * w, peoff = (unsigned)(rowb + lane) * 32u + 8u * w;
    const unsigned voff = (unsigned)(rowb + 16 * (w & 3) + (lane >> 2)) * (unsigned)vpitch + (unsigned)((w >> 2) * 32 + (lane & 3) * 8);
#define ISSUE_TILE(T, slot) do { \
        glds16(Kg + (koff + (unsigned)(64 * (T)) * kpitch), lds + KOFF + (slot) * KSLOT + w * 1024); \
        if (MIXER == 1 && w < 4) glds16(F.KPER + (peoff + (unsigned)(64 * (T)) * 32u), lds + KOFF + (slot) * KSLOT + (8 + w) * 1024); \
        glds16(Vb + (voff + (unsigned)(64 * (T)) * (unsigned)vpitch), lds + VOFF + (slot) * VSLOT + w * 1024); } while (0)
    ISSUE_TILE(0, 0);
    bf16x8 qf[ND0];
    { const size_t qrow = rowb + p;
      const bf16* qp = MIXER == 0 ? F.P + qrow * DINP + OFF_QA + 64 * h : F.QKVB + qrow * NMLA + 96 * h;
#pragma unroll
      for (int d0 = 0; d0 < ND0; ++d0) qf[d0] = *(const bf16x8*)(qp + 16 * d0 + 8 * hi);
      if (MIXER == 1) {
        bf16x8 a = qf[4], c = qf[5];
#pragma unroll
        for (int jj = 0; jj < 8; ++jj) { const float x1 = bf2f((bf16)a[jj]), x2 = bf2f((bf16)c[jj]); const float ang = (float)p * inv_freq[8 * hi + jj]; const float co = cosf(ang), sn = sinf(ang);
            a[jj] = (short)f2bf(x1 * co - x2 * sn); c[jj] = (short)f2bf(x2 * co + x1 * sn); }
        qf[4] = a; qf[5] = c; } }
    const u64* bmrow = F.BM + ((size_t)b * SEQ + 256 * j + 32 * w + r32) * NW64;
    u64 mw_next = 0ull; if (MIXER == 0) mw_next = bmrow[0];
    f32x16 o0 = {}, o1 = {};
    float m = -1e30f, l = 0.f;
    for (int T = 0; T < NT; ++T) {
        const int slot = T & 1;
        asm volatile("s_waitcnt vmcnt(0)" ::: "memory");
        __syncthreads();
        const u64 mw = mw_next;
        if (T + 1 < NT) { ISSUE_TILE(T + 1, slot ^ 1); if (MIXER == 0 && T + 1 <= Tmax) mw_next = bmrow[T + 1]; }
        if (T <= Tmax) {
            f32x16 s0 = {}, s1 = {};
            const ALAS unsigned char* kp = lds + KOFF + slot * KSLOT + hi * 1024 + r32 * 16;
#pragma unroll
            for (int d0 = 0; d0 < ND0; ++d0) {
                const bf16x8 k0 = *(const ALAS bf16x8*)(kp + d0 * 2048), k1 = *(const ALAS bf16x8*)(kp + d0 * 2048 + 512);
                s0 = __builtin_amdgcn_mfma_f32_32x32x16_bf16(k0, qf[d0], s0, 0, 0, 0);
                s1 = __builtin_amdgcn_mfma_f32_32x32x16_bf16(k1, qf[d0], s1, 0, 0, 0);
            }
            const int dl = p - 64 * T - 4 * hi;
            const bool nearb = 64 * T + 63 > p0q - (MIXER == 0 ? 113 : 0);
            if (MIXER == 0) {
                const unsigned wl = (unsigned)mw >> (4 * hi), wh = (unsigned)(mw >> 32) >> (4 * hi);
                if (nearb) {
#pragma unroll
                    for (int r = 0; r < 16; ++r) { const int c = (r & 3) + 8 * (r >> 2);
                        const int i0 = min(max(dl - c, 0), 127), i1 = min(max(dl - c - 32, 0), 127);
                        s0[r] = ((wl >> c) & 1u) ? __builtin_fmaf(s0[r], cs, tab[i0]) : -INFINITY;
                        s1[r] = ((wh >> c) & 1u) ? __builtin_fmaf(s1[r], cs, tab[i1]) : -INFINITY; }
                } else {
#pragma unroll
                    for (int r = 0; r < 16; ++r) { const int c = (r & 3) + 8 * (r >> 2);
                        s0[r] = ((wl >> c) & 1u) ? __builtin_fmaf(s0[r], cs, b31) : -INFINITY;
                        s1[r] = ((wh >> c) & 1u) ? __builtin_fmaf(s1[r], cs, b31) : -INFINITY; }
                }
            } else {
                if (nearb) {
#pragma unroll
                    for (int r = 0; r < 16; ++r) { const int c = (r & 3) + 8 * (r >> 2);
                        s0[r] = (c > dl) ? -INFINITY : s0[r] * cs; s1[r] = (c + 32 > dl) ? -INFINITY : s1[r] * cs; }
                } else {
#pragma unroll
                    for (int r = 0; r < 16; ++r) { s0[r] *= cs; s1[r] *= cs; }
                }
            }
            float tmax = fmaxf(s0[0], s1[0]);
#pragma unroll
            for (int r = 1; r < 16; ++r) tmax = fmaxf(tmax, fmaxf(s0[r], s1[r]));
            tmax = fmaxf(tmax, __shfl_xor(tmax, 32));
            if (__any(tmax > m + 8.f)) {
                const float mn = fmaxf(m, tmax), al = __builtin_amdgcn_exp2f(m - mn);
                m = mn; l *= al;
                if (hi == 0) scr[r32] = al;
                asm volatile("s_waitcnt lgkmcnt(0)" ::: "memory");
#pragma unroll
                for (int r = 0; r < 16; ++r) { const float a = scr[crow(r, hi)]; o0[r] *= a; o1[r] *= a; }
            }
            float rs = 0.f;
#pragma unroll
            for (int r = 0; r < 16; ++r) { s0[r] = __builtin_amdgcn_exp2f(s0[r] - m); s1[r] = __builtin_amdgcn_exp2f(s1[r] - m); rs += s0[r] + s1[r]; }
            l += rs;
            bf16x8 pa[4];
#pragma unroll
            for (int ks = 0; ks < 4; ++ks) { u32x4 t;
#pragma unroll
                for (int i = 0; i < 4; ++i) { const float lo = (ks < 2) ? s0[8 * (ks & 1) + 2 * i] : s1[8 * (ks & 1) + 2 * i], hh = (ks < 2) ? s0[8 * (ks & 1) + 2 * i + 1] : s1[8 * (ks & 1) + 2 * i + 1]; t[i] = pg8::cvt_pk_bf16(lo, hh); }
                pa[ks] = __builtin_bit_cast(bf16x8, t); }
            const ALAS unsigned char* vb = lds + VOFF + slot * VSLOT + ((lane >> 4) & 1) * 32 + (lane & 3) * 8 + (4 * hi + ((lane & 15) >> 2)) * 64;
#pragma unroll
            for (int ks = 0; ks < 4; ++ks) {
                const s16x4 a0 = vtr(vb + ks * 1024), a1 = vtr(vb + ks * 1024 + 512), c0 = vtr(vb + 4096 + ks * 1024), c1 = vtr(vb + 4096 + ks * 1024 + 512);
                const bf16x8 v0 = (bf16x8){a0[0], a0[1], a0[2], a0[3], a1[0], a1[1], a1[2], a1[3]}, v1 = (bf16x8){c0[0], c0[1], c0[2], c0[3], c1[0], c1[1], c1[2], c1[3]};
                o0 = __builtin_amdgcn_mfma_f32_32x32x16_bf16(pa[ks], v0, o0, 0, 0, 0);
                o1 = __builtin_amdgcn_mfma_f32_32x32x16_bf16(pa[ks], v1, o1, 0, 0, 0);
            }
        }
    }
#undef ISSUE_TILE
    l += __shfl_xor(l, 32);
    if (hi == 0) scr[r32] = 1.f / l;
    asm volatile("s_waitcnt lgkmcnt(0)" ::: "memory");
    const int gcol = (MIXER == 0 ? OFF_GA : OFF_GB) + 64 * h + r32;
#pragma unroll
    for (int r = 0; r < 16; ++r) {
        const int q = crow(r, hi); const float rl = scr[q];
        const bf16* gp = F.P + (rowb + p0q + q) * DINP + gcol;
        const float g0 = bf2f(gp[0]), g1 = bf2f(gp[32]);
        const float y0 = o0[r] * rl * (g0 / (1.f + __expf(-g0))), y1 = o1[r] * rl * (g1 / (1.f + __expf(-g1)));
        bf16* op = F.MIX + ((size_t)b * SEQ + 256 * j + 32 * w + q) * DM + MIXER * 512 + 64 * h + r32;
        op[0] = (bf16)f2bf(y0); op[32] = (bf16)f2bf(y1);
        if ((r & 3) == 3) asm volatile("" ::: "memory");
    }
    asm volatile("s_waitcnt lgkmcnt(0)" ::: "memory");
    __syncthreads();
}
#undef ALAS
}

__device__ __forceinline__ void ph_attn_mfma(const Frame& F, unsigned char* lds, const float* inv_freq) {
    if (F.G == 256) {
        const int vcu = (F.bid % 8) * 32 + F.bid / 8, bh = vcu >> 3, s = vcu & 7, b = bh >> 3, h = bh & 7;
        for (int i = 0; i < 4; ++i) {
            const int j = i < 2 ? 15 - s : s;
            if ((i & 1) == 0) att::attn_unit<0>(F, lds, b, h, j, inv_freq); else att::attn_unit<1>(F, lds, b, h, j, inv_freq);
        }
    } else {
        for (int u = F.bid; u < 1024; u += F.G) {
            const int j = u & 15, h = (u >> 4) & 7, b = (u >> 7) & 3, mixer = u >> 9;
            if (mixer == 0) att::attn_unit<0>(F, lds, b, h, j, inv_freq); else att::attn_unit<1>(F, lds, b, h, j, inv_freq);
        }
    }
}

namespace idx {
#define ILAS __attribute__((address_space(3)))
typedef short bf16x8 __attribute__((ext_vector_type(8)));
typedef float f32x4 __attribute__((ext_vector_type(4)));
constexpr int NI = 33, QOFF = 0, COFF = 16384, IDX_LDS = COFF + 2 * 8 * 16 * 4;

__device__ __forceinline__ void index_unit(const Frame& F, unsigned char* ldsg, int b, int u) {
    const int lane = F.lane, w = F.wave, q = lane & 15, g = lane >> 4;
    ILAS unsigned char* lds = (ILAS unsigned char*)ldsg;
    ILAS int* cnt = (ILAS int*)(lds + COFF);
    const size_t rowb = (size_t)b * LP;
    const int p = NMETA + 16 * u + q;
    const int nkt = u + 2;
    const int ni = (nkt - w + 7) >> 3;
    const int nwrite = 16 * (u >> 4) + 20;
    { const bf16* qp = F.P + (rowb + p) * DINP + OFF_QI + 64 * w + 8 * g;
      *(ILAS bf16x8*)(lds + QOFF + ((w * 2 + 0) * 64 + lane) * 16) = *(const bf16x8*)(qp);
      *(ILAS bf16x8*)(lds + QOFF + ((w * 2 + 1) * 64 + lane) * 16) = *(const bf16x8*)(qp + 32); }
    float ch[8];
    { const v4u wv = *(const v4u*)(F.P + (rowb + p) * DINP + OFF_WI);
#pragma unroll
      for (int h = 0; h < 4; ++h) { ch[2 * h] = __uint_as_float(wv[h] << 16) * 0.35355339059327373f; ch[2 * h + 1] = __uint_as_float(wv[h] & 0xffff0000u) * 0.35355339059327373f; } }
    __syncthreads();
    unsigned kr[NI][4];
    const bf16* kbase = F.P + OFF_KI + 8 * g;
    const unsigned koff0 = (unsigned)(rowb + 16 * w + q) * DINP;
    bf16x8 kfa0, kfa1, kfb0, kfb1;
    const bf16* kptr = kbase + koff0;
    if (ni > 0) { kfa0 = *(const bf16x8*)(kptr); kfa1 = *(const bf16x8*)(kptr + 32); }
#pragma unroll
    for (int i = 0; i < NI; ++i) {
        if (i < ni) {
            kptr += 128 * DINP; asm volatile("" : "+v"(kptr));
            if (i + 1 < ni) { kfb0 = *(const bf16x8*)(kptr); kfb1 = *(const bf16x8*)(kptr + 32); }
            float sc0 = 0.f, sc1 = 0.f, sc2 = 0.f, sc3 = 0.f;
            unsigned qa = QOFF + lane * 16; asm volatile("" : "+v"(qa));
#pragma unroll
            for (int h = 0; h < 8; ++h) {
                const bf16x8 q0 = *(const ILAS bf16x8*)(lds + qa + (h * 2 + 0) * 1024), q1 = *(const ILAS bf16x8*)(lds + qa + (h * 2 + 1) * 1024);
                f32x4 acc = {0.f, 0.f, 0.f, 0.f};
                acc = __builtin_amdgcn_mfma_f32_16x16x32_bf16(kfa0, q0, acc, 0, 0, 0);
                acc = __builtin_amdgcn_mfma_f32_16x16x32_bf16(kfa1, q1, acc, 0, 0, 0);
                sc0 += fmaxf(acc[0] * 0.125f, 0.f) * ch[h]; sc1 += fmaxf(acc[1] * 0.125f, 0.f) * ch[h];
                sc2 += fmaxf(acc[2] * 0.125f, 0.f) * ch[h]; sc3 += fmaxf(acc[3] * 0.125f, 0.f) * ch[h];
            }
            int g4a = 4 * g; asm volatile("" : "+v"(g4a)); const int s0 = 16 * (w + 8 * i) + g4a;
            kr[i][0] = (s0 + 0 >= NMETA && s0 + 0 <= p) ? fkey(sc0) : 0u; kr[i][1] = (s0 + 1 >= NMETA && s0 + 1 <= p) ? fkey(sc1) : 0u;
            kr[i][2] = (s0 + 2 >= NMETA && s0 + 2 <= p) ? fkey(sc2) : 0u; kr[i][3] = (s0 + 3 >= NMETA && s0 + 3 <= p) ? fkey(sc3) : 0u;
            kfa0 = kfb0; kfa1 = kfb1;
        } else { kr[i][0] = 0u; kr[i][1] = 0u; kr[i][2] = 0u; kr[i][3] = 0u; }
    }
#define IDX_REDUCE(c, par, out) do { c += __shfl_xor(c, 16); c += __shfl_xor(c, 32); if (g == 0) cnt[((par) * 8 + w) * 16 + q] = c; \
        asm volatile("s_waitcnt lgkmcnt(0)" ::: "memory"); __syncthreads(); \
        out = 0; _Pragma("unroll") for (int ww = 0; ww < 8; ++ww) out += cnt[((par) * 8 + ww) * 16 + q]; } while (0)
    unsigned thr = 0u;
    for (int bit = 31; bit >= 0; --bit) {
        const unsigned cand = thr | (1u << bit); int c = 0;
#pragma unroll
        for (int i = 0; i < NI; ++i) if (i < ni) c += (int)(kr[i][0] >= cand) + (int)(kr[i][1] >= cand) + (int)(kr[i][2] >= cand) + (int)(kr[i][3] >= cand);
        int tot; IDX_REDUCE(c, bit & 1, tot);
        if (tot >= KSEL) thr = cand;
    }
    int sstar = LP;
    {   int c = 0;
#pragma unroll
        for (int i = 0; i < NI; ++i) if (i < ni) {
#pragma unroll
            for (int jj = 0; jj < 4; ++jj) c += (int)(kr[i][jj] >= thr) + ((int)(kr[i][jj] > thr) << 16); }
        int tot; IDX_REDUCE(c, 1, tot);
        const int cge = tot & 0xffff, cgt = tot >> 16;
        const bool tie = thr != 0u && cge > KSEL;
        if (__any(tie)) {
            const int need = KSEL - cgt; int lo = 0, hi = LP - 1;
            for (int it = 0; it < 13; ++it) {
                const int mid = (lo + hi) >> 1; int c2 = 0;
#pragma unroll
                for (int i = 0; i < NI; ++i) if (i < ni) { int g4b = 4 * g; asm volatile("" : "+v"(g4b));
#pragma unroll
                    for (int jj = 0; jj < 4; ++jj) c2 += (int)(kr[i][jj] == thr && 16 * (w + 8 * i) + g4b + jj <= mid); }
                int t2; IDX_REDUCE(c2, it & 1, t2);
                if (lo < hi) { if (t2 >= need) hi = mid; else lo = mid + 1; }
            }
            if (tie) sstar = lo;
        }
    }
    const unsigned te = thr == 0u ? 1u : thr;
    unsigned short* bm16 = (unsigned short*)(F.BM + ((size_t)b * SEQ + 16 * u + q) * NW64);
#pragma unroll
    for (int i = 0; i < NI; ++i) {
        const int kt = w + 8 * i;
        if (kt < nwrite) {
            unsigned nib = 0u; int g4c = 4 * g; asm volatile("" : "+v"(g4c));
#pragma unroll
            for (int jj = 0; jj < 4; ++jj) { const unsigned k = kr[i][jj]; const int s = 16 * kt + g4c + jj;
                const bool sel = (s < NMETA) || (k >= te && (k > thr || s <= sstar)); nib |= sel ? (1u << jj) : 0u; }
            unsigned v = nib << (4 * g); v |= __shfl_xor(v, 16); v |= __shfl_xor(v, 32);
            if (g == 0) bm16[kt] = (unsigned short)v;
        }
    }
#undef IDX_REDUCE
    __syncthreads();
}
#undef ILAS
}

__device__ __forceinline__ void ph_index_mfma(const Frame& F, unsigned char* lds) {
    if (F.G == 256) {
        const int b = F.bid >> 6, s = F.bid & 63;
        for (int i = 0; i < 4; ++i) { const int u = i == 0 ? 255 - s : i == 1 ? 128 + s : i == 2 ? 127 - s : s; idx::index_unit(F, lds, b, u); }
    } else {
        for (int t = F.bid; t < 1024; t += F.G) idx::index_unit(F, lds, t >> 8, t & 255);
    }
}

constexpr int LDS_BYTES = 155648;
__global__ void __launch_bounds__(512, 2) fwd(Args args) {
    extern __shared__ __attribute__((aligned(16))) unsigned char lds[];
    Frame F;
    F.tid = threadIdx.x; F.lane = F.tid & 63; F.wave = __builtin_amdgcn_readfirstlane(F.tid >> 6); F.G = gridDim.x; F.bid = blockIdx.x;
    F.x = args.in[0]; F.meta = args.in[1]; F.lne_g = args.in[2]; F.lne_b = args.in[3]; F.w_in = args.in[4]; F.w_uq = args.in[5]; F.qn_g = args.in[6];
    F.w_ukv = args.in[7]; F.kvn_g = args.in[8]; F.rel_bias = args.in[9]; F.w_out = args.in[10]; F.lnp_g = args.in[11]; F.lnp_b = args.in[12];
    F.out = args.out;
    unsigned char* ws = args.ws;
    F.Win_t = (bf16*)(ws + WS_WIN); F.Wmla_t = (bf16*)(ws + WS_WMLA); F.Wout_t = (bf16*)(ws + WS_WOUT); F.KPER = (bf16*)(ws + WS_KPER);
    F.BM = (u64*)(ws + WS_BM); F.CQKVN = (bf16*)(ws + WS_CQKVN); F.XN = (bf16*)(ws + WS_XN); F.MIX = (bf16*)(ws + WS_XN);
    F.QKVB = (bf16*)(ws + WS_QKVB); F.P = (bf16*)(ws + WS_P); F.Z = (float*)(ws + WS_P);
    const int lo = args.ph_lo, hi = args.ph_hi;
    cooperative_groups::grid_group grid = cooperative_groups::this_grid();
#define IN(k) (lo <= (k) && (k) < hi)
#define SEAM(k) do { if (IN(k) && IN((k) + 1)) grid.sync(); } while (0)
    if (IN(0)) ph_prologue(F, (float*)lds);
    SEAM(0);
    PG8_LAS unsigned char* ring = (PG8_LAS unsigned char*)lds;
    if (IN(1)) { pg8::Gemm g{F.XN, F.Win_t, MROWS, DINP, DM}; pg8::StaticOrder S; S.init(MROWS, DINP, F.G, F.bid); pg8::EpiBf16 E{F.P, DINP};
        pg8::gemm_phase<pg8::EpiBf16, pg8::StaticOrder, true, true>(ring, g, S, E); }
    SEAM(1);
    if (IN(2)) ph_rms(F, args.inv_freq);
    SEAM(2);
    if (IN(3)) { { pg8::Gemm g{F.CQKVN, F.Wmla_t, MROWS, NMLA, KMLA}; pg8::StaticOrder S; S.init(MROWS, NMLA, F.G, F.bid); pg8::EpiBf16 E{F.QKVB, NMLA};
        pg8::gemm_phase<pg8::EpiBf16, pg8::StaticOrder, true, true>(ring, g, S, E); }
        __syncthreads(); ph_index_mfma(F, lds); }
    SEAM(3);
    if (IN(4)) ph_attn_mfma(F, lds, args.inv_freq);
    SEAM(4);
    if (IN(5)) { pg8::Gemm g{F.MIX, F.Wout_t, MQ, DM, DM}; pg8::StaticOrder S; S.init(MQ, DM, F.G, F.bid); pg8::EpiF32 E{F.Z, DM, nullptr};
        pg8::gemm_phase<pg8::EpiF32, pg8::StaticOrder, true, true>(ring, g, S, E); }
    SEAM(5);
    if (IN(6)) ph_final(F);
#undef IN
#undef SEAM
}

#ifndef MK_N_LAUNCHES
#define MK_N_LAUNCHES 1
#endif
extern "C" void kernel_launch(void* const* d_in, const int* in_sizes, int n_in, void* d_out, int out_size, void* d_ws, size_t ws_size, hipStream_t stream) {
    static int grid_blocks = 0;
    if (!grid_blocks) {
        if (n_in != 13 || out_size != MQ * DM || ws_size < WS_END) { fprintf(stderr, "kernel_launch: unexpected shapes (n_in %d out %d ws %zu)\n", n_in, out_size, ws_size); grid_blocks = -1; return; }
        if (hipFuncSetAttribute((const void*)fwd, hipFuncAttributeMaxDynamicSharedMemorySize, LDS_BYTES) != hipSuccess) { fprintf(stderr, "kernel_launch: hipFuncSetAttribute failed\n"); grid_blocks = -1; return; }
        int dev = 0, cus = 0, per_cu = 0;
        (void)hipGetDevice(&dev);
        (void)hipDeviceGetAttribute(&cus, hipDeviceAttributeMultiprocessorCount, dev);
        (void)hipOccupancyMaxActiveBlocksPerMultiprocessor(&per_cu, (const void*)fwd, 512, LDS_BYTES);
        if (per_cu < 1 || cus < 1) { fprintf(stderr, "kernel_launch: occupancy query says %d blocks/CU on %d CUs\n", per_cu, cus); grid_blocks = -1; return; }
        grid_blocks = cus;
    }
    if (grid_blocks < 0) return;
    Args a{};
    for (int i = 0; i < 13; ++i) a.in[i] = (const float*)d_in[i];
    a.out = (float*)d_out; a.ws = (unsigned char*)d_ws;
    for (int i = 0; i < 16; ++i) a.inv_freq[i] = (float)pow(10000.0, -(double)(2 * i) / 32.0);
    if (MK_N_LAUNCHES == 1) {
        a.ph_lo = 0; a.ph_hi = 7;
        void* kargs[] = {&a};
        hipError_t e = hipLaunchCooperativeKernel((const void*)fwd, dim3(grid_blocks), dim3(512), kargs, LDS_BYTES, stream);
        if (e != hipSuccess) fprintf(stderr, "kernel_launch: cooperative launch failed: %s (grid %d)\n", hipGetErrorString(e), grid_blocks);
    } else {
        for (int ph = 0; ph < 7; ++ph) {
            a.ph_lo = ph; a.ph_hi = ph + 1;
            hipLaunchKernelGGL(fwd, dim3(grid_blocks), dim3(512), LDS_BYTES, stream, a);
        }
    }
}
```

```cpp
#include <hip/hip_runtime.h>
#include <cstdio>
#include <cstdint>
#include <cmath>

constexpr int BATCH = 4, SEQ = 4096, DM = 1024, NMETA = 16;
constexpr int LTOK = NMETA + SEQ;
constexpr int LP = 4160;
constexpr int MROWS = BATCH * LP;
constexpr int MQ = BATCH * SEQ;
constexpr int DIN = 3560, DINP = 3584;
constexpr int OFF_QA = 0, OFF_KA = 512, OFF_VA = 1024, OFF_GA = 1536, OFF_QI = 2048, OFF_KI = 2560, OFF_WI = 2624,
              OFF_CQ = 2632, OFF_CKV = 2888, OFF_KPE = 3016, OFF_GB = 3048;
constexpr int KMLA = 384, NMLA = 1792;
constexpr int TOPK = 256, KSEL = TOPK - NMETA;
constexpr int NW64 = LP / 64;
constexpr float LN_EPS = 1e-5f, RMS_EPS = 1e-6f;
constexpr float ALPHA = 1.189207115002721f;

constexpr size_t MiB = 1u << 20;
constexpr size_t WS_CTL = 0;
constexpr size_t WS_WIN = 2 * MiB;
constexpr size_t WS_WMLA = 9 * MiB;
constexpr size_t WS_WOUT = 11 * MiB;
constexpr size_t WS_KPER = 13 * MiB;
constexpr size_t WS_BM = 15 * MiB;
constexpr size_t WS_CQKVN = 24 * MiB;
constexpr size_t WS_XN = 37 * MiB;
constexpr size_t WS_QKVB = 70 * MiB;
constexpr size_t WS_P = 127 * MiB;
constexpr size_t WS_END = 241 * MiB;

typedef unsigned short bf16;
typedef unsigned long long u64;
typedef unsigned v4u __attribute__((ext_vector_type(4)));
typedef float f32x4 __attribute__((ext_vector_type(4)));

__device__ __forceinline__ float bf2f(bf16 v) { return __uint_as_float((unsigned)v << 16); }
__device__ __forceinline__ unsigned f2bf(float f) { unsigned u = __float_as_uint(f); return (u + 0x7fffu + ((u >> 16) & 1u)) >> 16; }
__device__ __forceinline__ unsigned pk2(float lo, float hi) { return f2bf(lo) | (f2bf(hi) << 16); }
__device__ __forceinline__ float wave_sum(float v) {
#pragma unroll
    for (int o = 1; o < 64; o <<= 1) v += __shfl_xor(v, o);
    return v;
}
__device__ __forceinline__ float wave_max(float v) {
#pragma unroll
    for (int o = 1; o < 64; o <<= 1) v = fmaxf(v, __shfl_xor(v, o));
    return v;
}
__device__ __forceinline__ int wave_isum(int v) {
#pragma unroll
    for (int o = 1; o < 64; o <<= 1) v += __shfl_xor(v, o);
    return v;
}
__device__ __forceinline__ int t5_bucket(int d) {
    if (d < 16) return d < 0 ? 0 : d;
    return 16 + (d >= 19) + (d >= 21) + (d >= 24) + (d >= 27) + (d >= 31) + (d >= 35) + (d >= 40) + (d >= 46) + (d >= 52) + (d >= 59) + (d >= 67) + (d >= 77) + (d >= 87) + (d >= 99) + (d >= 113);
}
__device__ __forceinline__ unsigned fkey(float f) { unsigned u = __float_as_uint(f); return (u & 0x80000000u) ? ~u : (u | 0x80000000u); }

struct Args {
    const float* in[13];
    float* out;
    unsigned char* ws;
    float inv_freq[16];
    int ph_lo, ph_hi;
};

struct Frame {
    int tid, lane, wave, G, bid;
    const float *x, *meta, *lne_g, *lne_b, *w_in, *w_uq, *qn_g, *w_ukv, *kvn_g, *rel_bias, *w_out, *lnp_g, *lnp_b;
    float* out;
    bf16 *Win_t, *Wmla_t, *Wout_t, *KPER, *CQKVN, *XN, *MIX, *QKVB, *P;
    u64* BM;
    float* Z;
};

template <class F> __device__ __forceinline__ void transpose_tile(F src, bf16* dst, int ldk, int n0, int k0, float* scr, int tid) {
    const int ty = tid >> 6, tx = tid & 63;
#pragma unroll
    for (int i = 0; i < 8; ++i) { const int k = ty + 8 * i; scr[k * 65 + tx] = src(k0 + k, n0 + tx); }
    __syncthreads();
    const int nn = tid >> 3, kc = tid & 7;
    v4u o; o.x = pk2(scr[(8 * kc + 0) * 65 + nn], scr[(8 * kc + 1) * 65 + nn]); o.y = pk2(scr[(8 * kc + 2) * 65 + nn], scr[(8 * kc + 3) * 65 + nn]);
    o.z = pk2(scr[(8 * kc + 4) * 65 + nn], scr[(8 * kc + 5) * 65 + nn]); o.w = pk2(scr[(8 * kc + 6) * 65 + nn], scr[(8 * kc + 7) * 65 + nn]);
    *(v4u*)(dst + (size_t)(n0 + nn) * ldk + k0 + 8 * kc) = o;
    __syncthreads();
}
__device__ __forceinline__ void ph_prologue(const Frame& F, float* lds) {
    constexpr int I_IN = (DINP / 64) * (DM / 64), I_MLA = (NMLA / 64) * (KMLA / 64), I_OUT = (DM / 64) * (DM / 64);
    for (int it = F.bid; it < I_IN + I_MLA + I_OUT; it += F.G) {
        if (it < I_IN) {
            const int n0 = (it / (DM / 64)) * 64, k0 = (it % (DM / 64)) * 64; const float* w = F.w_in;
            transpose_tile([=](int k, int n) { return n < DIN ? w[(size_t)k * DIN + n] : 0.f; }, F.Win_t, DM, n0, k0, lds, F.tid);
        } else if (it < I_IN + I_MLA) {
            const int r = it - I_IN, n0 = (r / (KMLA / 64)) * 64, k0 = (r % (KMLA / 64)) * 64;
            const float *wq = F.w_uq, *wkv = F.w_ukv, *gq = F.qn_g, *gkv = F.kvn_g;
            transpose_tile([=](int k, int n) {
                if (n < 768) return k < 256 ? wq[(size_t)k * 768 + n] * gq[k] : 0.f;
                return k >= 256 ? wkv[(size_t)(k - 256) * 1024 + (n - 768)] * gkv[k - 256] : 0.f; }, F.Wmla_t, KMLA, n0, k0, lds, F.tid);
        } else {
            const int r = it - I_IN - I_MLA, n0 = (r / (DM / 64)) * 64, k0 = (r % (DM / 64)) * 64; const float* w = F.w_out;
            transpose_tile([=](int k, int n) { return w[(size_t)k * DM + n]; }, F.Wout_t, DM, n0, k0, lds, F.tid);
        }
    }
    const int gw = F.bid * 8 + F.wave, NGW = F.G * 8;
    for (int m = gw; m < MROWS; m += NGW) {
        const int b = m / LP, p = m % LP;
        unsigned long long* o8 = (unsigned long long*)(F.XN + (size_t)m * DM) + F.lane;
        if (p >= LTOK) {
#pragma unroll
            for (int j = 0; j < 4; ++j) o8[64 * j] = 0ull;
            continue;
        }
        const float* src = p < NMETA ? F.meta + (size_t)p * DM : F.x + ((size_t)b * SEQ + (p - NMETA)) * DM;
        const f32x4* xr = (const f32x4*)src + F.lane;
        f32x4 v[4]; float s = 0.f;
#pragma unroll
        for (int j = 0; j < 4; ++j) { v[j] = xr[64 * j]; s += (v[j].x + v[j].y) + (v[j].z + v[j].w); }
        const float mean = wave_sum(s) * (1.f / DM); float s2 = 0.f;
#pragma unroll
        for (int j = 0; j < 4; ++j) { v[j] = v[j] - mean; s2 += (v[j].x * v[j].x + v[j].y * v[j].y) + (v[j].z * v[j].z + v[j].w * v[j].w); }
        const float rstd = 1.f / sqrtf(wave_sum(s2) * (1.f / DM) + LN_EPS);
#pragma unroll
        for (int j = 0; j < 4; ++j) {
            const f32x4 g = ((const f32x4*)F.lne_g)[F.lane + 64 * j], bb = ((const f32x4*)F.lne_b)[F.lane + 64 * j];
            const f32x4 y = v[j] * rstd * g + bb;
            o8[64 * j] = (unsigned long long)pk2(y.x, y.y) | ((unsigned long long)pk2(y.z, y.w) << 32);
        }
    }
}

__device__ __forceinline__ void ph_rms(const Frame& F, const float* inv_freq) {
    const int gw = F.bid * 8 + F.wave, NGW = F.G * 8, lane = F.lane;
    for (int m = gw; m < MROWS; m += NGW) {
        const bf16* pr = F.P + (size_t)m * DINP; const int p = m % LP;
        const unsigned long long cq4 = *(const unsigned long long*)(pr + OFF_CQ + 4 * lane);
        const unsigned ckv2 = *(const unsigned*)(pr + OFF_CKV + 2 * lane);
        float c[4] = {bf2f((bf16)(cq4 & 0xffff)), bf2f((bf16)((cq4 >> 16) & 0xffff)), bf2f((bf16)((cq4 >> 32) & 0xffff)), bf2f((bf16)(cq4 >> 48))};
        float d[2] = {bf2f((bf16)(ckv2 & 0xffff)), bf2f((bf16)(ckv2 >> 16))};
        const float sq = wave_sum(c[0] * c[0] + c[1] * c[1] + c[2] * c[2] + c[3] * c[3]), skv = wave_sum(d[0] * d[0] + d[1] * d[1]);
        const float rq = 1.f / sqrtf(sq * (1.f / 256.f) + RMS_EPS), rkv = 1.f / sqrtf(skv * (1.f / 128.f) + RMS_EPS);
        bf16* o = F.CQKVN + (size_t)m * KMLA;
        *(unsigned long long*)(o + 4 * lane) = (unsigned long long)pk2(c[0] * rq, c[1] * rq) | ((unsigned long long)pk2(c[2] * rq, c[3] * rq) << 32);
        *(unsigned*)(o + 256 + 2 * lane) = pk2(d[0] * rkv, d[1] * rkv);
        if (lane < 16) {
            const float x1 = bf2f(pr[OFF_KPE + lane]), x2 = bf2f(pr[OFF_KPE + 16 + lane]);
            const float ang = (float)p * inv_freq[lane]; const float cs = cosf(ang), sn = sinf(ang);
            F.KPER[(size_t)m * 32 + lane] = (bf16)f2bf(x1 * cs - x2 * sn); F.KPER[(size_t)m * 32 + 16 + lane] = (bf16)f2bf(x2 * cs + x1 * sn);
        }
    }
}

__device__ __forceinline__ void ph_final(const Frame& F) {
    const int gw = F.bid * 8 + F.wave, NGW = F.G * 8, lane = F.lane;
    for (int m = gw; m < MQ; m += NGW) {
        const f32x4* xr = (const f32x4*)(F.x + (size_t)m * DM) + lane; const f32x4* zr = (const f32x4*)(F.Z + (size_t)m * DM) + lane;
        f32x4 v[4]; float s = 0.f;
#pragma unroll
        for (int j = 0; j < 4; ++j) { v[j] = xr[64 * j]; s += (v[j].x + v[j].y) + (v[j].z + v[j].w); }
        const float mean = wave_sum(s) * (1.f / DM); float s2 = 0.f;
#pragma unroll
        for (int j = 0; j < 4; ++j) { v[j] = v[j] - mean; s2 += (v[j].x * v[j].x + v[j].y * v[j].y) + (v[j].z * v[j].z + v[j].w * v[j].w); }
        const float rstd = 1.f / sqrtf(wave_sum(s2) * (1.f / DM) + LN_EPS);
        float t = 0.f;
#pragma unroll
        for (int j = 0; j < 4; ++j) {
            const f32x4 g = ((const f32x4*)F.lne_g)[lane + 64 * j], bb = ((const f32x4*)F.lne_b)[lane + 64 * j];
            v[j] = (v[j] * rstd * g + bb) * ALPHA + zr[64 * j];
            t += (v[j].x + v[j].y) + (v[j].z + v[j].w);
        }
        const float mean2 = wave_sum(t) * (1.f / DM); float t2 = 0.f;
#pragma unroll
        for (int j = 0; j < 4; ++j) { v[j] = v[j] - mean2; t2 += (v[j].x * v[j].x + v[j].y * v[j].y) + (v[j].z * v[j].z + v[j].w * v[j].w); }
        const float rstd2 = 1.f / sqrtf(wave_sum(t2) * (1.f / DM) + LN_EPS);
        f32x4* o = (f32x4*)(F.out + (size_t)m * DM) + lane;
#pragma unroll
        for (int j = 0; j < 4; ++j) {
            const f32x4 g = ((const f32x4*)F.lnp_g)[lane + 64 * j], bb = ((const f32x4*)F.lnp_b)[lane + 64 * j];
            o[64 * j] = v[j] * rstd2 * g + bb;
        }
    }
}

namespace pg8 {
#define PG8_LAS __attribute__((address_space(3)))
typedef unsigned short bf16_t;
typedef short bf16x8 __attribute__((ext_vector_type(8)));
typedef float f32x4 __attribute__((ext_vector_type(4)));
typedef unsigned u32x4 __attribute__((ext_vector_type(4)));
constexpr int BM = 256, BK = 64, HALF = 128, HTB = HALF * BK * 2  , STAGE_BYTES = 8 * HTB, NXCD = 8, WGM = 8;

__host__ __device__ __forceinline__ int lds_byte(int r, int c) { const int st = (r >> 4) * 2 + (c >> 5), rr = r & 15, cc = c & 31, ob = rr * 64 + cc * 2; return st * 1024 + (ob ^ (((ob >> 9) & 1) << 5)); }
__host__ __device__ __forceinline__ void stage_rc(int b, int& R, int& C) { const int st = b / 1024, sb = b % 1024, swz = sb ^ (((sb >> 9) & 1) << 5); R = (st >> 1) * 16 + swz / 64; C = (st & 1) * 32 + (swz % 64) / 2; }
__host__ __device__ __forceinline__ int perm32(int rho) { const int n = rho >> 4, i = rho & 15; return 8 * (i >> 2) + 4 * n + (i & 3); }

struct Unit { int pm, pn; };
struct Gemm { const bf16_t* A; const bf16_t* Bt; int M, N, K; };

struct StaticOrder {
    int nM, nN, nwg, G, c;
    __host__ __device__ void init(int M, int N, int G_, int c_) { nM = M / BM; nN = N / BM; nwg = nM * nN; G = G_; c = c_; }
    __host__ __device__ bool next(int i, Unit& u) const {
        const long L = (long)i * G + c; if (L >= nwg) return false;
        int wgid = (int)L; { const int q = nwg / NXCD, r = nwg % NXCD, xcd = wgid % NXCD, off = wgid / NXCD; wgid = (xcd < r ? xcd * (q + 1) : r * (q + 1) + (xcd - r) * q) + off; }
        const int nig = WGM * nN, gid = wgid / nig, fm = gid * WGM, gsz = (nM - fm) < WGM ? (nM - fm) : WGM;
        u.pm = fm + ((wgid % nig) % gsz); u.pn = (wgid % nig) / gsz; return true;
    }
    __device__ __forceinline__ void a_ready(const Unit&) const {}
    __device__ __forceinline__ void done(const Unit&) const {}
};

__device__ __forceinline__ unsigned cvt_pk_bf16(float lo, float hi) { unsigned r; asm volatile("v_cvt_pk_bf16_f32 %0, %1, %2" : "=v"(r) : "v"(lo), "v"(hi)); return r; }

struct EpiBf16 {
    static constexpr bool PERM = true, AFTER_DRAIN = false;
    bf16_t* O; int ldc;
    __device__ __forceinline__ void operator()(const f32x4 (&acc)[2][2][4][2], const Unit& u, int wr, int wc, int fr, int fq) const {
        const int row0 = u.pm * BM + wr * 64 + fr, col0 = u.pn * BM + wc * 32 + 8 * fq;
#pragma unroll
        for (int ai = 0; ai < 2; ++ai)
#pragma unroll
            for (int m = 0; m < 4; ++m) { bf16_t* rowp = O + (size_t)(row0 + ai * HALF + m * 16) * ldc + col0;
#pragma unroll
                for (int bj = 0; bj < 2; ++bj) { const f32x4 v0 = acc[ai][bj][m][0], v1 = acc[ai][bj][m][1];
                    u32x4 w; w.x = cvt_pk_bf16(v0[0], v0[1]); w.y = cvt_pk_bf16(v0[2], v0[3]); w.z = cvt_pk_bf16(v1[0], v1[1]); w.w = cvt_pk_bf16(v1[2], v1[3]);
                    *(u32x4*)(rowp + bj * HALF) = w; } }
    }
};
struct EpiF32 {
    static constexpr bool PERM = false, AFTER_DRAIN = false;
    float* C; int ldc; const float* bias;
    __device__ __forceinline__ void operator()(const f32x4 (&acc)[2][2][4][2], const Unit& u, int wr, int wc, int fr, int fq) const {
        const int row0 = u.pm * BM + wr * 64 + fr, col0 = u.pn * BM + wc * 32 + 4 * fq;
        f32x4 bv[2][2];
#pragma unroll
        for (int bj = 0; bj < 2; ++bj)
#pragma unroll
            for (int n = 0; n < 2; ++n) bv[bj][n] = bias ? *(const f32x4*)(bias + col0 + bj * HALF + n * 16) : (f32x4){0.f, 0.f, 0.f, 0.f};
#pragma unroll
        for (int ai = 0; ai < 2; ++ai)
#pragma unroll
            for (int m = 0; m < 4; ++m) { float* rowp = C + (size_t)(row0 + ai * HALF + m * 16) * ldc + col0;
#pragma unroll
                for (int bj = 0; bj < 2; ++bj)
#pragma unroll
                    for (int n = 0; n < 2; ++n) *(f32x4*)(rowp + bj * HALF + n * 16) = acc[ai][bj][m][n] + bv[bj][n]; }
    }
};
template <class Epi, class Sched, bool ALIGN_EPI = false, bool SP2 = false>
__device__ __forceinline__ void gemm_phase(PG8_LAS unsigned char* lds, const Gemm g, const Sched& S, const Epi& E) {
    const int tid = threadIdx.x, wid = __builtin_amdgcn_readfirstlane(tid >> 6), lane = tid & 63, wr = wid >> 2, wc = wid & 3, fr = lane & 15, fq = lane >> 4;
    const int K = g.K, nt = K / BK;
    unsigned voffA[2], voffB[2];
#pragma unroll
    for (int i = 0; i < 2; ++i) { int R, C; stage_rc(tid * 16 + i * 8192, R, C); const int Rb = Epi::PERM ? ((R & ~31) + perm32(R & 31)) : R;
        voffA[i] = (unsigned)(R * K + C) * 2u; voffB[i] = (unsigned)(Rb * K + C) * 2u; }
    const size_t kstep = (size_t)(BK * 2);
    const size_t hstep = (size_t)HALF * K * 2;
    const size_t tstep = 2 * hstep;
    const unsigned ldsw = (unsigned)wid * 1024u;
    const int aoff = lds_byte(wr * 64 + fr, fq * 8), boff = lds_byte(wc * 32 + fr, fq * 8);
#define PG8_SA(b, h) (((b) * 2 + (h)) * HTB)
#define PG8_SB(b, h) ((4 + (b) * 2 + (h)) * HTB)
#define PG8_STAGE(bufoff, gbase, voff) do { _Pragma("unroll") for (int _i = 0; _i < 2; ++_i) \
        __builtin_amdgcn_global_load_lds((const unsigned*)((const char*)(gbase) + (voff)[_i]), (PG8_LAS unsigned*)(lds + (bufoff) + ldsw + _i * 8192), 16, 0, 0); } while (0)
#define PG8_LDA(dst, b, h) do { _Pragma("unroll") for (int m = 0; m < 4; ++m) _Pragma("unroll") for (int k = 0; k < 2; ++k) dst[m][k] = *(const PG8_LAS bf16x8*)(lds + PG8_SA(b, h) + aoff + m * 2048 + k * 1024); } while (0)
#define PG8_LDB(dst, b, h) do { _Pragma("unroll") for (int n = 0; n < 2; ++n) _Pragma("unroll") for (int k = 0; k < 2; ++k) dst[n][k] = *(const PG8_LAS bf16x8*)(lds + PG8_SB(b, h) + boff + n * 2048 + k * 1024); } while (0)
#define PG8_MMA(ai, bj, At, Bt) do { __builtin_amdgcn_s_setprio(1); _Pragma("unroll") for (int m = 0; m < 4; ++m) _Pragma("unroll") for (int n = 0; n < 2; ++n) _Pragma("unroll") for (int k = 0; k < 2; ++k) \
        acc[ai][bj][m][n] = __builtin_amdgcn_mfma_f32_16x16x32_bf16(Bt[n][k], At[m][k], acc[ai][bj][m][n], 0, 0, 0); __builtin_amdgcn_s_setprio(0); } while (0)
#define PG8_WAIT_V(n) asm volatile("s_waitcnt vmcnt(" #n ")" ::: "memory")
#define PG8_WAIT_L(n) asm volatile("s_waitcnt lgkmcnt(" #n ")" ::: "memory")
#define PG8_BAR __builtin_amdgcn_s_barrier()
#define PG8_SCHED __builtin_amdgcn_sched_barrier(0)
    Unit cur, nxt; int ui = 0;
    if (!S.next(0, cur)) return;
    f32x4 acc[2][2][4][2];
#pragma unroll
    for (int a = 0; a < 2; ++a)
#pragma unroll
        for (int b = 0; b < 2; ++b)
#pragma unroll
            for (int m = 0; m < 4; ++m)
#pragma unroll
                for (int n = 0; n < 2; ++n) acc[a][b][m][n] = (f32x4){0.f, 0.f, 0.f, 0.f};
    bf16x8 At[4][2], B0[2][2], B1[2][2];
    const char* cA = (const char*)g.A + (size_t)cur.pm * tstep; const char* cB = (const char*)g.Bt + (size_t)cur.pn * tstep;
    S.a_ready(cur);
    if constexpr (SP2) {
        PG8_STAGE(PG8_SB(0, 0), cB, voffB); PG8_STAGE(PG8_SB(0, 1), cB + hstep, voffB); PG8_STAGE(PG8_SA(0, 0), cA, voffA); PG8_STAGE(PG8_SA(0, 1), cA + hstep, voffA);
        if (wr == 1) PG8_BAR;
        PG8_WAIT_V(2); PG8_BAR;
        PG8_STAGE(PG8_SB(1, 0), cB + kstep, voffB); PG8_STAGE(PG8_SA(1, 0), cA + kstep, voffA); PG8_STAGE(PG8_SB(1, 1), cB + hstep + kstep, voffB);
        PG8_WAIT_V(6); PG8_BAR;
    } else {
        PG8_STAGE(PG8_SB(0, 0), cB, voffB); PG8_STAGE(PG8_SA(0, 0), cA, voffA); PG8_STAGE(PG8_SB(0, 1), cB + hstep, voffB); PG8_STAGE(PG8_SA(0, 1), cA + hstep, voffA);
        if (wr == 1) PG8_BAR;
        PG8_WAIT_V(4); PG8_BAR;
        PG8_STAGE(PG8_SB(1, 0), cB + kstep, voffB); PG8_STAGE(PG8_SA(1, 0), cA + kstep, voffA); PG8_STAGE(PG8_SB(1, 1), cB + hstep + kstep, voffB);
        PG8_WAIT_V(6); PG8_BAR;
    }
    for (;;) {
        const bool has_next = S.next(ui + 1, nxt);
        const char* nA = has_next ? (const char*)g.A + (size_t)nxt.pm * tstep : cA; const char* nB = has_next ? (const char*)g.Bt + (size_t)nxt.pn * tstep : cB;
        for (int t = 0; t < nt; t += 2) {
            const bool last = (t == nt - 2);
            const char* a1 = cA + (size_t)(t + 1) * kstep;
            const char* a2 = last ? nA : cA + (size_t)(t + 2) * kstep; const char* b2 = last ? nB : cB + (size_t)(t + 2) * kstep;
            const char* a3 = a2 + kstep; const char* b3 = b2 + kstep;
            if (last && has_next) S.a_ready(nxt);
            if constexpr (SP2) {
            PG8_LDB(B0, 0, 0); PG8_LDB(B1, 0, 1); PG8_SCHED; PG8_LDA(At, 0, 0); PG8_STAGE(PG8_SA(1, 1), a1 + hstep, voffA);
            PG8_WAIT_V(8); PG8_WAIT_L(0); PG8_BAR; PG8_MMA(0, 0, At, B0); PG8_MMA(0, 1, At, B1); PG8_BAR; PG8_SCHED;
            PG8_LDA(At, 0, 1); PG8_STAGE(PG8_SB(0, 0), b2, voffB); PG8_STAGE(PG8_SB(0, 1), b2 + hstep, voffB); PG8_STAGE(PG8_SA(0, 0), a2, voffA);
            PG8_WAIT_V(8); PG8_WAIT_L(0); PG8_BAR; PG8_MMA(1, 0, At, B0); PG8_MMA(1, 1, At, B1); PG8_BAR; PG8_SCHED;
            PG8_LDB(B0, 1, 0); PG8_LDB(B1, 1, 1); PG8_SCHED; PG8_LDA(At, 1, 0); PG8_STAGE(PG8_SA(0, 1), a2 + hstep, voffA);
            PG8_WAIT_V(8); PG8_WAIT_L(0); PG8_BAR; PG8_MMA(0, 0, At, B0); PG8_MMA(0, 1, At, B1); PG8_BAR; PG8_SCHED;
            PG8_LDA(At, 1, 1); PG8_STAGE(PG8_SB(1, 0), b3, voffB); PG8_STAGE(PG8_SB(1, 1), b3 + hstep, voffB); PG8_STAGE(PG8_SA(1, 0), a3, voffA);
            PG8_WAIT_V(8); PG8_WAIT_L(0); PG8_BAR; PG8_MMA(1, 0, At, B0); PG8_MMA(1, 1, At, B1); PG8_BAR; PG8_SCHED;
            } else {
            PG8_LDB(B0, 0, 0); PG8_SCHED; PG8_LDA(At, 0, 0); PG8_STAGE(PG8_SA(1, 1), a1 + hstep, voffA);
            PG8_WAIT_L(8); PG8_BAR; PG8_WAIT_L(0); PG8_MMA(0, 0, At, B0); PG8_BAR; PG8_SCHED;
            PG8_LDB(B1, 0, 1); PG8_STAGE(PG8_SB(0, 0), b2, voffB);
            PG8_BAR; PG8_WAIT_L(0); PG8_MMA(0, 1, At, B1); PG8_BAR;
            PG8_LDA(At, 0, 1); PG8_STAGE(PG8_SA(0, 0), a2, voffA);
            PG8_BAR; PG8_WAIT_L(0); PG8_MMA(1, 0, At, B0); PG8_BAR; PG8_SCHED;
            PG8_STAGE(PG8_SB(0, 1), b2 + hstep, voffB);
            PG8_WAIT_V(6); PG8_BAR; PG8_MMA(1, 1, At, B1); PG8_BAR;
            PG8_LDB(B0, 1, 0); PG8_SCHED; PG8_LDA(At, 1, 0); PG8_STAGE(PG8_SA(0, 1), a2 + hstep, voffA);
            PG8_WAIT_L(8); PG8_BAR; PG8_WAIT_L(0); PG8_MMA(0, 0, At, B0); PG8_BAR; PG8_SCHED;
            PG8_LDB(B1, 1, 1); PG8_STAGE(PG8_SB(1, 0), b3, voffB);
            PG8_BAR; PG8_WAIT_L(0); PG8_MMA(0, 1, At, B1); PG8_BAR;
            PG8_LDA(At, 1, 1); PG8_STAGE(PG8_SA(1, 0), a3, voffA);
            PG8_BAR; PG8_WAIT_L(0); PG8_MMA(1, 0, At, B0); PG8_BAR; PG8_SCHED;
            PG8_STAGE(PG8_SB(1, 1), b3 + hstep, voffB);
            PG8_WAIT_V(6); PG8_BAR; PG8_MMA(1, 1, At, B1); PG8_BAR;
            }
        }
        if constexpr (ALIGN_EPI) { if (wr == 0) PG8_BAR; }
        if constexpr (!Epi::AFTER_DRAIN) { E(acc, cur, wr, wc, fr, fq); S.done(cur); }
        if (!has_next) break;
#pragma unroll
        for (int a = 0; a < 2; ++a)
#pragma unroll
            for (int b = 0; b < 2; ++b)
#pragma unroll
                for (int m = 0; m < 4; ++m)
#pragma unroll
                    for (int n = 0; n < 2; ++n) acc[a][b][m][n] = (f32x4){0.f, 0.f, 0.f, 0.f};
        cur = nxt; cA = nA; cB = nB; ++ui;
        if constexpr (ALIGN_EPI) { if (wr == 1) PG8_BAR; }
    }
    PG8_WAIT_V(0);
    if constexpr (!ALIGN_EPI) { if (wr == 0) PG8_BAR; }
    PG8_BAR;
    if constexpr (Epi::AFTER_DRAIN) { E.fused(acc, cur, wr, wc, fr, fq, lds, wid, lane); S.done(cur); }
#undef PG8_SA
#undef PG8_SB
#undef PG8_STAGE
#undef PG8_LDA
#undef PG8_LDB
#undef PG8_MMA
#undef PG8_WAIT_V
#undef PG8_WAIT_L
#undef PG8_BAR
#undef PG8_SCHED
}
}

namespace att {
#define ALAS __attribute__((address_space(3)))
typedef short bf16x8 __attribute__((ext_vector_type(8)));
typedef short s16x4 __attribute__((ext_vector_type(4)));
typedef float f32x16 __attribute__((ext_vector_type(16)));
typedef unsigned u32x4 __attribute__((ext_vector_type(4)));
constexpr int KSLOT = 12288, VSLOT = 8192, KOFF = 0, VOFF = 2 * KSLOT, TABOFF = VOFF + 2 * VSLOT, SCROFF = TABOFF + 512, ATT_LDS = SCROFF + 8 * 128;
constexpr float LOG2E = 1.4426950408889634f;
__device__ __forceinline__ s16x4 vtr(const ALAS unsigned char* p) { return __builtin_bit_cast(s16x4, __builtin_amdgcn_ds_read_tr16_b64_v4i16((ALAS s16x4*)p)); }
__device__ __forceinline__ void glds16(const void* g, ALAS unsigned char* l) { __builtin_amdgcn_global_load_lds((const unsigned*)g, (ALAS unsigned*)l, 16, 0, 0); }
__device__ __forceinline__ int crow(int r, int hi) { return (r & 3) + 8 * (r >> 2) + 4 * hi; }

template <int MIXER> __device__ __forceinline__ void attn_unit(const Frame& F, unsigned char* ldsg, int b, int h, int j, const float* inv_freq) {
    constexpr int DQK = MIXER == 0 ? 64 : 96, ND0 = DQK / 16;
    const int lane = F.lane, w = F.wave, r32 = lane & 31, hi = lane >> 5;
    ALAS unsigned char* lds = (ALAS unsigned char*)ldsg;
    const int NT = 4 * j + 5;
    const int p0q = NMETA + 256 * j + 32 * w, p = p0q + r32, Tmax = (p0q + 31) >> 6;
    const size_t rowb = (size_t)b * LP;
    const bf16* Vb = MIXER == 0 ? F.P + OFF_VA + 64 * h : F.QKVB + 768 + 128 * h + 64;
    const int vpitch = MIXER == 0 ? DINP : NMLA;
    const float cs = (MIXER == 0 ? 0.125f : 0.10206207261596577f) * LOG2E;
    ALAS float* tab = (ALAS float*)(lds + TABOFF); ALAS float* scr = (ALAS float*)(lds + SCROFF + w * 128);
    if (MIXER == 0 && F.tid < 128) tab[F.tid] = F.rel_bias[t5_bucket(F.tid) * 8 + h] * LOG2E;
    const float b31 = MIXER == 0 ? F.rel_bias[31 * 8 + h] * LOG2E : 0.f;
    const bf16* Kg = MIXER == 0 ? F.P + OFF_KA + 64 * h : F.QKVB + 768 + 128 * h;
    const unsigned kpitch = MIXER == 0 ? DINP : NMLA;
    const unsigned koff = (unsigned)(rowb + lane) * kpitch + 8u * w, peoff = (unsigned)(rowb + lane) * 32u + 8u * w;
    const unsigned voff = (unsigned)(rowb + 16 * (w & 3) + (lane >> 2)) * (unsigned)vpitch + (unsigned)((w >> 2) * 32 + (lane & 3) * 8);
#define ISSUE_TILE(T, slot) do { \
        glds16(Kg + (koff + (unsigned)(64 * (T)) * kpitch), lds + KOFF + (slot) * KSLOT + w * 1024); \
        if (MIXER == 1 && w < 4) glds16(F.KPER + (peoff + (unsigned)(64 * (T)) * 32u), lds + KOFF + (slot) * KSLOT + (8 + w) * 1024); \
        glds16(Vb + (voff + (unsigned)(64 * (T)) * (unsigned)vpitch), lds + VOFF + (slot) * VSLOT + w * 1024); } while (0)
    ISSUE_TILE(0, 0);
    bf16x8 qf[ND0];
    { const size_t qrow = rowb + p;
      const bf16* qp = MIXER == 0 ? F.P + qrow * DINP + OFF_QA + 64 * h : F.QKVB + qrow * NMLA + 96 * h;
#pragma unroll
      for (int d0 = 0; d0 < ND0; ++d0) qf[d0] = *(const bf16x8*)(qp + 16 * d0 + 8 * hi);
      if (MIXER == 1) {
        bf16x8 a = qf[4], c = qf[5];
#pragma unroll
        for (int jj = 0; jj < 8; ++jj) { const float x1 = bf2f((bf16)a[jj]), x2 = bf2f((bf16)c[jj]); const float ang = (float)p * inv_freq[8 * hi + jj]; const float co = cosf(ang), sn = sinf(ang);
            a[jj] = (short)f2bf(x1 * co - x2 * sn); c[jj] = (short)f2bf(x2 * co + x1 * sn); }
        qf[4] = a; qf[5] = c; } }
    const u64* bmrow = F.BM + ((size_t)b * SEQ + 256 * j + 32 * w + r32) * NW64;
    u64 mw_next = 0ull; if (MIXER == 0) mw_next = bmrow[0];
    f32x16 o0 = {}, o1 = {};
    float m = -1e30f, l = 0.f;
    for (int T = 0; T < NT; ++T) {
        const int slot = T & 1;
        asm volatile("s_waitcnt vmcnt(0)" ::: "memory");
        __syncthreads();
        const u64 mw = mw_next;
        if (T + 1 < NT) { ISSUE_TILE(T + 1, slot ^ 1); if (MIXER == 0 && T + 1 <= Tmax) mw_next = bmrow[T + 1]; }
        if (T <= Tmax) {
            f32x16 s0 = {}, s1 = {};
            const ALAS unsigned char* kp = lds + KOFF + slot * KSLOT + hi * 1024 + r32 * 16;
#pragma unroll
            for (int d0 = 0; d0 < ND0; ++d0) {
                const bf16x8 k0 = *(const ALAS bf16x8*)(kp + d0 * 2048), k1 = *(const ALAS bf16x8*)(kp + d0 * 2048 + 512);
                s0 = __builtin_amdgcn_mfma_f32_32x32x16_bf16(k0, qf[d0], s0, 0, 0, 0);
                s1 = __builtin_amdgcn_mfma_f32_32x32x16_bf16(k1, qf[d0], s1, 0, 0, 0);
            }
            const int dl = p - 64 * T - 4 * hi;
            const bool nearb = 64 * T + 63 > p0q - (MIXER == 0 ? 113 : 0);
            if (MIXER == 0) {
                const unsigned wl = (unsigned)mw >> (4 * hi), wh = (unsigned)(mw >> 32) >> (4 * hi);
                if (nearb) {
#pragma unroll
                    for (int r = 0; r < 16; ++r) { const int c = (r & 3) + 8 * (r >> 2);
                        const int i0 = min(max(dl - c, 0), 127), i1 = min(max(dl - c - 32, 0), 127);
                        s0[r] = ((wl >> c) & 1u) ? __builtin_fmaf(s0[r], cs, tab[i0]) : -INFINITY;
                        s1[r] = ((wh >> c) & 1u) ? __builtin_fmaf(s1[r], cs, tab[i1]) : -INFINITY; }
                } else {
#pragma unroll
                    for (int r = 0; r < 16; ++r) { const int c = (r & 3) + 8 * (r >> 2);
                        s0[r] = ((wl >> c) & 1u) ? __builtin_fmaf(s0[r], cs, b31) : -INFINITY;
                        s1[r] = ((wh >> c) & 1u) ? __builtin_fmaf(s1[r], cs, b31) : -INFINITY; }
                }
            } else {
                if (nearb) {
#pragma unroll
                    for (int r = 0; r < 16; ++r) { const int c = (r & 3) + 8 * (r >> 2);
                        s0[r] = (c > dl) ? -INFINITY : s0[r] * cs; s1[r] = (c + 32 > dl) ? -INFINITY : s1[r] * cs; }
                } else {
#pragma unroll
                    for (int r = 0; r < 16; ++r) { s0[r] *= cs; s1[r] *= cs; }
                }
            }
            float tmax = fmaxf(s0[0], s1[0]);
#pragma unroll
            for (int r = 1; r < 16; ++r) tmax = fmaxf(tmax, fmaxf(s0[r], s1[r]));
            tmax = fmaxf(tmax, __shfl_xor(tmax, 32));
            if (__any(tmax > m + 8.f)) {
                const float mn = fmaxf(m, tmax), al = __builtin_amdgcn_exp2f(m - mn);
                m = mn; l *= al;
                if (hi == 0) scr[r32] = al;
                asm volatile("s_waitcnt lgkmcnt(0)" ::: "memory");
#pragma unroll
                for (int r = 0; r < 16; ++r) { const float a = scr[crow(r, hi)]; o0[r] *= a; o1[r] *= a; }
            }
            float rs = 0.f;
#pragma unroll
            for (int r = 0; r < 16; ++r) { s0[r] = __builtin_amdgcn_exp2f(s0[r] - m); s1[r] = __builtin_amdgcn_exp2f(s1[r] - m); rs += s0[r] + s1[r]; }
            l += rs;
            bf16x8 pa[4];
#pragma unroll
            for (int ks = 0; ks < 4; ++ks) { u32x4 t;
#pragma unroll
                for (int i = 0; i < 4; ++i) { const float lo = (ks < 2) ? s0[8 * (ks & 1) + 2 * i] : s1[8 * (ks & 1) + 2 * i], hh = (ks < 2) ? s0[8 * (ks & 1) + 2 * i + 1] : s1[8 * (ks & 1) + 2 * i + 1]; t[i] = pg8::cvt_pk_bf16(lo, hh); }
                pa[ks] = __builtin_bit_cast(bf16x8, t); }
            const ALAS unsigned char* vb = lds + VOFF + slot * VSLOT + ((lane >> 4) & 1) * 32 + (lane & 3) * 8 + (4 * hi + ((lane & 15) >> 2)) * 64;
#pragma unroll
            for (int ks = 0; ks < 4; ++ks) {
                const s16x4 a0 = vtr(vb + ks * 1024), a1 = vtr(vb + ks * 1024 + 512), c0 = vtr(vb + 4096 + ks * 1024), c1 = vtr(vb + 4096 + ks * 1024 + 512);
                const bf16x8 v0 = (bf16x8){a0[0], a0[1], a0[2], a0[3], a1[0], a1[1], a1[2], a1[3]}, v1 = (bf16x8){c0[0], c0[1], c0[2], c0[3], c1[0], c1[1], c1[2], c1[3]};
                o0 = __builtin_amdgcn_mfma_f32_32x32x16_bf16(pa[ks], v0, o0, 0, 0, 0);
                o1 = __builtin_amdgcn_mfma_f32_32x32x16_bf16(pa[ks], v1, o1, 0, 0, 0);
            }
        }
    }
#undef ISSUE_TILE
    l += __shfl_xor(l, 32);
    if (hi == 0) scr[r32] = 1.f / l;
    asm volatile("s_waitcnt lgkmcnt(0)" ::: "memory");
    const int gcol = (MIXER == 0 ? OFF_GA : OFF_GB) + 64 * h + r32;
#pragma unroll
    for (int r = 0; r < 16; ++r) {
        const int q = crow(r, hi); const float rl = scr[q];
        const bf16* gp = F.P + (rowb + p0q + q) * DINP + gcol;
        const float g0 = bf2f(gp[0]), g1 = bf2f(gp[32]);
        const float y0 = o0[r] * rl * (g0 / (1.f + __expf(-g0))), y1 = o1[r] * rl * (g1 / (1.f + __expf(-g1)));
        bf16* op = F.MIX + ((size_t)b * SEQ + 256 * j + 32 * w + q) * DM + MIXER * 512 + 64 * h + r32;
        op[0] = (bf16)f2bf(y0); op[32] = (bf16)f2bf(y1);
        if ((r & 3) == 3) asm volatile("" ::: "memory");
    }
    asm volatile("s_waitcnt lgkmcnt(0)" ::: "memory");
    __syncthreads();
}
#undef ALAS
}

__device__ __forceinline__ void ph_attn_mfma(const Frame& F, unsigned char* lds, const float* inv_freq) {
    if (F.G == 256) {
        const int vcu = (F.bid % 8) * 32 + F.bid / 8, bh = vcu >> 3, s = vcu & 7, b = bh >> 3, h = bh & 7;
        for (int i = 0; i < 4; ++i) {
            const int j = i < 2 ? 15 - s : s;
            if ((i & 1) == 0) att::attn_unit<0>(F, lds, b, h, j, inv_freq); else att::attn_unit<1>(F, lds, b, h, j, inv_freq);
        }
    } else {
        for (int u = F.bid; u < 1024; u += F.G) {
            const int j = u & 15, h = (u >> 4) & 7, b = (u >> 7) & 3, mixer = u >> 9;
            if (mixer == 0) att::attn_unit<0>(F, lds, b, h, j, inv_freq); else att::attn_unit<1>(F, lds, b, h, j, inv_freq);
        }
    }
}

namespace idx {
#define ILAS __attribute__((address_space(3)))
typedef short bf16x8 __attribute__((ext_vector_type(8)));
typedef float f32x4 __attribute__((ext_vector_type(4)));
constexpr int NI = 33, QOFF = 0, COFF = 16384, IDX_LDS = COFF + 2 * 8 * 16 * 4;

__device__ __forceinline__ void index_unit(const Frame& F, unsigned char* ldsg, int b, int u) {
    const int lane = F.lane, w = F.wave, q = lane & 15, g = lane >> 4;
    ILAS unsigned char* lds = (ILAS unsigned char*)ldsg;
    ILAS int* cnt = (ILAS int*)(lds + COFF);
    const size_t rowb = (size_t)b * LP;
    const int p = NMETA + 16 * u + q;
    const int nkt = u + 2;
    const int ni = (nkt - w + 7) >> 3;
    const int nwrite = 16 * (u >> 4) + 20;
    { const bf16* qp = F.P + (rowb + p) * DINP + OFF_QI + 64 * w + 8 * g;
      *(ILAS bf16x8*)(lds + QOFF + ((w * 2 + 0) * 64 + lane) * 16) = *(const bf16x8*)(qp);
      *(ILAS bf16x8*)(lds + QOFF + ((w * 2 + 1) * 64 + lane) * 16) = *(const bf16x8*)(qp + 32); }
    float ch[8];
    { const v4u wv = *(const v4u*)(F.P + (rowb + p) * DINP + OFF_WI);
#pragma unroll
      for (int h = 0; h < 4; ++h) { ch[2 * h] = __uint_as_float(wv[h] << 16) * 0.35355339059327373f; ch[2 * h + 1] = __uint_as_float(wv[h] & 0xffff0000u) * 0.35355339059327373f; } }
    __syncthreads();
    unsigned kr[NI][4];
    const bf16* kbase = F.P + OFF_KI + 8 * g;
    const unsigned koff0 = (unsigned)(rowb + 16 * w + q) * DINP;
    bf16x8 kfa0, kfa1, kfb0, kfb1;
    const bf16* kptr = kbase + koff0;
    if (ni > 0) { kfa0 = *(const bf16x8*)(kptr); kfa1 = *(const bf16x8*)(kptr + 32); }
#pragma unroll
    for (int i = 0; i < NI; ++i) {
        if (i < ni) {
            kptr += 128 * DINP; asm volatile("" : "+v"(kptr));
            if (i + 1 < ni) { kfb0 = *(const bf16x8*)(kptr); kfb1 = *(const bf16x8*)(kptr + 32); }
            float sc0 = 0.f, sc1 = 0.f, sc2 = 0.f, sc3 = 0.f;
            unsigned qa = QOFF + lane * 16; asm volatile("" : "+v"(qa));
#pragma unroll
            for (int h = 0; h < 8; ++h) {
                const bf16x8 q0 = *(const ILAS bf16x8*)(lds + qa + (h * 2 + 0) * 1024), q1 = *(const ILAS bf16x8*)(lds + qa + (h * 2 + 1) * 1024);
                f32x4 acc = {0.f, 0.f, 0.f, 0.f};
                acc = __builtin_amdgcn_mfma_f32_16x16x32_bf16(kfa0, q0, acc, 0, 0, 0);
                acc = __builtin_amdgcn_mfma_f32_16x16x32_bf16(kfa1, q1, acc, 0, 0, 0);
                sc0 += fmaxf(acc[0] * 0.125f, 0.f) * ch[h]; sc1 += fmaxf(acc[1] * 0.125f, 0.f) * ch[h];
                sc2 += fmaxf(acc[2] * 0.125f, 0.f) * ch[h]; sc3 += fmaxf(acc[3] * 0.125f, 0.f) * ch[h];
            }
            int g4a = 4 * g; asm volatile("" : "+v"(g4a)); const int s0 = 16 * (w + 8 * i) + g4a;
            kr[i][0] = (s0 + 0 >= NMETA && s0 + 0 <= p) ? fkey(sc0) : 0u; kr[i][1] = (s0 + 1 >= NMETA && s0 + 1 <= p) ? fkey(sc1) : 0u;
            kr[i][2] = (s0 + 2 >= NMETA && s0 + 2 <= p) ? fkey(sc2) : 0u; kr[i][3] = (s0 + 3 >= NMETA && s0 + 3 <= p) ? fkey(sc3) : 0u;
            kfa0 = kfb0; kfa1 = kfb1;
        } else { kr[i][0] = 0u; kr[i][1] = 0u; kr[i][2] = 0u; kr[i][3] = 0u; }
    }
#define IDX_REDUCE(c, par, out) do { c += __shfl_xor(c, 16); c += __shfl_xor(c, 32); if (g == 0) cnt[((par) * 8 + w) * 16 + q] = c; \
        asm volatile("s_waitcnt lgkmcnt(0)" ::: "memory"); __syncthreads(); \
        out = 0; _Pragma("unroll") for (int ww = 0; ww < 8; ++ww) out += cnt[((par) * 8 + ww) * 16 + q]; } while (0)
    unsigned thr = 0u;
    for (int bit = 31; bit >= 0; --bit) {
        const unsigned cand = thr | (1u << bit); int c = 0;
#pragma unroll
        for (int i = 0; i < NI; ++i) if (i < ni) c += (int)(kr[i][0] >= cand) + (int)(kr[i][1] >= cand) + (int)(kr[i][2] >= cand) + (int)(kr[i][3] >= cand);
        int tot; IDX_REDUCE(c, bit & 1, tot);
        if (tot >= KSEL) thr = cand;
    }
    int sstar = LP;
    {   int c = 0;
#pragma unroll
        for (int i = 0; i < NI; ++i) if (i < ni) {
#pragma unroll
            for (int jj = 0; jj < 4; ++jj) c += (int)(kr[i][jj] >= thr) + ((int)(kr[i][jj] > thr) << 16); }
        int tot; IDX_REDUCE(c, 1, tot);
        const int cge = tot & 0xffff, cgt = tot >> 16;
        const bool tie = thr != 0u && cge > KSEL;
        if (__any(tie)) {
            const int need = KSEL - cgt; int lo = 0, hi = LP - 1;
            for (int it = 0; it < 13; ++it) {
                const int mid = (lo + hi) >> 1; int c2 = 0;
#pragma unroll
                for (int i = 0; i < NI; ++i) if (i < ni) { int g4b = 4 * g; asm volatile("" : "+v"(g4b));
#pragma unroll
                    for (int jj = 0; jj < 4; ++jj) c2 += (int)(kr[i][jj] == thr && 16 * (w + 8 * i) + g4b + jj <= mid); }
                int t2; IDX_REDUCE(c2, it & 1, t2);
                if (lo < hi) { if (t2 >= need) hi = mid; else lo = mid + 1; }
            }
            if (tie) sstar = lo;
        }
    }
    const unsigned te = thr == 0u ? 1u : thr;
    unsigned short* bm16 = (unsigned short*)(F.BM + ((size_t)b * SEQ + 16 * u + q) * NW64);
#pragma unroll
    for (int i = 0; i < NI; ++i) {
        const int kt = w + 8 * i;
        if (kt < nwrite) {
            unsigned nib = 0u; int g4c = 4 * g; asm volatile("" : "+v"(g4c));
#pragma unroll
            for (int jj = 0; jj < 4; ++jj) { const unsigned k = kr[i][jj]; const int s = 16 * kt + g4c + jj;
                const bool sel = (s < NMETA) || (k >= te && (k > thr || s <= sstar)); nib |= sel ? (1u << jj) : 0u; }
            unsigned v = nib << (4 * g); v |= __shfl_xor(v, 16); v |= __shfl_xor(v, 32);
            if (g == 0) bm16[kt] = (unsigned short)v;
        }
    }
#undef IDX_REDUCE
    __syncthreads();
}
#undef ILAS
}

__device__ __forceinline__ void ph_index_mfma(const Frame& F, unsigned char* lds) {
    if (F.G == 256) {
        const int b = F.bid >> 6, s = F.bid & 63;
        for (int i = 0; i < 4; ++i) { const int u = i == 0 ? 255 - s : i == 1 ? 128 + s : i == 2 ? 127 - s : s; idx::index_unit(F, lds, b, u); }
    } else {
        for (int t = F.bid; t < 1024; t += F.G) idx::index_unit(F, lds, t >> 8, t & 255);
    }
}

#define LAS __attribute__((address_space(3)))
#define XB_TMO      128
#define XB_XCNT(j)  (256  + 64 * (j))
#define XB_XSUB(j)  (1280 + 64 * (j))
#define XB_XGEN(j)  (2304 + 64 * (j))
#define XB_TOP      3328
#define XB_TOPGEN   3392
#define XCD_BAR_WORDS 3456
#define XB_SPIN_CAP (1u << 18)

__device__ __forceinline__ unsigned xb_ld(unsigned* p)              { return __hip_atomic_load(p, __ATOMIC_RELAXED, __HIP_MEMORY_SCOPE_AGENT); }
__device__ __forceinline__ unsigned xb_add(unsigned* p, unsigned v) { return __hip_atomic_fetch_add(p, v, __ATOMIC_RELAXED, __HIP_MEMORY_SCOPE_AGENT); }
__device__ __forceinline__ unsigned xb_xcc_id() { return (unsigned)__builtin_amdgcn_s_getreg((3 << 11) | 20) & 0xFu; }
#define XB_SPIN(cond, bar) do { unsigned _sp = 0; while (cond) { __builtin_amdgcn_s_sleep(1); \
    if ((++_sp & 255u) == 0u) { if (xb_ld(&(bar)[XB_TMO])) break; if (_sp > XB_SPIN_CAP) { atomicAdd(&(bar)[XB_TMO], 1u); break; } } } } while (0)

struct XcdBarrier {
    unsigned* bar; unsigned x;
    volatile LAS unsigned* st;
};

__device__ __forceinline__ XcdBarrier xcd_barrier_post(unsigned* bar, volatile LAS unsigned* st) {
    XcdBarrier b; b.bar = bar; b.x = xb_xcc_id(); b.st = st;
    if (threadIdx.x == 0) (void)xb_add(&bar[XB_XCNT(b.x)], 1u);
    return b;
}
__device__ __forceinline__ void xcd_barrier_complete(unsigned* bar, unsigned x, unsigned& nloc, unsigned& nx) {
    const unsigned G = gridDim.x * gridDim.y * gridDim.z;
    unsigned sum, cnt, mine, sp = 0u;
    for (;;) {
        sum = 0u; cnt = 0u; mine = 0u;
#pragma unroll
        for (unsigned j = 0; j < 16; ++j) { const unsigned c = xb_ld(&bar[XB_XCNT(j)]); sum += c; cnt += (c > 0u) ? 1u : 0u; mine = (j == x) ? c : mine; }
        if (sum == G) break;
        __builtin_amdgcn_s_sleep(1);
        if ((++sp & 255u) == 0u) { if (xb_ld(&bar[XB_TMO])) break; if (sp > XB_SPIN_CAP) { atomicAdd(&bar[XB_TMO], 1u); break; } }
    }
    nloc = mine > 0u ? mine : 1u; nx = cnt > 0u ? cnt : 1u;
}

__device__ __forceinline__ void xcd_barrier(const XcdBarrier& b) {
    asm volatile("s_waitcnt vmcnt(0)" ::: "memory");
    __syncthreads();
    if (threadIdx.x == 0) {
        unsigned* bar = b.bar;
        __builtin_amdgcn_s_waitcnt(0);
        unsigned nloc = b.st[0], nx = b.st[1];
        if (nloc == 0u) { xcd_barrier_complete(bar, b.x, nloc, nx); b.st[0] = nloc; b.st[1] = nx; }
        const unsigned old = xb_add(&bar[XB_XSUB(b.x)], 1u);
        const unsigned gen = old / nloc;
        if (old + 1u == (gen + 1u) * nloc) {
            __builtin_amdgcn_fence(__ATOMIC_RELEASE, "agent");
            asm volatile("s_waitcnt vmcnt(0)" ::: "memory");
            const unsigned og = xb_add(&bar[XB_TOP], 1u);
            const unsigned tg = og / nx;
            if (og + 1u == (tg + 1u) * nx) xb_add(&bar[XB_TOPGEN], 1u);
            else XB_SPIN(xb_ld(&bar[XB_TOPGEN]) == tg, bar);
            __builtin_amdgcn_fence(__ATOMIC_ACQUIRE, "agent");
            xb_add(&bar[XB_XGEN(b.x)], 1u);
            asm volatile("s_waitcnt vmcnt(0)" ::: "memory");
        } else {
            XB_SPIN(xb_ld(&bar[XB_XGEN(b.x)]) == gen, bar);
            __builtin_amdgcn_fence(__ATOMIC_ACQUIRE, "agent");
            asm volatile("s_waitcnt vmcnt(0)" ::: "memory");
        }
    }
    __syncthreads();
}

constexpr int LDS_BYTES = 147456, MISC_OFF = 131072 + 320;
__global__ void __launch_bounds__(512, 2) fwd(Args args) {
    extern __shared__ __attribute__((aligned(16))) unsigned char lds[];
    Frame F;
    F.tid = threadIdx.x; F.lane = F.tid & 63; F.wave = __builtin_amdgcn_readfirstlane(F.tid >> 6); F.G = gridDim.x; F.bid = blockIdx.x;
    F.x = args.in[0]; F.meta = args.in[1]; F.lne_g = args.in[2]; F.lne_b = args.in[3]; F.w_in = args.in[4]; F.w_uq = args.in[5]; F.qn_g = args.in[6];
    F.w_ukv = args.in[7]; F.kvn_g = args.in[8]; F.rel_bias = args.in[9]; F.w_out = args.in[10]; F.lnp_g = args.in[11]; F.lnp_b = args.in[12];
    F.out = args.out;
    unsigned char* ws = args.ws;
    F.Win_t = (bf16*)(ws + WS_WIN); F.Wmla_t = (bf16*)(ws + WS_WMLA); F.Wout_t = (bf16*)(ws + WS_WOUT); F.KPER = (bf16*)(ws + WS_KPER);
    F.BM = (u64*)(ws + WS_BM); F.CQKVN = (bf16*)(ws + WS_CQKVN); F.XN = (bf16*)(ws + WS_XN); F.MIX = (bf16*)(ws + WS_XN);
    F.QKVB = (bf16*)(ws + WS_QKVB); F.P = (bf16*)(ws + WS_P); F.Z = (float*)(ws + WS_P);
    const int lo = args.ph_lo, hi = args.ph_hi;
    volatile LAS unsigned* MISC = (volatile LAS unsigned*)((LAS unsigned char*)lds + MISC_OFF);
    if (F.tid < 32) MISC[F.tid] = 0u;
    __syncthreads();
    XcdBarrier bar = xcd_barrier_post((unsigned*)(ws + WS_CTL) + 4096, MISC + 8);
#define IN(k) (lo <= (k) && (k) < hi)
#define SEAM(k) do { if (IN(k) && IN((k) + 1)) xcd_barrier(bar); } while (0)
    if (IN(0)) ph_prologue(F, (float*)lds);
    SEAM(0);
    PG8_LAS unsigned char* ring = (PG8_LAS unsigned char*)lds;
    if (IN(1)) { pg8::Gemm g{F.XN, F.Win_t, MROWS, DINP, DM}; pg8::StaticOrder S; S.init(MROWS, DINP, F.G, F.bid); pg8::EpiBf16 E{F.P, DINP};
        pg8::gemm_phase<pg8::EpiBf16, pg8::StaticOrder, true, true>(ring, g, S, E); }
    SEAM(1);
    if (IN(2)) ph_rms(F, args.inv_freq);
    SEAM(2);
    if (IN(3)) { { pg8::Gemm g{F.CQKVN, F.Wmla_t, MROWS, NMLA, KMLA}; pg8::StaticOrder S; S.init(MROWS, NMLA, F.G, F.bid); pg8::EpiBf16 E{F.QKVB, NMLA};
        pg8::gemm_phase<pg8::EpiBf16, pg8::StaticOrder, true, true>(ring, g, S, E); }
        __syncthreads(); ph_index_mfma(F, lds); }
    SEAM(3);
    if (IN(4)) ph_attn_mfma(F, lds, args.inv_freq);
    SEAM(4);
    if (IN(5)) { pg8::Gemm g{F.MIX, F.Wout_t, MQ, DM, DM}; pg8::StaticOrder S; S.init(MQ, DM, F.G, F.bid); pg8::EpiF32 E{F.Z, DM, nullptr};
        pg8::gemm_phase<pg8::EpiF32, pg8::StaticOrder, true, true>(ring, g, S, E); }
    SEAM(5);
    if (IN(6)) ph_final(F);
#undef IN
#undef SEAM
}

#ifndef MK_N_LAUNCHES
#define MK_N_LAUNCHES 1
#endif
extern "C" void kernel_launch(void* const* d_in, const int* in_sizes, int n_in, void* d_out, int out_size, void* d_ws, size_t ws_size, hipStream_t stream) {
    static int grid_blocks = 0;
    if (!grid_blocks) {
        if (n_in != 13 || out_size != MQ * DM || ws_size < WS_END) { fprintf(stderr, "kernel_launch: unexpected shapes (n_in %d out %d ws %zu)\n", n_in, out_size, ws_size); grid_blocks = -1; return; }
        if (hipFuncSetAttribute((const void*)fwd, hipFuncAttributeMaxDynamicSharedMemorySize, LDS_BYTES) != hipSuccess) { fprintf(stderr, "kernel_launch: hipFuncSetAttribute failed\n"); grid_blocks = -1; return; }
        int dev = 0, cus = 0, per_cu = 0;
        (void)hipGetDevice(&dev);
        (void)hipDeviceGetAttribute(&cus, hipDeviceAttributeMultiprocessorCount, dev);
        (void)hipOccupancyMaxActiveBlocksPerMultiprocessor(&per_cu, (const void*)fwd, 512, LDS_BYTES);
        if (per_cu < 1 || cus < 1) { fprintf(stderr, "kernel_launch: occupancy query says %d blocks/CU on %d CUs\n", per_cu, cus); grid_blocks = -1; return; }
        grid_blocks = cus;
    }
    if (grid_blocks < 0) return;
    Args a{};
    for (int i = 0; i < 13; ++i) a.in[i] = (const float*)d_in[i];
    a.out = (float*)d_out; a.ws = (unsigned char*)d_ws;
    for (int i = 0; i < 16; ++i) a.inv_freq[i] = (float)pow(10000.0, -(double)(2 * i) / 32.0);
    (void)hipMemsetAsync((char*)d_ws + WS_CTL, 0, 65536, stream);
    a.ph_lo = 0; a.ph_hi = 7;
    hipLaunchKernelGGL(fwd, dim3(grid_blocks), dim3(512), LDS_BYTES, stream, a);
}
```

```cpp
#include <hip/hip_runtime.h>
#include <cstdio>
#include <cstdint>
#include <cmath>

constexpr int BATCH = 4, SEQ = 4096, DM = 1024, NMETA = 16;
constexpr int LTOK = NMETA + SEQ;
constexpr int LP = 4160;
constexpr int MROWS = BATCH * LP;
constexpr int MQ = BATCH * SEQ;
constexpr int DIN = 3560, DINP = 3584;
constexpr int OFF_QA = 0, OFF_KA = 512, OFF_VA = 1024, OFF_GA = 1536, OFF_QI = 2048, OFF_KI = 2560, OFF_WI = 2624,
              OFF_CQ = 2632, OFF_CKV = 2888, OFF_KPE = 3016, OFF_GB = 3048;
constexpr int KMLA = 384, NMLA = 1792;
constexpr int TOPK = 256, KSEL = TOPK - NMETA;
constexpr int NW64 = LP / 64;
constexpr float LN_EPS = 1e-5f, RMS_EPS = 1e-6f;
constexpr float ALPHA = 1.189207115002721f;

constexpr size_t MiB = 1u << 20;
constexpr size_t WS_CTL = 0;
constexpr size_t WS_WIN = 2 * MiB;
constexpr size_t WS_WMLA = 9 * MiB;
constexpr size_t WS_WOUT = 11 * MiB;
constexpr size_t WS_KPER = 13 * MiB;
constexpr size_t WS_BM = 15 * MiB;
constexpr size_t WS_CQKVN = 24 * MiB;
constexpr size_t WS_XN = 37 * MiB;
constexpr size_t WS_QKVB = 70 * MiB;
constexpr size_t WS_P = 127 * MiB;
constexpr size_t WS_END = 241 * MiB;

typedef unsigned short bf16;
typedef unsigned long long u64;
typedef unsigned v4u __attribute__((ext_vector_type(4)));
typedef float f32x4 __attribute__((ext_vector_type(4)));

__device__ __forceinline__ float bf2f(bf16 v) { return __uint_as_float((unsigned)v << 16); }
__device__ __forceinline__ unsigned f2bf(float f) { unsigned u = __float_as_uint(f); return (u + 0x7fffu + ((u >> 16) & 1u)) >> 16; }
__device__ __forceinline__ unsigned pk2(float lo, float hi) { return f2bf(lo) | (f2bf(hi) << 16); }
__device__ __forceinline__ float wave_sum(float v) {
#pragma unroll
    for (int o = 1; o < 64; o <<= 1) v += __shfl_xor(v, o);
    return v;
}
__device__ __forceinline__ float wave_max(float v) {
#pragma unroll
    for (int o = 1; o < 64; o <<= 1) v = fmaxf(v, __shfl_xor(v, o));
    return v;
}
__device__ __forceinline__ int wave_isum(int v) {
#pragma unroll
    for (int o = 1; o < 64; o <<= 1) v += __shfl_xor(v, o);
    return v;
}
__device__ __forceinline__ int t5_bucket(int d) {
    if (d < 16) return d < 0 ? 0 : d;
    return 16 + (d >= 19) + (d >= 21) + (d >= 24) + (d >= 27) + (d >= 31) + (d >= 35) + (d >= 40) + (d >= 46) + (d >= 52) + (d >= 59) + (d >= 67) + (d >= 77) + (d >= 87) + (d >= 99) + (d >= 113);
}
__device__ __forceinline__ unsigned fkey(float f) { unsigned u = __float_as_uint(f); return (u & 0x80000000u) ? ~u : (u | 0x80000000u); }

struct Args {
    const float* in[13];
    float* out;
    unsigned char* ws;
    float inv_freq[16];
    int ph_lo, ph_hi;
};

struct Frame {
    int tid, lane, wave, G, bid;
    const float *x, *meta, *lne_g, *lne_b, *w_in, *w_uq, *qn_g, *w_ukv, *kvn_g, *rel_bias, *w_out, *lnp_g, *lnp_b;
    float* out;
    bf16 *Win_t, *Wmla_t, *Wout_t, *KPER, *CQKVN, *XN, *MIX, *QKVB, *P;
    u64* BM;
    float* Z;
};

template <class F> __device__ __forceinline__ void transpose_tile(F src, bf16* dst, int ldk, int n0, int k0, float* scr, int tid) {
    const int ty = tid >> 6, tx = tid & 63;
#pragma unroll
    for (int i = 0; i < 8; ++i) { const int k = ty + 8 * i; scr[k * 65 + tx] = src(k0 + k, n0 + tx); }
    __syncthreads();
    const int nn = tid >> 3, kc = tid & 7;
    v4u o; o.x = pk2(scr[(8 * kc + 0) * 65 + nn], scr[(8 * kc + 1) * 65 + nn]); o.y = pk2(scr[(8 * kc + 2) * 65 + nn], scr[(8 * kc + 3) * 65 + nn]);
    o.z = pk2(scr[(8 * kc + 4) * 65 + nn], scr[(8 * kc + 5) * 65 + nn]); o.w = pk2(scr[(8 * kc + 6) * 65 + nn], scr[(8 * kc + 7) * 65 + nn]);
    *(v4u*)(dst + (size_t)(n0 + nn) * ldk + k0 + 8 * kc) = o;
    __syncthreads();
}
__device__ __forceinline__ void ph_prologue(const Frame& F, float* lds) {
    constexpr int I_IN = (DINP / 64) * (DM / 64), I_MLA = (NMLA / 64) * (KMLA / 64), I_OUT = (DM / 64) * (DM / 64);
    for (int it = F.bid; it < I_IN + I_MLA + I_OUT; it += F.G) {
        if (it < I_IN) {
            const int n0 = (it / (DM / 64)) * 64, k0 = (it % (DM / 64)) * 64; const float* w = F.w_in;
            transpose_tile([=](int k, int n) { return n < DIN ? w[(size_t)k * DIN + n] : 0.f; }, F.Win_t, DM, n0, k0, lds, F.tid);
        } else if (it < I_IN + I_MLA) {
            const int r = it - I_IN, n0 = (r / (KMLA / 64)) * 64, k0 = (r % (KMLA / 64)) * 64;
            const float *wq = F.w_uq, *wkv = F.w_ukv, *gq = F.qn_g, *gkv = F.kvn_g;
            transpose_tile([=](int k, int n) {
                if (n < 768) return k < 256 ? wq[(size_t)k * 768 + n] * gq[k] : 0.f;
                return k >= 256 ? wkv[(size_t)(k - 256) * 1024 + (n - 768)] * gkv[k - 256] : 0.f; }, F.Wmla_t, KMLA, n0, k0, lds, F.tid);
        } else {
            const int r = it - I_IN - I_MLA, n0 = (r / (DM / 64)) * 64, k0 = (r % (DM / 64)) * 64; const float* w = F.w_out;
            transpose_tile([=](int k, int n) { return w[(size_t)k * DM + n]; }, F.Wout_t, DM, n0, k0, lds, F.tid);
        }
    }
    const int gw = F.bid * 8 + F.wave, NGW = F.G * 8;
    for (int m = gw; m < MROWS; m += NGW) {
        const int b = m / LP, p = m % LP;
        unsigned long long* o8 = (unsigned long long*)(F.XN + (size_t)m * DM) + F.lane;
        if (p >= LTOK) {
#pragma unroll
            for (int j = 0; j < 4; ++j) o8[64 * j] = 0ull;
            continue;
        }
        const float* src = p < NMETA ? F.meta + (size_t)p * DM : F.x + ((size_t)b * SEQ + (p - NMETA)) * DM;
        const f32x4* xr = (const f32x4*)src + F.lane;
        f32x4 v[4]; float s = 0.f;
#pragma unroll
        for (int j = 0; j < 4; ++j) { v[j] = xr[64 * j]; s += (v[j].x + v[j].y) + (v[j].z + v[j].w); }
        const float mean = wave_sum(s) * (1.f / DM); float s2 = 0.f;
#pragma unroll
        for (int j = 0; j < 4; ++j) { v[j] = v[j] - mean; s2 += (v[j].x * v[j].x + v[j].y * v[j].y) + (v[j].z * v[j].z + v[j].w * v[j].w); }
        const float rstd = 1.f / sqrtf(wave_sum(s2) * (1.f / DM) + LN_EPS);
#pragma unroll
        for (int j = 0; j < 4; ++j) {
            const f32x4 g = ((const f32x4*)F.lne_g)[F.lane + 64 * j], bb = ((const f32x4*)F.lne_b)[F.lane + 64 * j];
            const f32x4 y = v[j] * rstd * g + bb;
            o8[64 * j] = (unsigned long long)pk2(y.x, y.y) | ((unsigned long long)pk2(y.z, y.w) << 32);
        }
    }
}

__device__ __forceinline__ void ph_rms(const Frame& F, const float* inv_freq) {
    const int gw = F.bid * 8 + F.wave, NGW = F.G * 8, lane = F.lane;
    for (int m = gw; m < MROWS; m += NGW) {
        const bf16* pr = F.P + (size_t)m * DINP; const int p = m % LP;
        const unsigned long long cq4 = *(const unsigned long long*)(pr + OFF_CQ + 4 * lane);
        const unsigned ckv2 = *(const unsigned*)(pr + OFF_CKV + 2 * lane);
        float c[4] = {bf2f((bf16)(cq4 & 0xffff)), bf2f((bf16)((cq4 >> 16) & 0xffff)), bf2f((bf16)((cq4 >> 32) & 0xffff)), bf2f((bf16)(cq4 >> 48))};
        float d[2] = {bf2f((bf16)(ckv2 & 0xffff)), bf2f((bf16)(ckv2 >> 16))};
        const float sq = wave_sum(c[0] * c[0] + c[1] * c[1] + c[2] * c[2] + c[3] * c[3]), skv = wave_sum(d[0] * d[0] + d[1] * d[1]);
        const float rq = 1.f / sqrtf(sq * (1.f / 256.f) + RMS_EPS), rkv = 1.f / sqrtf(skv * (1.f / 128.f) + RMS_EPS);
        bf16* o = F.CQKVN + (size_t)m * KMLA;
        *(unsigned long long*)(o + 4 * lane) = (unsigned long long)pk2(c[0] * rq, c[1] * rq) | ((unsigned long long)pk2(c[2] * rq, c[3] * rq) << 32);
        *(unsigned*)(o + 256 + 2 * lane) = pk2(d[0] * rkv, d[1] * rkv);
        if (lane < 16) {
            const float x1 = bf2f(pr[OFF_KPE + lane]), x2 = bf2f(pr[OFF_KPE + 16 + lane]);
            const float ang = (float)p * inv_freq[lane]; const float cs = cosf(ang), sn = sinf(ang);
            F.KPER[(size_t)m * 32 + lane] = (bf16)f2bf(x1 * cs - x2 * sn); F.KPER[(size_t)m * 32 + 16 + lane] = (bf16)f2bf(x2 * cs + x1 * sn);
        }
    }
}

__device__ __forceinline__ void ph_final(const Frame& F) {
    const int gw = F.bid * 8 + F.wave, NGW = F.G * 8, lane = F.lane;
    for (int m = gw; m < MQ; m += NGW) {
        const f32x4* xr = (const f32x4*)(F.x + (size_t)m * DM) + lane; const f32x4* zr = (const f32x4*)(F.Z + (size_t)m * DM) + lane;
        f32x4 v[4]; float s = 0.f;
#pragma unroll
        for (int j = 0; j < 4; ++j) { v[j] = xr[64 * j]; s += (v[j].x + v[j].y) + (v[j].z + v[j].w); }
        const float mean = wave_sum(s) * (1.f / DM); float s2 = 0.f;
#pragma unroll
        for (int j = 0; j < 4; ++j) { v[j] = v[j] - mean; s2 += (v[j].x * v[j].x + v[j].y * v[j].y) + (v[j].z * v[j].z + v[j].w * v[j].w); }
        const float rstd = 1.f / sqrtf(wave_sum(s2) * (1.f / DM) + LN_EPS);
        float t = 0.f;
#pragma unroll
        for (int j = 0; j < 4; ++j) {
            const f32x4 g = ((const f32x4*)F.lne_g)[lane + 64 * j], bb = ((const f32x4*)F.lne_b)[lane + 64 * j];
            v[j] = (v[j] * rstd * g + bb) * ALPHA + zr[64 * j];
            t += (v[j].x + v[j].y) + (v[j].z + v[j].w);
        }
        const float mean2 = wave_sum(t) * (1.f / DM); float t2 = 0.f;
#pragma unroll
        for (int j = 0; j < 4; ++j) { v[j] = v[j] - mean2; t2 += (v[j].x * v[j].x + v[j].y * v[j].y) + (v[j].z * v[j].z + v[j].w * v[j].w); }
        const float rstd2 = 1.f / sqrtf(wave_sum(t2) * (1.f / DM) + LN_EPS);
        f32x4* o = (f32x4*)(F.out + (size_t)m * DM) + lane;
#pragma unroll
        for (int j = 0; j < 4; ++j) {
            const f32x4 g = ((const f32x4*)F.lnp_g)[lane + 64 * j], bb = ((const f32x4*)F.lnp_b)[lane + 64 * j];
            o[64 * j] = v[j] * rstd2 * g + bb;
        }
    }
}

namespace pg8 {
#define PG8_LAS __attribute__((address_space(3)))
typedef unsigned short bf16_t;
typedef short bf16x8 __attribute__((ext_vector_type(8)));
typedef float f32x4 __attribute__((ext_vector_type(4)));
typedef unsigned u32x4 __attribute__((ext_vector_type(4)));
constexpr int BM = 256, BK = 64, HALF = 128, HTB = HALF * BK * 2  , STAGE_BYTES = 8 * HTB, NXCD = 8, WGM = 8;

__host__ __device__ __forceinline__ int lds_byte(int r, int c) { const int st = (r >> 4) * 2 + (c >> 5), rr = r & 15, cc = c & 31, ob = rr * 64 + cc * 2; return st * 1024 + (ob ^ (((ob >> 9) & 1) << 5)); }
__host__ __device__ __forceinline__ void stage_rc(int b, int& R, int& C) { const int st = b / 1024, sb = b % 1024, swz = sb ^ (((sb >> 9) & 1) << 5); R = (st >> 1) * 16 + swz / 64; C = (st & 1) * 32 + (swz % 64) / 2; }
__host__ __device__ __forceinline__ int perm32(int rho) { const int n = rho >> 4, i = rho & 15; return 8 * (i >> 2) + 4 * n + (i & 3); }

struct Unit { int pm, pn; };
struct Gemm { const bf16_t* A; const bf16_t* Bt; int M, N, K; };

struct StaticOrder {
    int nM, nN, nwg, G, c;
    __host__ __device__ void init(int M, int N, int G_, int c_) { nM = M / BM; nN = N / BM; nwg = nM * nN; G = G_; c = c_; }
    __host__ __device__ bool next(int i, Unit& u) const {
        const long L = (long)i * G + c; if (L >= nwg) return false;
        int wgid = (int)L; { const int q = nwg / NXCD, r = nwg % NXCD, xcd = wgid % NXCD, off = wgid / NXCD; wgid = (xcd < r ? xcd * (q + 1) : r * (q + 1) + (xcd - r) * q) + off; }
        const int nig = WGM * nN, gid = wgid / nig, fm = gid * WGM, gsz = (nM - fm) < WGM ? (nM - fm) : WGM;
        u.pm = fm + ((wgid % nig) % gsz); u.pn = (wgid % nig) / gsz; return true;
    }
    __device__ __forceinline__ void a_ready(const Unit&) const {}
    __device__ __forceinline__ void done(const Unit&) const {}
};

__device__ __forceinline__ unsigned cvt_pk_bf16(float lo, float hi) { unsigned r; asm volatile("v_cvt_pk_bf16_f32 %0, %1, %2" : "=v"(r) : "v"(lo), "v"(hi)); return r; }

struct EpiBf16 {
    static constexpr bool PERM = true, AFTER_DRAIN = false;
    bf16_t* O; int ldc;
    __device__ __forceinline__ void operator()(const f32x4 (&acc)[2][2][4][2], const Unit& u, int wr, int wc, int fr, int fq) const {
        const int row0 = u.pm * BM + wr * 64 + fr, col0 = u.pn * BM + wc * 32 + 8 * fq;
#pragma unroll
        for (int ai = 0; ai < 2; ++ai)
#pragma unroll
            for (int m = 0; m < 4; ++m) { bf16_t* rowp = O + (size_t)(row0 + ai * HALF + m * 16) * ldc + col0;
#pragma unroll
                for (int bj = 0; bj < 2; ++bj) { const f32x4 v0 = acc[ai][bj][m][0], v1 = acc[ai][bj][m][1];
                    u32x4 w; w.x = cvt_pk_bf16(v0[0], v0[1]); w.y = cvt_pk_bf16(v0[2], v0[3]); w.z = cvt_pk_bf16(v1[0], v1[1]); w.w = cvt_pk_bf16(v1[2], v1[3]);
                    *(u32x4*)(rowp + bj * HALF) = w; } }
    }
};
struct EpiF32 {
    static constexpr bool PERM = false, AFTER_DRAIN = false;
    float* C; int ldc; const float* bias;
    __device__ __forceinline__ void operator()(const f32x4 (&acc)[2][2][4][2], const Unit& u, int wr, int wc, int fr, int fq) const {
        const int row0 = u.pm * BM + wr * 64 + fr, col0 = u.pn * BM + wc * 32 + 4 * fq;
        f32x4 bv[2][2];
#pragma unroll
        for (int bj = 0; bj < 2; ++bj)
#pragma unroll
            for (int n = 0; n < 2; ++n) bv[bj][n] = bias ? *(const f32x4*)(bias + col0 + bj * HALF + n * 16) : (f32x4){0.f, 0.f, 0.f, 0.f};
#pragma unroll
        for (int ai = 0; ai < 2; ++ai)
#pragma unroll
            for (int m = 0; m < 4; ++m) { float* rowp = C + (size_t)(row0 + ai * HALF + m * 16) * ldc + col0;
#pragma unroll
                for (int bj = 0; bj < 2; ++bj)
#pragma unroll
                    for (int n = 0; n < 2; ++n) *(f32x4*)(rowp + bj * HALF + n * 16) = acc[ai][bj][m][n] + bv[bj][n]; }
    }
};
template <class Epi, class Sched, bool ALIGN_EPI = false, bool SP2 = false>
__device__ __forceinline__ void gemm_phase(PG8_LAS unsigned char* lds, const Gemm g, const Sched& S, const Epi& E) {
    const int tid = threadIdx.x, wid = __builtin_amdgcn_readfirstlane(tid >> 6), lane = tid & 63, wr = wid >> 2, wc = wid & 3, fr = lane & 15, fq = lane >> 4;
    const int K = g.K, nt = K / BK;
    unsigned voffA[2], voffB[2];
#pragma unroll
    for (int i = 0; i < 2; ++i) { int R, C; stage_rc(tid * 16 + i * 8192, R, C); const int Rb = Epi::PERM ? ((R & ~31) + perm32(R & 31)) : R;
        voffA[i] = (unsigned)(R * K + C) * 2u; voffB[i] = (unsigned)(Rb * K + C) * 2u; }
    const size_t kstep = (size_t)(BK * 2);
    const size_t hstep = (size_t)HALF * K * 2;
    const size_t tstep = 2 * hstep;
    const unsigned ldsw = (unsigned)wid * 1024u;
    const int aoff = lds_byte(wr * 64 + fr, fq * 8), boff = lds_byte(wc * 32 + fr, fq * 8);
#define PG8_SA(b, h) (((b) * 2 + (h)) * HTB)
#define PG8_SB(b, h) ((4 + (b) * 2 + (h)) * HTB)
#define PG8_STAGE(bufoff, gbase, voff) do { _Pragma("unroll") for (int _i = 0; _i < 2; ++_i) \
        __builtin_amdgcn_global_load_lds((const unsigned*)((const char*)(gbase) + (voff)[_i]), (PG8_LAS unsigned*)(lds + (bufoff) + ldsw + _i * 8192), 16, 0, 0); } while (0)
#define PG8_LDA(dst, b, h) do { _Pragma("unroll") for (int m = 0; m < 4; ++m) _Pragma("unroll") for (int k = 0; k < 2; ++k) dst[m][k] = *(const PG8_LAS bf16x8*)(lds + PG8_SA(b, h) + aoff + m * 2048 + k * 1024); } while (0)
#define PG8_LDB(dst, b, h) do { _Pragma("unroll") for (int n = 0; n < 2; ++n) _Pragma("unroll") for (int k = 0; k < 2; ++k) dst[n][k] = *(const PG8_LAS bf16x8*)(lds + PG8_SB(b, h) + boff + n * 2048 + k * 1024); } while (0)
#define PG8_MMA(ai, bj, At, Bt) do { __builtin_amdgcn_s_setprio(1); _Pragma("unroll") for (int m = 0; m < 4; ++m) _Pragma("unroll") for (int n = 0; n < 2; ++n) _Pragma("unroll") for (int k = 0; k < 2; ++k) \
        acc[ai][bj][m][n] = __builtin_amdgcn_mfma_f32_16x16x32_bf16(Bt[n][k], At[m][k], acc[ai][bj][m][n], 0, 0, 0); __builtin_amdgcn_s_setprio(0); } while (0)
#define PG8_WAIT_V(n) asm volatile("s_waitcnt vmcnt(" #n ")" ::: "memory")
#define PG8_WAIT_L(n) asm volatile("s_waitcnt lgkmcnt(" #n ")" ::: "memory")
#define PG8_BAR __builtin_amdgcn_s_barrier()
#define PG8_SCHED __builtin_amdgcn_sched_barrier(0)
    Unit cur, nxt; int ui = 0;
    if (!S.next(0, cur)) return;
    f32x4 acc[2][2][4][2];
#pragma unroll
    for (int a = 0; a < 2; ++a)
#pragma unroll
        for (int b = 0; b < 2; ++b)
#pragma unroll
            for (int m = 0; m < 4; ++m)
#pragma unroll
                for (int n = 0; n < 2; ++n) acc[a][b][m][n] = (f32x4){0.f, 0.f, 0.f, 0.f};
    bf16x8 At[4][2], B0[2][2], B1[2][2];
    const char* cA = (const char*)g.A + (size_t)cur.pm * tstep; const char* cB = (const char*)g.Bt + (size_t)cur.pn * tstep;
    S.a_ready(cur);
    if constexpr (SP2) {
        PG8_STAGE(PG8_SB(0, 0), cB, voffB); PG8_STAGE(PG8_SB(0, 1), cB + hstep, voffB); PG8_STAGE(PG8_SA(0, 0), cA, voffA); PG8_STAGE(PG8_SA(0, 1), cA + hstep, voffA);
        if (wr == 1) PG8_BAR;
        PG8_WAIT_V(2); PG8_BAR;
        PG8_STAGE(PG8_SB(1, 0), cB + kstep, voffB); PG8_STAGE(PG8_SA(1, 0), cA + kstep, voffA); PG8_STAGE(PG8_SB(1, 1), cB + hstep + kstep, voffB);
        PG8_WAIT_V(6); PG8_BAR;
    } else {
        PG8_STAGE(PG8_SB(0, 0), cB, voffB); PG8_STAGE(PG8_SA(0, 0), cA, voffA); PG8_STAGE(PG8_SB(0, 1), cB + hstep, voffB); PG8_STAGE(PG8_SA(0, 1), cA + hstep, voffA);
        if (wr == 1) PG8_BAR;
        PG8_WAIT_V(4); PG8_BAR;
        PG8_STAGE(PG8_SB(1, 0), cB + kstep, voffB); PG8_STAGE(PG8_SA(1, 0), cA + kstep, voffA); PG8_STAGE(PG8_SB(1, 1), cB + hstep + kstep, voffB);
        PG8_WAIT_V(6); PG8_BAR;
    }
    for (;;) {
        const bool has_next = S.next(ui + 1, nxt);
        const char* nA = has_next ? (const char*)g.A + (size_t)nxt.pm * tstep : cA; const char* nB = has_next ? (const char*)g.Bt + (size_t)nxt.pn * tstep : cB;
        for (int t = 0; t < nt; t += 2) {
            const bool last = (t == nt - 2);
            const char* a1 = cA + (size_t)(t + 1) * kstep;
            const char* a2 = last ? nA : cA + (size_t)(t + 2) * kstep; const char* b2 = last ? nB : cB + (size_t)(t + 2) * kstep;
            const char* a3 = a2 + kstep; const char* b3 = b2 + kstep;
            if (last && has_next) S.a_ready(nxt);
            if constexpr (SP2) {
            PG8_LDB(B0, 0, 0); PG8_LDB(B1, 0, 1); PG8_SCHED; PG8_LDA(At, 0, 0); PG8_STAGE(PG8_SA(1, 1), a1 + hstep, voffA);
            PG8_WAIT_V(8); PG8_WAIT_L(0); PG8_BAR; PG8_MMA(0, 0, At, B0); PG8_MMA(0, 1, At, B1); PG8_BAR; PG8_SCHED;
            PG8_LDA(At, 0, 1); PG8_STAGE(PG8_SB(0, 0), b2, voffB); PG8_STAGE(PG8_SB(0, 1), b2 + hstep, voffB); PG8_STAGE(PG8_SA(0, 0), a2, voffA);
            PG8_WAIT_V(8); PG8_WAIT_L(0); PG8_BAR; PG8_MMA(1, 0, At, B0); PG8_MMA(1, 1, At, B1); PG8_BAR; PG8_SCHED;
            PG8_LDB(B0, 1, 0); PG8_LDB(B1, 1, 1); PG8_SCHED; PG8_LDA(At, 1, 0); PG8_STAGE(PG8_SA(0, 1), a2 + hstep, voffA);
            PG8_WAIT_V(8); PG8_WAIT_L(0); PG8_BAR; PG8_MMA(0, 0, At, B0); PG8_MMA(0, 1, At, B1); PG8_BAR; PG8_SCHED;
            PG8_LDA(At, 1, 1); PG8_STAGE(PG8_SB(1, 0), b3, voffB); PG8_STAGE(PG8_SB(1, 1), b3 + hstep, voffB); PG8_STAGE(PG8_SA(1, 0), a3, voffA);
            PG8_WAIT_V(8); PG8_WAIT_L(0); PG8_BAR; PG8_MMA(1, 0, At, B0); PG8_MMA(1, 1, At, B1); PG8_BAR; PG8_SCHED;
            } else {
            PG8_LDB(B0, 0, 0); PG8_SCHED; PG8_LDA(At, 0, 0); PG8_STAGE(PG8_SA(1, 1), a1 + hstep, voffA);
            PG8_WAIT_L(8); PG8_BAR; PG8_WAIT_L(0); PG8_MMA(0, 0, At, B0); PG8_BAR; PG8_SCHED;
            PG8_LDB(B1, 0, 1); PG8_STAGE(PG8_SB(0, 0), b2, voffB);
            PG8_BAR; PG8_WAIT_L(0); PG8_MMA(0, 1, At, B1); PG8_BAR;
            PG8_LDA(At, 0, 1); PG8_STAGE(PG8_SA(0, 0), a2, voffA);
            PG8_BAR; PG8_WAIT_L(0); PG8_MMA(1, 0, At, B0); PG8_BAR; PG8_SCHED;
            PG8_STAGE(PG8_SB(0, 1), b2 + hstep, voffB);
            PG8_WAIT_V(6); PG8_BAR; PG8_MMA(1, 1, At, B1); PG8_BAR;
            PG8_LDB(B0, 1, 0); PG8_SCHED; PG8_LDA(At, 1, 0); PG8_STAGE(PG8_SA(0, 1), a2 + hstep, voffA);
            PG8_WAIT_L(8); PG8_BAR; PG8_WAIT_L(0); PG8_MMA(0, 0, At, B0); PG8_BAR; PG8_SCHED;
            PG8_LDB(B1, 1, 1); PG8_STAGE(PG8_SB(1, 0), b3, voffB);
            PG8_BAR; PG8_WAIT_L(0); PG8_MMA(0, 1, At, B1); PG8_BAR;
            PG8_LDA(At, 1, 1); PG8_STAGE(PG8_SA(1, 0), a3, voffA);
            PG8_BAR; PG8_WAIT_L(0); PG8_MMA(1, 0, At, B0); PG8_BAR; PG8_SCHED;
            PG8_STAGE(PG8_SB(1, 1), b3 + hstep, voffB);
            PG8_WAIT_V(6); PG8_BAR; PG8_MMA(1, 1, At, B1); PG8_BAR;
            }
        }
        if constexpr (ALIGN_EPI) { if (wr == 0) PG8_BAR; }
        if constexpr (!Epi::AFTER_DRAIN) { E(acc, cur, wr, wc, fr, fq); S.done(cur); }
        if (!has_next) break;
#pragma unroll
        for (int a = 0; a < 2; ++a)
#pragma unroll
            for (int b = 0; b < 2; ++b)
#pragma unroll
                for (int m = 0; m < 4; ++m)
#pragma unroll
                    for (int n = 0; n < 2; ++n) acc[a][b][m][n] = (f32x4){0.f, 0.f, 0.f, 0.f};
        cur = nxt; cA = nA; cB = nB; ++ui;
        if constexpr (ALIGN_EPI) { if (wr == 1) PG8_BAR; }
    }
    PG8_WAIT_V(0);
    if constexpr (!ALIGN_EPI) { if (wr == 0) PG8_BAR; }
    PG8_BAR;
    if constexpr (Epi::AFTER_DRAIN) { E.fused(acc, cur, wr, wc, fr, fq, lds, wid, lane); S.done(cur); }
#undef PG8_SA
#undef PG8_SB
#undef PG8_STAGE
#undef PG8_LDA
#undef PG8_LDB
#undef PG8_MMA
#undef PG8_WAIT_V
#undef PG8_WAIT_L
#undef PG8_BAR
#undef PG8_SCHED
}
}

namespace att {
#define ALAS __attribute__((address_space(3)))
typedef short bf16x8 __attribute__((ext_vector_type(8)));
typedef short s16x4 __attribute__((ext_vector_type(4)));
typedef float f32x16 __attribute__((ext_vector_type(16)));
typedef unsigned u32x4 __attribute__((ext_vector_type(4)));
constexpr int KSLOT = 12288, VSLOT = 8192, KOFF = 0, VOFF = 2 * KSLOT, TABOFF = VOFF + 2 * VSLOT, SCROFF = TABOFF + 512, ATT_LDS = SCROFF + 8 * 128;
constexpr float LOG2E = 1.4426950408889634f;
__device__ __forceinline__ s16x4 vtr(const ALAS unsigned char* p) { return __builtin_bit_cast(s16x4, __builtin_amdgcn_ds_read_tr16_b64_v4i16((ALAS s16x4*)p)); }
__device__ __forceinline__ void glds16(const void* g, ALAS unsigned char* l) { __builtin_amdgcn_global_load_lds((const unsigned*)g, (ALAS unsigned*)l, 16, 0, 0); }
__device__ __forceinline__ int crow(int r, int hi) { return (r & 3) + 8 * (r >> 2) + 4 * hi; }

template <int MIXER> __device__ __forceinline__ void attn_unit(const Frame& F, unsigned char* ldsg, int b, int h, int j, const float* inv_freq) {
    constexpr int DQK = MIXER == 0 ? 64 : 96, ND0 = DQK / 16;
    const int lane = F.lane, w = F.wave, r32 = lane & 31, hi = lane >> 5;
    ALAS unsigned char* lds = (ALAS unsigned char*)ldsg;
    const int NT = 4 * j + 5;
    const int p0q = NMETA + 256 * j + 32 * w, p = p0q + r32, Tmax = (p0q + 31) >> 6;
    const size_t rowb = (size_t)b * LP;
    const bf16* Vb = MIXER == 0 ? F.P + OFF_VA + 64 * h : F.QKVB + 768 + 128 * h + 64;
    const int vpitch = MIXER == 0 ? DINP : NMLA;
    const float cs = (MIXER == 0 ? 0.125f : 0.10206207261596577f) * LOG2E;
    ALAS float* tab = (ALAS float*)(lds + TABOFF); ALAS float* scr = (ALAS float*)(lds + SCROFF + w * 128);
    if (MIXER == 0 && F.tid < 128) tab[F.tid] = F.rel_bias[t5_bucket(F.tid) * 8 + h] * LOG2E;
    const float b31 = MIXER == 0 ? F.rel_bias[31 * 8 + h] * LOG2E : 0.f;
    const bf16* Kg = MIXER == 0 ? F.P + OFF_KA + 64 * h : F.QKVB + 768 + 128 * h;
    const unsigned kpitch = MIXER == 0 ? DINP : NMLA;
    const unsigned koff = (unsigned)(rowb + lane) * kpitch + 8u * w, peoff = (unsigned)(rowb + lane) * 32u + 8u * w;
    const unsigned voff = (unsigned)(rowb + 16 * (w & 3) + (lane >> 2)) * (unsigned)vpitch + (unsigned)((w >> 2) * 32 + (lane & 3) * 8);
#define ISSUE_TILE(T, slot) do { \
        glds16(Kg + (koff + (unsigned)(64 * (T)) * kpitch), lds + KOFF + (slot) * KSLOT + w * 1024); \
        if (MIXER == 1 && w < 4) glds16(F.KPER + (peoff + (unsigned)(64 * (T)) * 32u), lds + KOFF + (slot) * KSLOT + (8 + w) * 1024); \
        glds16(Vb + (voff + (unsigned)(64 * (T)) * (unsigned)vpitch), lds + VOFF + (slot) * VSLOT + w * 1024); } while (0)
    ISSUE_TILE(0, 0);
    bf16x8 qf[ND0];
    { const size_t qrow = rowb + p;
      const bf16* qp = MIXER == 0 ? F.P + qrow * DINP + OFF_QA + 64 * h : F.QKVB + qrow * NMLA + 96 * h;
#pragma unroll
      for (int d0 = 0; d0 < ND0; ++d0) qf[d0] = *(const bf16x8*)(qp + 16 * d0 + 8 * hi);
      if (MIXER == 1) {
        bf16x8 a = qf[4], c = qf[5];
#pragma unroll
        for (int jj = 0; jj < 8; ++jj) { const float x1 = bf2f((bf16)a[jj]), x2 = bf2f((bf16)c[jj]); const float ang = (float)p * inv_freq[8 * hi + jj]; const float co = cosf(ang), sn = sinf(ang);
            a[jj] = (short)f2bf(x1 * co - x2 * sn); c[jj] = (short)f2bf(x2 * co + x1 * sn); }
        qf[4] = a; qf[5] = c; } }
    const u64* bmrow = F.BM + ((size_t)b * SEQ + 256 * j + 32 * w + r32) * NW64;
    u64 mw_next = 0ull; if (MIXER == 0) mw_next = bmrow[0];
    f32x16 o0 = {}, o1 = {};
    float m = -1e30f, l = 0.f;
    for (int T = 0; T < NT; ++T) {
        const int slot = T & 1;
        asm volatile("s_waitcnt vmcnt(0)" ::: "memory");
        __syncthreads();
        const u64 mw = mw_next;
        if (T + 1 < NT) { ISSUE_TILE(T + 1, slot ^ 1); if (MIXER == 0 && T + 1 <= Tmax) mw_next = bmrow[T + 1]; }
        if (T <= Tmax) {
            f32x16 s0 = {}, s1 = {};
            const ALAS unsigned char* kp = lds + KOFF + slot * KSLOT + hi * 1024 + r32 * 16;
#pragma unroll
            for (int d0 = 0; d0 < ND0; ++d0) {
                const bf16x8 k0 = *(const ALAS bf16x8*)(kp + d0 * 2048), k1 = *(const ALAS bf16x8*)(kp + d0 * 2048 + 512);
                s0 = __builtin_amdgcn_mfma_f32_32x32x16_bf16(k0, qf[d0], s0, 0, 0, 0);
                s1 = __builtin_amdgcn_mfma_f32_32x32x16_bf16(k1, qf[d0], s1, 0, 0, 0);
            }
            const int dl = p - 64 * T - 4 * hi;
            const bool nearb = 64 * T + 63 > p0q - (MIXER == 0 ? 113 : 0);
            if (MIXER == 0) {
                const unsigned wl = (unsigned)mw >> (4 * hi), wh = (unsigned)(mw >> 32) >> (4 * hi);
                if (nearb) {
#pragma unroll
                    for (int r = 0; r < 16; ++r) { const int c = (r & 3) + 8 * (r >> 2);
                        const int i0 = min(max(dl - c, 0), 127), i1 = min(max(dl - c - 32, 0), 127);
                        s0[r] = ((wl >> c) & 1u) ? __builtin_fmaf(s0[r], cs, tab[i0]) : -INFINITY;
                        s1[r] = ((wh >> c) & 1u) ? __builtin_fmaf(s1[r], cs, tab[i1]) : -INFINITY; }
                } else {
#pragma unroll
                    for (int r = 0; r < 16; ++r) { const int c = (r & 3) + 8 * (r >> 2);
                        s0[r] = ((wl >> c) & 1u) ? __builtin_fmaf(s0[r], cs, b31) : -INFINITY;
                        s1[r] = ((wh >> c) & 1u) ? __builtin_fmaf(s1[r], cs, b31) : -INFINITY; }
                }
            } else {
                if (nearb) {
#pragma unroll
                    for (int r = 0; r < 16; ++r) { const int c = (r & 3) + 8 * (r >> 2);
                        s0[r] = (c > dl) ? -INFINITY : s0[r] * cs; s1[r] = (c + 32 > dl) ? -INFINITY : s1[r] * cs; }
                } else {
#pragma unroll
                    for (int r = 0; r < 16; ++r) { s0[r] *= cs; s1[r] *= cs; }
                }
            }
            float tmax = fmaxf(s0[0], s1[0]);
#pragma unroll
            for (int r = 1; r < 16; ++r) tmax = fmaxf(tmax, fmaxf(s0[r], s1[r]));
            tmax = fmaxf(tmax, __shfl_xor(tmax, 32));
            if (__any(tmax > m + 8.f)) {
                const float mn = fmaxf(m, tmax), al = __builtin_amdgcn_exp2f(m - mn);
                m = mn; l *= al;
                if (hi == 0) scr[r32] = al;
                asm volatile("s_waitcnt lgkmcnt(0)" ::: "memory");
#pragma unroll
                for (int r = 0; r < 16; ++r) { const float a = scr[crow(r, hi)]; o0[r] *= a; o1[r] *= a; }
            }
            float rs = 0.f;
#pragma unroll
            for (int r = 0; r < 16; ++r) { s0[r] = __builtin_amdgcn_exp2f(s0[r] - m); s1[r] = __builtin_amdgcn_exp2f(s1[r] - m); rs += s0[r] + s1[r]; }
            l += rs;
            bf16x8 pa[4];
#pragma unroll
            for (int ks = 0; ks < 4; ++ks) { u32x4 t;
#pragma unroll
                for (int i = 0; i < 4; ++i) { const float lo = (ks < 2) ? s0[8 * (ks & 1) + 2 * i] : s1[8 * (ks & 1) + 2 * i], hh = (ks < 2) ? s0[8 * (ks & 1) + 2 * i + 1] : s1[8 * (ks & 1) + 2 * i + 1]; t[i] = pg8::cvt_pk_bf16(lo, hh); }
                pa[ks] = __builtin_bit_cast(bf16x8, t); }
            const ALAS unsigned char* vb = lds + VOFF + slot * VSLOT + ((lane >> 4) & 1) * 32 + (lane & 3) * 8 + (4 * hi + ((lane & 15) >> 2)) * 64;
#pragma unroll
            for (int ks = 0; ks < 4; ++ks) {
                const s16x4 a0 = vtr(vb + ks * 1024), a1 = vtr(vb + ks * 1024 + 512), c0 = vtr(vb + 4096 + ks * 1024), c1 = vtr(vb + 4096 + ks * 1024 + 512);
                const bf16x8 v0 = (bf16x8){a0[0], a0[1], a0[2], a0[3], a1[0], a1[1], a1[2], a1[3]}, v1 = (bf16x8){c0[0], c0[1], c0[2], c0[3], c1[0], c1[1], c1[2], c1[3]};
                o0 = __builtin_amdgcn_mfma_f32_32x32x16_bf16(pa[ks], v0, o0, 0, 0, 0);
                o1 = __builtin_amdgcn_mfma_f32_32x32x16_bf16(pa[ks], v1, o1, 0, 0, 0);
            }
        }
    }
#undef ISSUE_TILE
    l += __shfl_xor(l, 32);
    if (hi == 0) scr[r32] = 1.f / l;
    asm volatile("s_waitcnt lgkmcnt(0)" ::: "memory");
    const int gcol = (MIXER == 0 ? OFF_GA : OFF_GB) + 64 * h + r32;
#pragma unroll
    for (int r = 0; r < 16; ++r) {
        const int q = crow(r, hi); const float rl = scr[q];
        const bf16* gp = F.P + (rowb + p0q + q) * DINP + gcol;
        const float g0 = bf2f(gp[0]), g1 = bf2f(gp[32]);
        const float y0 = o0[r] * rl * (g0 / (1.f + __expf(-g0))), y1 = o1[r] * rl * (g1 / (1.f + __expf(-g1)));
        bf16* op = F.MIX + ((size_t)b * SEQ + 256 * j + 32 * w + q) * DM + MIXER * 512 + 64 * h + r32;
        op[0] = (bf16)f2bf(y0); op[32] = (bf16)f2bf(y1);
        if ((r & 3) == 3) asm volatile("" ::: "memory");
    }
    asm volatile("s_waitcnt lgkmcnt(0)" ::: "memory");
    __syncthreads();
}
#undef ALAS
}

__device__ __forceinline__ void ph_attn_mfma(const Frame& F, unsigned char* lds, const float* inv_freq) {
    const bool bal = F.G == 256;
    const int nun = bal ? 4 : (1024 - F.bid + F.G - 1) / F.G;
    for (int i = 0; i < nun; ++i) {
        int b, h, j, mixer;
        if (bal) { const int vcu = (F.bid % 8) * 32 + F.bid / 8, bh = vcu >> 3, s = vcu & 7; b = bh >> 3; h = bh & 7; j = i < 2 ? 15 - s : s; mixer = i & 1; }
        else { const int u = F.bid + i * F.G; j = u & 15; h = (u >> 4) & 7; b = (u >> 7) & 3; mixer = u >> 9; }
        if (mixer == 0) att::attn_unit<0>(F, lds, b, h, j, inv_freq); else att::attn_unit<1>(F, lds, b, h, j, inv_freq);
    }
}

namespace idx {
#define ILAS __attribute__((address_space(3)))
typedef short bf16x8 __attribute__((ext_vector_type(8)));
typedef float f32x4 __attribute__((ext_vector_type(4)));
constexpr int NI = 33, NPAIR = 17, CAP = 128;
constexpr int QOFF = 0, CBOFF = 16384  , LCOFF = CBOFF + 256  , NEEDOFF = LCOFF + 64  , RESOFF = NEEDOFF + 64  , LISTOFF = RESOFF + 128  ,
              CHOFF = LISTOFF + 16 * CAP * 8  , IDX_LDS = CHOFF + 512;

__device__ __forceinline__ void index_unit(const Frame& F, unsigned char* ldsg, int b, int u) {
    const int lane = F.lane, w = F.wave, q = lane & 15, g = lane >> 4;
    ILAS unsigned char* lds = (ILAS unsigned char*)ldsg;
    ILAS int* cbuf = (ILAS int*)(lds + CBOFF); ILAS int* lcount = (ILAS int*)(lds + LCOFF); ILAS int* needs = (ILAS int*)(lds + NEEDOFF);
    ILAS unsigned* res = (ILAS unsigned*)(lds + RESOFF); ILAS unsigned* list = (ILAS unsigned*)(lds + LISTOFF);
    const size_t rowb = (size_t)b * LP;
    const int p = NMETA + 16 * u + q;
    const int nkt = u + 2;
    const int ni = (nkt - w + 7) >> 3;
    const int nwrite = 16 * (u >> 4) + 20;
    { const bf16* qp = F.P + (rowb + p) * DINP + OFF_QI + 64 * w + 8 * g;
      *(ILAS bf16x8*)(lds + QOFF + ((w * 2 + 0) * 64 + lane) * 16) = *(const bf16x8*)(qp);
      *(ILAS bf16x8*)(lds + QOFF + ((w * 2 + 1) * 64 + lane) * 16) = *(const bf16x8*)(qp + 32); }
    if (w == 0) { cbuf[lane & 47] = 0; if (lane < 16) lcount[lane] = 0; }
    ILAS float* chs = (ILAS float*)(lds + CHOFF);
    if (w == 1 && lane < 16) { const v4u wv = *(const v4u*)(F.P + (rowb + p) * DINP + OFF_WI);
#pragma unroll
      for (int h = 0; h < 4; ++h) { chs[(2 * h) * 16 + lane] = __uint_as_float(wv[h] << 16) * 0.35355339059327373f * 0.125f; chs[(2 * h + 1) * 16 + lane] = __uint_as_float(wv[h] & 0xffff0000u) * 0.35355339059327373f * 0.125f; } }
    asm volatile("s_waitcnt lgkmcnt(0)" ::: "memory");
    __syncthreads();
    unsigned kr[NI][4];
    const bf16* kptr = F.P + OFF_KI + 8 * g + (unsigned)(rowb + 16 * w + q) * DINP;
    bf16x8 ka0 = {}, ka1 = {}, kb0 = {}, kb1 = {}, na0 = {}, na1 = {}, nb0 = {}, nb1 = {};
    if (ni > 0) { ka0 = *(const bf16x8*)(kptr); ka1 = *(const bf16x8*)(kptr + 32); }
    if (ni > 1) { kb0 = *(const bf16x8*)(kptr + 128 * DINP); kb1 = *(const bf16x8*)(kptr + 128 * DINP + 32); }
#define IDX_KEYS(i_, S0, S1, S2, S3, valid_) do { int g4a = 4 * g; asm volatile("" : "+v"(g4a)); int wo_ = w; asm volatile("" : "+s"(wo_)); const int s0_ = 16 * (wo_ + 8 * (i_)) + g4a; \
        kr[i_][0] = ((valid_) && s0_ + 0 >= NMETA && s0_ + 0 <= p) ? fkey(S0) : 0u; kr[i_][1] = ((valid_) && s0_ + 1 >= NMETA && s0_ + 1 <= p) ? fkey(S1) : 0u; \
        kr[i_][2] = ((valid_) && s0_ + 2 >= NMETA && s0_ + 2 <= p) ? fkey(S2) : 0u; kr[i_][3] = ((valid_) && s0_ + 3 >= NMETA && s0_ + 3 <= p) ? fkey(S3) : 0u; } while (0)
#pragma unroll
    for (int m = 0; m < 16; ++m) {
        const int iA = 2 * m, iB = 2 * m + 1;
        if (iA < ni) {
            kptr += 256 * DINP; asm volatile("" : "+v"(kptr));
            if (iA + 2 < ni) { na0 = *(const bf16x8*)(kptr); na1 = *(const bf16x8*)(kptr + 32); }
            if (iB + 2 < ni) { nb0 = *(const bf16x8*)(kptr + 128 * DINP); nb1 = *(const bf16x8*)(kptr + 128 * DINP + 32); }
            float sa0 = 0.f, sa1 = 0.f, sa2 = 0.f, sa3 = 0.f, sb0 = 0.f, sb1 = 0.f, sb2 = 0.f, sb3 = 0.f;
            unsigned qa = QOFF + lane * 16, qc = CHOFF + q * 4; asm volatile("" : "+v"(qa), "+v"(qc));
#pragma unroll
            for (int h = 0; h < 8; ++h) {
                const bf16x8 q0 = *(const ILAS bf16x8*)(lds + qa + (h * 2 + 0) * 1024), q1 = *(const ILAS bf16x8*)(lds + qa + (h * 2 + 1) * 1024);
                const float chh = *(const ILAS float*)(lds + qc + h * 64);
                f32x4 accA = {0.f, 0.f, 0.f, 0.f}, accB = {0.f, 0.f, 0.f, 0.f};
                accA = __builtin_amdgcn_mfma_f32_16x16x32_bf16(ka0, q0, accA, 0, 0, 0);
                accB = __builtin_amdgcn_mfma_f32_16x16x32_bf16(kb0, q0, accB, 0, 0, 0);
                accA = __builtin_amdgcn_mfma_f32_16x16x32_bf16(ka1, q1, accA, 0, 0, 0);
                accB = __builtin_amdgcn_mfma_f32_16x16x32_bf16(kb1, q1, accB, 0, 0, 0);
                sa0 += fmaxf(accA[0], 0.f) * chh; sa1 += fmaxf(accA[1], 0.f) * chh; sa2 += fmaxf(accA[2], 0.f) * chh; sa3 += fmaxf(accA[3], 0.f) * chh;
                sb0 += fmaxf(accB[0], 0.f) * chh; sb1 += fmaxf(accB[1], 0.f) * chh; sb2 += fmaxf(accB[2], 0.f) * chh; sb3 += fmaxf(accB[3], 0.f) * chh;
                if (h & 1) asm volatile("" ::: "memory");
            }
            IDX_KEYS(iA, sa0, sa1, sa2, sa3, true);
            IDX_KEYS(iB, sb0, sb1, sb2, sb3, iB < ni);
            ka0 = na0; ka1 = na1; kb0 = nb0; kb1 = nb1;
        } else {
            kr[iA][0] = 0u; kr[iA][1] = 0u; kr[iA][2] = 0u; kr[iA][3] = 0u; kr[iB][0] = 0u; kr[iB][1] = 0u; kr[iB][2] = 0u; kr[iB][3] = 0u;
        }
    }
    if (32 < ni) {
        float sa0 = 0.f, sa1 = 0.f, sa2 = 0.f, sa3 = 0.f;
        unsigned qa = QOFF + lane * 16, qc = CHOFF + q * 4; asm volatile("" : "+v"(qa), "+v"(qc));
#pragma unroll
        for (int h = 0; h < 8; ++h) {
            const bf16x8 q0 = *(const ILAS bf16x8*)(lds + qa + (h * 2 + 0) * 1024), q1 = *(const ILAS bf16x8*)(lds + qa + (h * 2 + 1) * 1024);
            const float chh = *(const ILAS float*)(lds + qc + h * 64);
            f32x4 accA = {0.f, 0.f, 0.f, 0.f};
            accA = __builtin_amdgcn_mfma_f32_16x16x32_bf16(ka0, q0, accA, 0, 0, 0);
            accA = __builtin_amdgcn_mfma_f32_16x16x32_bf16(ka1, q1, accA, 0, 0, 0);
            sa0 += fmaxf(accA[0], 0.f) * chh; sa1 += fmaxf(accA[1], 0.f) * chh; sa2 += fmaxf(accA[2], 0.f) * chh; sa3 += fmaxf(accA[3], 0.f) * chh;
        }
        IDX_KEYS(32, sa0, sa1, sa2, sa3, true);
    } else { kr[32][0] = 0u; kr[32][1] = 0u; kr[32][2] = 0u; kr[32][3] = 0u; }
#undef IDX_KEYS
    int rk = 0;
#define IDX_REDUCE(c, out) do { const int nx_ = rk == 2 ? 0 : rk + 1; __hip_atomic_fetch_add(&cbuf[rk * 16 + q], (c), __ATOMIC_RELAXED, __HIP_MEMORY_SCOPE_WORKGROUP); \
        if (w == 0 && lane < 16) cbuf[nx_ * 16 + lane] = 0; \
        asm volatile("s_waitcnt lgkmcnt(0)" ::: "memory"); __syncthreads(); out = cbuf[rk * 16 + q]; rk = nx_; } while (0)
#define IDX_BISECT(X, target, t15, cge, cgt) do { t15 = 0u; cge = 0; \
        for (int bit = 14; bit >= 0; --bit) { const unsigned cand_ = t15 | (1u << bit), C_ = cand_ * 0x00010001u; int c_ = 0; \
            _Pragma("unroll") for (int i = 0; i < NI; ++i) if (i < ni) { c_ = __builtin_popcount((X[i][0] - C_) & 0x80008000u) + c_; c_ = __builtin_popcount((X[i][1] - C_) & 0x80008000u) + c_; } \
            int tot_; IDX_REDUCE(c_, tot_); if (tot_ >= (target)) { t15 = cand_; cge = tot_; } } \
        { const unsigned C_ = (t15 + 1u) * 0x00010001u; int c_ = 0; \
          _Pragma("unroll") for (int i = 0; i < NI; ++i) if (i < ni) { c_ = __builtin_popcount((X[i][0] - C_) & 0x80008000u) + c_; c_ = __builtin_popcount((X[i][1] - C_) & 0x80008000u) + c_; } \
          IDX_REDUCE(c_, cgt); } } while (0)
    unsigned thr = 0u; int sstar = LP;
    unsigned t0; int cge0, cgt0; bool live, big;
    {
        unsigned X[NI][2];
#pragma unroll
        for (int i = 0; i < NI; ++i) { X[i][0] = (((kr[i][1] & 0xffff0000u) | (kr[i][0] >> 16)) >> 1) | 0x80008000u; X[i][1] = (((kr[i][3] & 0xffff0000u) | (kr[i][2] >> 16)) >> 1) | 0x80008000u; }
        IDX_BISECT(X, KSEL, t0, cge0, cgt0);
        live = t0 != 0u;
        big = __any(live && cge0 - cgt0 > CAP);
        if (!big) {
            if (w == 0 && g == 0) needs[q] = KSEL - cgt0;
#pragma unroll
            for (int i = 0; i < NI; ++i) if (i < ni) {
                const unsigned Cp = (t0 | 0x8000u) * 0x00010001u, e0 = X[i][0] ^ Cp, e1 = X[i][1] ^ Cp;
                const unsigned z = (((e0 - 0x00010001u) & ~e0) | ((e1 - 0x00010001u) & ~e1)) & 0x80008000u;
                if (live && z != 0u) {
                    int g4b = 4 * g; asm volatile("" : "+v"(g4b)); int wo = w; asm volatile("" : "+s"(wo));
#pragma nounroll
                    for (int jj = 0; jj < 4; ++jj) {
                        const unsigned k = jj == 0 ? kr[i][0] : jj == 1 ? kr[i][1] : jj == 2 ? kr[i][2] : kr[i][3];
                        if ((k >> 17) == t0) {
                            const int pos = __hip_atomic_fetch_add(&lcount[q], 1, __ATOMIC_RELAXED, __HIP_MEMORY_SCOPE_WORKGROUP);
                            if (pos < CAP) { list[(q * CAP + pos) * 2] = k; list[(q * CAP + pos) * 2 + 1] = (unsigned)(16 * (wo + 8 * i) + g4b + jj); } }
                    }
                }
            }
        }
    }
    if (!big) {
        asm volatile("s_waitcnt lgkmcnt(0)" ::: "memory");
        __syncthreads();
        { const int q2 = 2 * w + (lane >> 5), e0 = lane & 31, mq = min(lcount[q2], CAP), nd = needs[q2];
          for (int e = e0; e < mq; e += 32) {
              const unsigned ke = list[(q2 * CAP + e) * 2], se = list[(q2 * CAP + e) * 2 + 1]; int rank = 0;
              for (int f = 0; f < mq; ++f) { const unsigned kf = list[(q2 * CAP + f) * 2], sf = list[(q2 * CAP + f) * 2 + 1]; rank += (kf > ke || (kf == ke && sf < se)) ? 1 : 0; }
              if (rank == nd - 1) { res[2 * q2] = ke; res[2 * q2 + 1] = se; } } }
        asm volatile("s_waitcnt lgkmcnt(0)" ::: "memory");
        __syncthreads();
        { int qo = q; asm volatile("" : "+v"(qo)); if (live) { thr = res[2 * qo]; sstar = (int)res[2 * qo + 1]; } }
    } else {
        for (int bit = 31; bit >= 0; --bit) {
            const unsigned cand = thr | (1u << bit); int c = 0;
#pragma unroll
            for (int i = 0; i < NI; ++i) if (i < ni) c += (int)(kr[i][0] >= cand) + (int)(kr[i][1] >= cand) + (int)(kr[i][2] >= cand) + (int)(kr[i][3] >= cand);
            int tot; IDX_REDUCE(c, tot);
            if (tot >= KSEL) thr = cand;
        }
        int c = 0;
#pragma unroll
        for (int i = 0; i < NI; ++i) if (i < ni) {
#pragma unroll
            for (int jj = 0; jj < 4; ++jj) c += (int)(kr[i][jj] >= thr) + ((int)(kr[i][jj] > thr) << 16); }
        int tot; IDX_REDUCE(c, tot);
        const int cge2 = tot & 0xffff, cgt2 = tot >> 16;
        const bool tie = thr != 0u && cge2 > KSEL;
        const int need = KSEL - cgt2; int lo = 0, hi = LP - 1;
        for (int it = 0; it < 13; ++it) {
            const int mid = (lo + hi) >> 1; int c2 = 0;
#pragma unroll
            for (int i = 0; i < NI; ++i) if (i < ni) { int g4b = 4 * g; asm volatile("" : "+v"(g4b)); int wo = w; asm volatile("" : "+s"(wo));
#pragma unroll
                for (int jj = 0; jj < 4; ++jj) c2 += (int)(kr[i][jj] == thr && 16 * (wo + 8 * i) + g4b + jj <= mid); }
            int t2; IDX_REDUCE(c2, t2);
            if (lo < hi) { if (t2 >= need) hi = mid; else lo = mid + 1; }
        }
        if (tie) sstar = lo;
    }
#undef IDX_BISECT
    const unsigned te = thr == 0u ? 1u : thr;
    unsigned short* bm16 = (unsigned short*)(F.BM + ((size_t)b * SEQ + 16 * u + q) * NW64);
#pragma unroll
    for (int i = 0; i < NI; ++i) {
        int wo = w; asm volatile("" : "+s"(wo));
        const int kt = wo + 8 * i;
        if (kt < nwrite) {
            unsigned nib = 0u; int g4c = 4 * g; asm volatile("" : "+v"(g4c));
#pragma unroll
            for (int jj = 0; jj < 4; ++jj) { const unsigned k = kr[i][jj]; const int s = 16 * kt + g4c + jj;
                const bool sel = (s < NMETA) || (k >= te && (k > thr || s <= sstar)); nib |= sel ? (1u << jj) : 0u; }
            unsigned v = nib << (4 * g); v |= __shfl_xor(v, 16); v |= __shfl_xor(v, 32);
            if (g == 0) bm16[kt] = (unsigned short)v;
        }
    }
#undef IDX_REDUCE
    __syncthreads();
}
#undef ILAS
}

__device__ __forceinline__ void ph_index_mfma(const Frame& F, unsigned char* lds) {
    const bool bal = F.G == 256;
    const int nun = bal ? 4 : (1024 - F.bid + F.G - 1) / F.G;
    for (int i = 0; i < nun; ++i) {
        int b, u, bid = F.bid; asm volatile("" : "+s"(bid));
        if (bal) { const int s = bid & 63; b = bid >> 6; u = i == 0 ? 255 - s : i == 1 ? 128 + s : i == 2 ? 127 - s : s; }
        else { const int t = bid + i * F.G; b = t >> 8; u = t & 255; }
        idx::index_unit(F, lds, b, u);
    }
}

#define LAS __attribute__((address_space(3)))
#define XB_TMO      128
#define XB_XCNT(j)  (256  + 64 * (j))
#define XB_XSUB(j)  (1280 + 64 * (j))
#define XB_XGEN(j)  (2304 + 64 * (j))
#define XB_TOP      3328
#define XB_TOPGEN   3392
#define XCD_BAR_WORDS 3456
#define XB_SPIN_CAP (1u << 18)

__device__ __forceinline__ unsigned xb_ld(unsigned* p)              { return __hip_atomic_load(p, __ATOMIC_RELAXED, __HIP_MEMORY_SCOPE_AGENT); }
__device__ __forceinline__ unsigned xb_add(unsigned* p, unsigned v) { return __hip_atomic_fetch_add(p, v, __ATOMIC_RELAXED, __HIP_MEMORY_SCOPE_AGENT); }
__device__ __forceinline__ unsigned xb_xcc_id() { return (unsigned)__builtin_amdgcn_s_getreg((3 << 11) | 20) & 0xFu; }
#define XB_SPIN(cond, bar) do { unsigned _sp = 0; while (cond) { __builtin_amdgcn_s_sleep(1); \
    if ((++_sp & 255u) == 0u) { if (xb_ld(&(bar)[XB_TMO])) break; if (_sp > XB_SPIN_CAP) { atomicAdd(&(bar)[XB_TMO], 1u); break; } } } } while (0)

struct XcdBarrier {
    unsigned* bar; unsigned x;
    volatile LAS unsigned* st;
};

__device__ __forceinline__ XcdBarrier xcd_barrier_post(unsigned* bar, volatile LAS unsigned* st) {
    XcdBarrier b; b.bar = bar; b.x = xb_xcc_id(); b.st = st;
    if (threadIdx.x == 0) (void)xb_add(&bar[XB_XCNT(b.x)], 1u);
    return b;
}
__device__ __forceinline__ void xcd_barrier_complete(unsigned* bar, unsigned x, unsigned& nloc, unsigned& nx) {
    const unsigned G = gridDim.x * gridDim.y * gridDim.z;
    unsigned sum, cnt, mine, sp = 0u;
    for (;;) {
        sum = 0u; cnt = 0u; mine = 0u;
#pragma unroll
        for (unsigned j = 0; j < 16; ++j) { const unsigned c = xb_ld(&bar[XB_XCNT(j)]); sum += c; cnt += (c > 0u) ? 1u : 0u; mine = (j == x) ? c : mine; }
        if (sum == G) break;
        __builtin_amdgcn_s_sleep(1);
        if ((++sp & 255u) == 0u) { if (xb_ld(&bar[XB_TMO])) break; if (sp > XB_SPIN_CAP) { atomicAdd(&bar[XB_TMO], 1u); break; } }
    }
    nloc = mine > 0u ? mine : 1u; nx = cnt > 0u ? cnt : 1u;
}

__device__ __forceinline__ void xcd_barrier(const XcdBarrier& b) {
    asm volatile("s_waitcnt vmcnt(0)" ::: "memory");
    __syncthreads();
    if (threadIdx.x == 0) {
        unsigned* bar = b.bar;
        __builtin_amdgcn_s_waitcnt(0);
        unsigned nloc = b.st[0], nx = b.st[1];
        if (nloc == 0u) { xcd_barrier_complete(bar, b.x, nloc, nx); b.st[0] = nloc; b.st[1] = nx; }
        const unsigned old = xb_add(&bar[XB_XSUB(b.x)], 1u);
        const unsigned gen = old / nloc;
        if (old + 1u == (gen + 1u) * nloc) {
            __builtin_amdgcn_fence(__ATOMIC_RELEASE, "agent");
            asm volatile("s_waitcnt vmcnt(0)" ::: "memory");
            const unsigned og = xb_add(&bar[XB_TOP], 1u);
            const unsigned tg = og / nx;
            if (og + 1u == (tg + 1u) * nx) xb_add(&bar[XB_TOPGEN], 1u);
            else XB_SPIN(xb_ld(&bar[XB_TOPGEN]) == tg, bar);
            __builtin_amdgcn_fence(__ATOMIC_ACQUIRE, "agent");
            xb_add(&bar[XB_XGEN(b.x)], 1u);
            asm volatile("s_waitcnt vmcnt(0)" ::: "memory");
        } else {
            XB_SPIN(xb_ld(&bar[XB_XGEN(b.x)]) == gen, bar);
            __builtin_amdgcn_fence(__ATOMIC_ACQUIRE, "agent");
            asm volatile("s_waitcnt vmcnt(0)" ::: "memory");
        }
    }
    __syncthreads();
}

constexpr int LDS_BYTES = 147456, MISC_OFF = 131072 + 320;
__global__ void __launch_bounds__(512, 2) fwd(Args args) {
    extern __shared__ __attribute__((aligned(16))) unsigned char lds[];
    Frame F;
    F.tid = threadIdx.x; F.lane = F.tid & 63; F.wave = __builtin_amdgcn_readfirstlane(F.tid >> 6); F.G = gridDim.x; F.bid = blockIdx.x;
    F.x = args.in[0]; F.meta = args.in[1]; F.lne_g = args.in[2]; F.lne_b = args.in[3]; F.w_in = args.in[4]; F.w_uq = args.in[5]; F.qn_g = args.in[6];
    F.w_ukv = args.in[7]; F.kvn_g = args.in[8]; F.rel_bias = args.in[9]; F.w_out = args.in[10]; F.lnp_g = args.in[11]; F.lnp_b = args.in[12];
    F.out = args.out;
    unsigned char* ws = args.ws;
    F.Win_t = (bf16*)(ws + WS_WIN); F.Wmla_t = (bf16*)(ws + WS_WMLA); F.Wout_t = (bf16*)(ws + WS_WOUT); F.KPER = (bf16*)(ws + WS_KPER);
    F.BM = (u64*)(ws + WS_BM); F.CQKVN = (bf16*)(ws + WS_CQKVN); F.XN = (bf16*)(ws + WS_XN); F.MIX = (bf16*)(ws + WS_XN);
    F.QKVB = (bf16*)(ws + WS_QKVB); F.P = (bf16*)(ws + WS_P); F.Z = (float*)(ws + WS_P);
    const int lo = args.ph_lo, hi = args.ph_hi;
    volatile LAS unsigned* MISC = (volatile LAS unsigned*)((LAS unsigned char*)lds + MISC_OFF);
    if (F.tid < 32) MISC[F.tid] = 0u;
    __syncthreads();
    XcdBarrier bar = xcd_barrier_post((unsigned*)(ws + WS_CTL) + 4096, MISC + 8);
#define IN(k) (lo <= (k) && (k) < hi)
#define SEAM(k) do { if (IN(k) && IN((k) + 1)) xcd_barrier(bar); } while (0)
    if (IN(0)) ph_prologue(F, (float*)lds);
    SEAM(0);
    PG8_LAS unsigned char* ring = (PG8_LAS unsigned char*)lds;
    if (IN(1)) { pg8::Gemm g{F.XN, F.Win_t, MROWS, DINP, DM}; pg8::StaticOrder S; S.init(MROWS, DINP, F.G, F.bid); pg8::EpiBf16 E{F.P, DINP};
        pg8::gemm_phase<pg8::EpiBf16, pg8::StaticOrder, true, true>(ring, g, S, E); }
    SEAM(1);
    if (IN(2)) ph_rms(F, args.inv_freq);
    SEAM(2);
    if (IN(3)) { { pg8::Gemm g{F.CQKVN, F.Wmla_t, MROWS, NMLA, KMLA}; pg8::StaticOrder S; S.init(MROWS, NMLA, F.G, F.bid); pg8::EpiBf16 E{F.QKVB, NMLA};
        pg8::gemm_phase<pg8::EpiBf16, pg8::StaticOrder, true, true>(ring, g, S, E); }
        __syncthreads(); ph_index_mfma(F, lds); }
    SEAM(3);
    if (IN(4)) ph_attn_mfma(F, lds, args.inv_freq);
    SEAM(4);
    if (IN(5)) { pg8::Gemm g{F.MIX, F.Wout_t, MQ, DM, DM}; pg8::StaticOrder S; S.init(MQ, DM, F.G, F.bid); pg8::EpiF32 E{F.Z, DM, nullptr};
        pg8::gemm_phase<pg8::EpiF32, pg8::StaticOrder, true, true>(ring, g, S, E); }
    SEAM(5);
    if (IN(6)) ph_final(F);
#undef IN
#undef SEAM
}

#ifndef MK_N_LAUNCHES
#define MK_N_LAUNCHES 1
#endif
extern "C" void kernel_launch(void* const* d_in, const int* in_sizes, int n_in, void* d_out, int out_size, void* d_ws, size_t ws_size, hipStream_t stream) {
    static int grid_blocks = 0;
    if (!grid_blocks) {
        if (n_in != 13 || out_size != MQ * DM || ws_size < WS_END) { fprintf(stderr, "kernel_launch: unexpected shapes (n_in %d out %d ws %zu)\n", n_in, out_size, ws_size); grid_blocks = -1; return; }
        if (hipFuncSetAttribute((const void*)fwd, hipFuncAttributeMaxDynamicSharedMemorySize, LDS_BYTES) != hipSuccess) { fprintf(stderr, "kernel_launch: hipFuncSetAttribute failed\n"); grid_blocks = -1; return; }
        int dev = 0, cus = 0, per_cu = 0;
        (void)hipGetDevice(&dev);
        (void)hipDeviceGetAttribute(&cus, hipDeviceAttributeMultiprocessorCount, dev);
        (void)hipOccupancyMaxActiveBlocksPerMultiprocessor(&per_cu, (const void*)fwd, 512, LDS_BYTES);
        if (per_cu < 1 || cus < 1) { fprintf(stderr, "kernel_launch: occupancy query says %d blocks/CU on %d CUs\n", per_cu, cus); grid_blocks = -1; return; }
        grid_blocks = cus;
    }
    if (grid_blocks < 0) return;
    Args a{};
    for (int i = 0; i < 13; ++i) a.in[i] = (const float*)d_in[i];
    a.out = (float*)d_out; a.ws = (unsigned char*)d_ws;
    for (int i = 0; i < 16; ++i) a.inv_freq[i] = (float)pow(10000.0, -(double)(2 * i) / 32.0);
    (void)hipMemsetAsync((char*)d_ws + WS_CTL, 0, 65536, stream);
    a.ph_lo = 0; a.ph_hi = 7;
    hipLaunchKernelGGL(fwd, dim3(grid_blocks), dim3(512), LDS_BYTES, stream, a);
}
```

```cpp
#include <hip/hip_runtime.h>
#include <cstdio>
#include <cstdint>
#include <cmath>

constexpr int BATCH = 4, SEQ = 4096, DM = 1024, NMETA = 16;
constexpr int LTOK = NMETA + SEQ;
constexpr int LP = 4160;
constexpr int MROWS = BATCH * LP;
constexpr int MQ = BATCH * SEQ;
constexpr int DIN = 3560, DINP = 3584;
constexpr int OFF_QA = 0, OFF_KA = 512, OFF_VA = 1024, OFF_GA = 1536, OFF_QI = 2048, OFF_KI = 2560, OFF_WI = 2624,
              OFF_CQ = 2632, OFF_CKV = 2888, OFF_KPE = 3016, OFF_GB = 3048;
constexpr int KMLA = 384, NMLA = 1792;
constexpr int TOPK = 256, KSEL = TOPK - NMETA;
constexpr int NW64 = LP / 64;
constexpr float LN_EPS = 1e-5f, RMS_EPS = 1e-6f;
constexpr float ALPHA = 1.189207115002721f;

constexpr size_t MiB = 1u << 20;
constexpr size_t WS_CTL = 0;
constexpr size_t WS_WIN = 2 * MiB;
constexpr size_t WS_WMLA = 9 * MiB;
constexpr size_t WS_WOUT = 11 * MiB;
constexpr size_t WS_KPER = 13 * MiB;
constexpr size_t WS_BM = 15 * MiB;
constexpr size_t WS_CQKVN = 24 * MiB;
constexpr size_t WS_XN = 37 * MiB;
constexpr size_t WS_QKVB = 70 * MiB;
constexpr size_t WS_P = 127 * MiB;
constexpr size_t WS_KIC = 241 * MiB;
constexpr size_t WS_END = 244 * MiB;

typedef unsigned short bf16;
typedef unsigned long long u64;
typedef unsigned v4u __attribute__((ext_vector_type(4)));
typedef float f32x4 __attribute__((ext_vector_type(4)));

__device__ __forceinline__ float bf2f(bf16 v) { return __uint_as_float((unsigned)v << 16); }
__device__ __forceinline__ unsigned f2bf(float f) { unsigned u = __float_as_uint(f); return (u + 0x7fffu + ((u >> 16) & 1u)) >> 16; }
__device__ __forceinline__ unsigned pk2(float lo, float hi) { return f2bf(lo) | (f2bf(hi) << 16); }
__device__ __forceinline__ float wave_sum(float v) {
#pragma unroll
    for (int o = 1; o < 64; o <<= 1) v += __shfl_xor(v, o);
    return v;
}
__device__ __forceinline__ float wave_max(float v) {
#pragma unroll
    for (int o = 1; o < 64; o <<= 1) v = fmaxf(v, __shfl_xor(v, o));
    return v;
}
__device__ __forceinline__ int wave_isum(int v) {
#pragma unroll
    for (int o = 1; o < 64; o <<= 1) v += __shfl_xor(v, o);
    return v;
}
__device__ __forceinline__ int t5_bucket(int d) {
    if (d < 16) return d < 0 ? 0 : d;
    return 16 + (d >= 19) + (d >= 21) + (d >= 24) + (d >= 27) + (d >= 31) + (d >= 35) + (d >= 40) + (d >= 46) + (d >= 52) + (d >= 59) + (d >= 67) + (d >= 77) + (d >= 87) + (d >= 99) + (d >= 113);
}
__device__ __forceinline__ unsigned fkey(float f) { unsigned u = __float_as_uint(f); return (u & 0x80000000u) ? ~u : (u | 0x80000000u); }

struct Args {
    const float* in[13];
    float* out;
    unsigned char* ws;
    float inv_freq[16];
    int ph_lo, ph_hi;
};

struct Frame {
    int tid, lane, wave, G, bid;
    const float *x, *meta, *lne_g, *lne_b, *w_in, *w_uq, *qn_g, *w_ukv, *kvn_g, *rel_bias, *w_out, *lnp_g, *lnp_b;
    float* out;
    bf16 *Win_t, *Wmla_t, *Wout_t, *KPER, *CQKVN, *XN, *MIX, *QKVB, *P, *KIC;
    u64* BM;
    float* Z;
};

template <class F> __device__ __forceinline__ void transpose_tile(F src, bf16* dst, int ldk, int n0, int k0, float* scr, int tid) {
    const int ty = tid >> 6, tx = tid & 63;
#pragma unroll
    for (int i = 0; i < 8; ++i) { const int k = ty + 8 * i; scr[k * 65 + tx] = src(k0 + k, n0 + tx); }
    __syncthreads();
    const int nn = tid >> 3, kc = tid & 7;
    v4u o; o.x = pk2(scr[(8 * kc + 0) * 65 + nn], scr[(8 * kc + 1) * 65 + nn]); o.y = pk2(scr[(8 * kc + 2) * 65 + nn], scr[(8 * kc + 3) * 65 + nn]);
    o.z = pk2(scr[(8 * kc + 4) * 65 + nn], scr[(8 * kc + 5) * 65 + nn]); o.w = pk2(scr[(8 * kc + 6) * 65 + nn], scr[(8 * kc + 7) * 65 + nn]);
    *(v4u*)(dst + (size_t)(n0 + nn) * ldk + k0 + 8 * kc) = o;
    __syncthreads();
}
__device__ __forceinline__ void ph_prologue(const Frame& F, float* lds) {
    constexpr int I_IN = (DINP / 64) * (DM / 64), I_MLA = (NMLA / 64) * (KMLA / 64), I_OUT = (DM / 64) * (DM / 64);
    for (int it = F.bid; it < I_IN + I_MLA + I_OUT; it += F.G) {
        if (it < I_IN) {
            const int n0 = (it / (DM / 64)) * 64, k0 = (it % (DM / 64)) * 64; const float* w = F.w_in;
            transpose_tile([=](int k, int n) { return n < DIN ? w[(size_t)k * DIN + n] : 0.f; }, F.Win_t, DM, n0, k0, lds, F.tid);
        } else if (it < I_IN + I_MLA) {
            const int r = it - I_IN, n0 = (r / (KMLA / 64)) * 64, k0 = (r % (KMLA / 64)) * 64;
            const float *wq = F.w_uq, *wkv = F.w_ukv, *gq = F.qn_g, *gkv = F.kvn_g;
            transpose_tile([=](int k, int n) {
                if (n < 768) return k < 256 ? wq[(size_t)k * 768 + n] * gq[k] : 0.f;
                return k >= 256 ? wkv[(size_t)(k - 256) * 1024 + (n - 768)] * gkv[k - 256] : 0.f; }, F.Wmla_t, KMLA, n0, k0, lds, F.tid);
        } else {
            const int r = it - I_IN - I_MLA, n0 = (r / (DM / 64)) * 64, k0 = (r % (DM / 64)) * 64; const float* w = F.w_out;
            transpose_tile([=](int k, int n) { return w[(size_t)k * DM + n]; }, F.Wout_t, DM, n0, k0, lds, F.tid);
        }
    }
    const int gw = F.bid * 8 + F.wave, NGW = F.G * 8;
    for (int m = gw; m < MROWS; m += NGW) {
        const int b = m / LP, p = m % LP;
        unsigned long long* o8 = (unsigned long long*)(F.XN + (size_t)m * DM) + F.lane;
        if (p >= LTOK) {
#pragma unroll
            for (int j = 0; j < 4; ++j) o8[64 * j] = 0ull;
            continue;
        }
        const float* src = p < NMETA ? F.meta + (size_t)p * DM : F.x + ((size_t)b * SEQ + (p - NMETA)) * DM;
        const f32x4* xr = (const f32x4*)src + F.lane;
        f32x4 v[4]; float s = 0.f;
#pragma unroll
        for (int j = 0; j < 4; ++j) { v[j] = xr[64 * j]; s += (v[j].x + v[j].y) + (v[j].z + v[j].w); }
        const float mean = wave_sum(s) * (1.f / DM); float s2 = 0.f;
#pragma unroll
        for (int j = 0; j < 4; ++j) { v[j] = v[j] - mean; s2 += (v[j].x * v[j].x + v[j].y * v[j].y) + (v[j].z * v[j].z + v[j].w * v[j].w); }
        const float rstd = 1.f / sqrtf(wave_sum(s2) * (1.f / DM) + LN_EPS);
#pragma unroll
        for (int j = 0; j < 4; ++j) {
            const f32x4 g = ((const f32x4*)F.lne_g)[F.lane + 64 * j], bb = ((const f32x4*)F.lne_b)[F.lane + 64 * j];
            const f32x4 y = v[j] * rstd * g + bb;
            o8[64 * j] = (unsigned long long)pk2(y.x, y.y) | ((unsigned long long)pk2(y.z, y.w) << 32);
        }
    }
}

__device__ __forceinline__ void ph_rms(const Frame& F, const float* inv_freq) {
    const int gw = F.bid * 8 + F.wave, NGW = F.G * 8, lane = F.lane;
    for (int m = gw; m < MROWS; m += NGW) {
        const bf16* pr = F.P + (size_t)m * DINP; const int p = m % LP;
        const unsigned long long cq4 = *(const unsigned long long*)(pr + OFF_CQ + 4 * lane);
        const unsigned ckv2 = *(const unsigned*)(pr + OFF_CKV + 2 * lane);
        float c[4] = {bf2f((bf16)(cq4 & 0xffff)), bf2f((bf16)((cq4 >> 16) & 0xffff)), bf2f((bf16)((cq4 >> 32) & 0xffff)), bf2f((bf16)(cq4 >> 48))};
        float d[2] = {bf2f((bf16)(ckv2 & 0xffff)), bf2f((bf16)(ckv2 >> 16))};
        const float sq = wave_sum(c[0] * c[0] + c[1] * c[1] + c[2] * c[2] + c[3] * c[3]), skv = wave_sum(d[0] * d[0] + d[1] * d[1]);
        const float rq = 1.f / sqrtf(sq * (1.f / 256.f) + RMS_EPS), rkv = 1.f / sqrtf(skv * (1.f / 128.f) + RMS_EPS);
        bf16* o = F.CQKVN + (size_t)m * KMLA;
        *(unsigned long long*)(o + 4 * lane) = (unsigned long long)pk2(c[0] * rq, c[1] * rq) | ((unsigned long long)pk2(c[2] * rq, c[3] * rq) << 32);
        *(unsigned*)(o + 256 + 2 * lane) = pk2(d[0] * rkv, d[1] * rkv);
        if (lane >= 32 && lane < 40) *(v4u*)(F.KIC + (size_t)m * 64 + 8 * (lane - 32)) = *(const v4u*)(pr + OFF_KI + 8 * (lane - 32));
        if (lane < 16) {
            const float x1 = bf2f(pr[OFF_KPE + lane]), x2 = bf2f(pr[OFF_KPE + 16 + lane]);
            const float ang = (float)p * inv_freq[lane]; const float cs = cosf(ang), sn = sinf(ang);
            F.KPER[(size_t)m * 32 + lane] = (bf16)f2bf(x1 * cs - x2 * sn); F.KPER[(size_t)m * 32 + 16 + lane] = (bf16)f2bf(x2 * cs + x1 * sn);
        }
    }
}

__device__ __forceinline__ void ph_final(const Frame& F) {
    const int gw = F.bid * 8 + F.wave, NGW = F.G * 8, lane = F.lane;
    for (int m = gw; m < MQ; m += NGW) {
        const f32x4* xr = (const f32x4*)(F.x + (size_t)m * DM) + lane; const f32x4* zr = (const f32x4*)(F.Z + (size_t)m * DM) + lane;
        f32x4 v[4]; float s = 0.f;
#pragma unroll
        for (int j = 0; j < 4; ++j) { v[j] = xr[64 * j]; s += (v[j].x + v[j].y) + (v[j].z + v[j].w); }
        const float mean = wave_sum(s) * (1.f / DM); float s2 = 0.f;
#pragma unroll
        for (int j = 0; j < 4; ++j) { v[j] = v[j] - mean; s2 += (v[j].x * v[j].x + v[j].y * v[j].y) + (v[j].z * v[j].z + v[j].w * v[j].w); }
        const float rstd = 1.f / sqrtf(wave_sum(s2) * (1.f / DM) + LN_EPS);
        float t = 0.f;
#pragma unroll
        for (int j = 0; j < 4; ++j) {
            const f32x4 g = ((const f32x4*)F.lne_g)[lane + 64 * j], bb = ((const f32x4*)F.lne_b)[lane + 64 * j];
            v[j] = (v[j] * rstd * g + bb) * ALPHA + zr[64 * j];
            t += (v[j].x + v[j].y) + (v[j].z + v[j].w);
        }
        const float mean2 = wave_sum(t) * (1.f / DM); float t2 = 0.f;
#pragma unroll
        for (int j = 0; j < 4; ++j) { v[j] = v[j] - mean2; t2 += (v[j].x * v[j].x + v[j].y * v[j].y) + (v[j].z * v[j].z + v[j].w * v[j].w); }
        const float rstd2 = 1.f / sqrtf(wave_sum(t2) * (1.f / DM) + LN_EPS);
        f32x4* o = (f32x4*)(F.out + (size_t)m * DM) + lane;
#pragma unroll
        for (int j = 0; j < 4; ++j) {
            const f32x4 g = ((const f32x4*)F.lnp_g)[lane + 64 * j], bb = ((const f32x4*)F.lnp_b)[lane + 64 * j];
            o[64 * j] = v[j] * rstd2 * g + bb;
        }
    }
}

namespace pg8 {
#define PG8_LAS __attribute__((address_space(3)))
typedef unsigned short bf16_t;
typedef short bf16x8 __attribute__((ext_vector_type(8)));
typedef float f32x4 __attribute__((ext_vector_type(4)));
typedef unsigned u32x4 __attribute__((ext_vector_type(4)));
constexpr int BM = 256, BK = 64, HALF = 128, HTB = HALF * BK * 2  , STAGE_BYTES = 8 * HTB, NXCD = 8, WGM = 8;

__host__ __device__ __forceinline__ int lds_byte(int r, int c) { const int st = (r >> 4) * 2 + (c >> 5), rr = r & 15, cc = c & 31, ob = rr * 64 + cc * 2; return st * 1024 + (ob ^ (((ob >> 9) & 1) << 5)); }
__host__ __device__ __forceinline__ void stage_rc(int b, int& R, int& C) { const int st = b / 1024, sb = b % 1024, swz = sb ^ (((sb >> 9) & 1) << 5); R = (st >> 1) * 16 + swz / 64; C = (st & 1) * 32 + (swz % 64) / 2; }
__host__ __device__ __forceinline__ int perm32(int rho) { const int n = rho >> 4, i = rho & 15; return 8 * (i >> 2) + 4 * n + (i & 3); }

struct Unit { int pm, pn; };
struct Gemm { const bf16_t* A; const bf16_t* Bt; int M, N, K; };

struct StaticOrder {
    int nM, nN, nwg, G, c;
    __host__ __device__ void init(int M, int N, int G_, int c_) { nM = M / BM; nN = N / BM; nwg = nM * nN; G = G_; c = c_; }
    __host__ __device__ bool next(int i, Unit& u) const {
        const long L = (long)i * G + c; if (L >= nwg) return false;
        int wgid = (int)L; { const int q = nwg / NXCD, r = nwg % NXCD, xcd = wgid % NXCD, off = wgid / NXCD; wgid = (xcd < r ? xcd * (q + 1) : r * (q + 1) + (xcd - r) * q) + off; }
        const int nig = WGM * nN, gid = wgid / nig, fm = gid * WGM, gsz = (nM - fm) < WGM ? (nM - fm) : WGM;
        u.pm = fm + ((wgid % nig) % gsz); u.pn = (wgid % nig) / gsz; return true;
    }
    __device__ __forceinline__ void a_ready(const Unit&) const {}
    __device__ __forceinline__ void done(const Unit&) const {}
};

__device__ __forceinline__ unsigned cvt_pk_bf16(float lo, float hi) { unsigned r; asm volatile("v_cvt_pk_bf16_f32 %0, %1, %2" : "=v"(r) : "v"(lo), "v"(hi)); return r; }

struct EpiBf16 {
    static constexpr bool PERM = true, AFTER_DRAIN = false;
    bf16_t* O; int ldc;
    __device__ __forceinline__ void operator()(const f32x4 (&acc)[2][2][4][2], const Unit& u, int wr, int wc, int fr, int fq) const {
        const int row0 = u.pm * BM + wr * 64 + fr, col0 = u.pn * BM + wc * 32 + 8 * fq;
#pragma unroll
        for (int ai = 0; ai < 2; ++ai)
#pragma unroll
            for (int m = 0; m < 4; ++m) { bf16_t* rowp = O + (size_t)(row0 + ai * HALF + m * 16) * ldc + col0;
#pragma unroll
                for (int bj = 0; bj < 2; ++bj) { const f32x4 v0 = acc[ai][bj][m][0], v1 = acc[ai][bj][m][1];
                    u32x4 w; w.x = cvt_pk_bf16(v0[0], v0[1]); w.y = cvt_pk_bf16(v0[2], v0[3]); w.z = cvt_pk_bf16(v1[0], v1[1]); w.w = cvt_pk_bf16(v1[2], v1[3]);
                    *(u32x4*)(rowp + bj * HALF) = w; } }
    }
};
struct EpiF32 {
    static constexpr bool PERM = false, AFTER_DRAIN = false;
    float* C; int ldc; const float* bias;
    __device__ __forceinline__ void operator()(const f32x4 (&acc)[2][2][4][2], const Unit& u, int wr, int wc, int fr, int fq) const {
        const int row0 = u.pm * BM + wr * 64 + fr, col0 = u.pn * BM + wc * 32 + 4 * fq;
        f32x4 bv[2][2];
#pragma unroll
        for (int bj = 0; bj < 2; ++bj)
#pragma unroll
            for (int n = 0; n < 2; ++n) bv[bj][n] = bias ? *(const f32x4*)(bias + col0 + bj * HALF + n * 16) : (f32x4){0.f, 0.f, 0.f, 0.f};
#pragma unroll
        for (int ai = 0; ai < 2; ++ai)
#pragma unroll
            for (int m = 0; m < 4; ++m) { float* rowp = C + (size_t)(row0 + ai * HALF + m * 16) * ldc + col0;
#pragma unroll
                for (int bj = 0; bj < 2; ++bj)
#pragma unroll
                    for (int n = 0; n < 2; ++n) *(f32x4*)(rowp + bj * HALF + n * 16) = acc[ai][bj][m][n] + bv[bj][n]; }
    }
};
template <class Epi, class Sched, bool ALIGN_EPI = false, bool SP2 = false>
__device__ __forceinline__ void gemm_phase(PG8_LAS unsigned char* lds, const Gemm g, const Sched& S, const Epi& E) {
    const int tid = threadIdx.x, wid = __builtin_amdgcn_readfirstlane(tid >> 6), lane = tid & 63, wr = wid >> 2, wc = wid & 3, fr = lane & 15, fq = lane >> 4;
    const int K = g.K, nt = K / BK;
    unsigned voffA[2], voffB[2];
#pragma unroll
    for (int i = 0; i < 2; ++i) { int R, C; stage_rc(tid * 16 + i * 8192, R, C); const int Rb = Epi::PERM ? ((R & ~31) + perm32(R & 31)) : R;
        voffA[i] = (unsigned)(R * K + C) * 2u; voffB[i] = (unsigned)(Rb * K + C) * 2u; }
    const size_t kstep = (size_t)(BK * 2);
    const size_t hstep = (size_t)HALF * K * 2;
    const size_t tstep = 2 * hstep;
    const unsigned ldsw = (unsigned)wid * 1024u;
    const int aoff = lds_byte(wr * 64 + fr, fq * 8), boff = lds_byte(wc * 32 + fr, fq * 8);
#define PG8_SA(b, h) (((b) * 2 + (h)) * HTB)
#define PG8_SB(b, h) ((4 + (b) * 2 + (h)) * HTB)
#define PG8_STAGE(bufoff, gbase, voff) do { _Pragma("unroll") for (int _i = 0; _i < 2; ++_i) \
        __builtin_amdgcn_global_load_lds((const unsigned*)((const char*)(gbase) + (voff)[_i]), (PG8_LAS unsigned*)(lds + (bufoff) + ldsw + _i * 8192), 16, 0, 0); } while (0)
#define PG8_LDA(dst, b, h) do { _Pragma("unroll") for (int m = 0; m < 4; ++m) _Pragma("unroll") for (int k = 0; k < 2; ++k) dst[m][k] = *(const PG8_LAS bf16x8*)(lds + PG8_SA(b, h) + aoff + m * 2048 + k * 1024); } while (0)
#define PG8_LDB(dst, b, h) do { _Pragma("unroll") for (int n = 0; n < 2; ++n) _Pragma("unroll") for (int k = 0; k < 2; ++k) dst[n][k] = *(const PG8_LAS bf16x8*)(lds + PG8_SB(b, h) + boff + n * 2048 + k * 1024); } while (0)
#define PG8_MMA(ai, bj, At, Bt) do { __builtin_amdgcn_s_setprio(1); _Pragma("unroll") for (int m = 0; m < 4; ++m) _Pragma("unroll") for (int n = 0; n < 2; ++n) _Pragma("unroll") for (int k = 0; k < 2; ++k) \
        acc[ai][bj][m][n] = __builtin_amdgcn_mfma_f32_16x16x32_bf16(Bt[n][k], At[m][k], acc[ai][bj][m][n], 0, 0, 0); __builtin_amdgcn_s_setprio(0); } while (0)
#define PG8_WAIT_V(n) asm volatile("s_waitcnt vmcnt(" #n ")" ::: "memory")
#define PG8_WAIT_L(n) asm volatile("s_waitcnt lgkmcnt(" #n ")" ::: "memory")
#define PG8_BAR __builtin_amdgcn_s_barrier()
#define PG8_SCHED __builtin_amdgcn_sched_barrier(0)
    Unit cur, nxt; int ui = 0;
    if (!S.next(0, cur)) return;
    f32x4 acc[2][2][4][2];
#pragma unroll
    for (int a = 0; a < 2; ++a)
#pragma unroll
        for (int b = 0; b < 2; ++b)
#pragma unroll
            for (int m = 0; m < 4; ++m)
#pragma unroll
                for (int n = 0; n < 2; ++n) acc[a][b][m][n] = (f32x4){0.f, 0.f, 0.f, 0.f};
    bf16x8 At[4][2], B0[2][2], B1[2][2];
    const char* cA = (const char*)g.A + (size_t)cur.pm * tstep; const char* cB = (const char*)g.Bt + (size_t)cur.pn * tstep;
    S.a_ready(cur);
    if constexpr (SP2) {
        PG8_STAGE(PG8_SB(0, 0), cB, voffB); PG8_STAGE(PG8_SB(0, 1), cB + hstep, voffB); PG8_STAGE(PG8_SA(0, 0), cA, voffA); PG8_STAGE(PG8_SA(0, 1), cA + hstep, voffA);
        if (wr == 1) PG8_BAR;
        PG8_WAIT_V(2); PG8_BAR;
        PG8_STAGE(PG8_SB(1, 0), cB + kstep, voffB); PG8_STAGE(PG8_SA(1, 0), cA + kstep, voffA); PG8_STAGE(PG8_SB(1, 1), cB + hstep + kstep, voffB);
        PG8_WAIT_V(6); PG8_BAR;
    } else {
        PG8_STAGE(PG8_SB(0, 0), cB, voffB); PG8_STAGE(PG8_SA(0, 0), cA, voffA); PG8_STAGE(PG8_SB(0, 1), cB + hstep, voffB); PG8_STAGE(PG8_SA(0, 1), cA + hstep, voffA);
        if (wr == 1) PG8_BAR;
        PG8_WAIT_V(4); PG8_BAR;
        PG8_STAGE(PG8_SB(1, 0), cB + kstep, voffB); PG8_STAGE(PG8_SA(1, 0), cA + kstep, voffA); PG8_STAGE(PG8_SB(1, 1), cB + hstep + kstep, voffB);
        PG8_WAIT_V(6); PG8_BAR;
    }
    for (;;) {
        const bool has_next = S.next(ui + 1, nxt);
        const char* nA = has_next ? (const char*)g.A + (size_t)nxt.pm * tstep : cA; const char* nB = has_next ? (const char*)g.Bt + (size_t)nxt.pn * tstep : cB;
        for (int t = 0; t < nt; t += 2) {
            const bool last = (t == nt - 2);
            const char* a1 = cA + (size_t)(t + 1) * kstep;
            const char* a2 = last ? nA : cA + (size_t)(t + 2) * kstep; const char* b2 = last ? nB : cB + (size_t)(t + 2) * kstep;
            const char* a3 = a2 + kstep; const char* b3 = b2 + kstep;
            if (last && has_next) S.a_ready(nxt);
            if constexpr (SP2) {
            PG8_LDB(B0, 0, 0); PG8_LDB(B1, 0, 1); PG8_SCHED; PG8_LDA(At, 0, 0); PG8_STAGE(PG8_SA(1, 1), a1 + hstep, voffA);
            PG8_WAIT_V(8); PG8_WAIT_L(0); PG8_BAR; PG8_MMA(0, 0, At, B0); PG8_MMA(0, 1, At, B1); PG8_BAR; PG8_SCHED;
            PG8_LDA(At, 0, 1); PG8_STAGE(PG8_SB(0, 0), b2, voffB); PG8_STAGE(PG8_SB(0, 1), b2 + hstep, voffB); PG8_STAGE(PG8_SA(0, 0), a2, voffA);
            PG8_WAIT_V(8); PG8_WAIT_L(0); PG8_BAR; PG8_MMA(1, 0, At, B0); PG8_MMA(1, 1, At, B1); PG8_BAR; PG8_SCHED;
            PG8_LDB(B0, 1, 0); PG8_LDB(B1, 1, 1); PG8_SCHED; PG8_LDA(At, 1, 0); PG8_STAGE(PG8_SA(0, 1), a2 + hstep, voffA);
            PG8_WAIT_V(8); PG8_WAIT_L(0); PG8_BAR; PG8_MMA(0, 0, At, B0); PG8_MMA(0, 1, At, B1); PG8_BAR; PG8_SCHED;
            PG8_LDA(At, 1, 1); PG8_STAGE(PG8_SB(1, 0), b3, voffB); PG8_STAGE(PG8_SB(1, 1), b3 + hstep, voffB); PG8_STAGE(PG8_SA(1, 0), a3, voffA);
            PG8_WAIT_V(8); PG8_WAIT_L(0); PG8_BAR; PG8_MMA(1, 0, At, B0); PG8_MMA(1, 1, At, B1); PG8_BAR; PG8_SCHED;
            } else {
            PG8_LDB(B0, 0, 0); PG8_SCHED; PG8_LDA(At, 0, 0); PG8_STAGE(PG8_SA(1, 1), a1 + hstep, voffA);
            PG8_WAIT_L(8); PG8_BAR; PG8_WAIT_L(0); PG8_MMA(0, 0, At, B0); PG8_BAR; PG8_SCHED;
            PG8_LDB(B1, 0, 1); PG8_STAGE(PG8_SB(0, 0), b2, voffB);
            PG8_BAR; PG8_WAIT_L(0); PG8_MMA(0, 1, At, B1); PG8_BAR;
            PG8_LDA(At, 0, 1); PG8_STAGE(PG8_SA(0, 0), a2, voffA);
            PG8_BAR; PG8_WAIT_L(0); PG8_MMA(1, 0, At, B0); PG8_BAR; PG8_SCHED;
            PG8_STAGE(PG8_SB(0, 1), b2 + hstep, voffB);
            PG8_WAIT_V(6); PG8_BAR; PG8_MMA(1, 1, At, B1); PG8_BAR;
            PG8_LDB(B0, 1, 0); PG8_SCHED; PG8_LDA(At, 1, 0); PG8_STAGE(PG8_SA(0, 1), a2 + hstep, voffA);
            PG8_WAIT_L(8); PG8_BAR; PG8_WAIT_L(0); PG8_MMA(0, 0, At, B0); PG8_BAR; PG8_SCHED;
            PG8_LDB(B1, 1, 1); PG8_STAGE(PG8_SB(1, 0), b3, voffB);
            PG8_BAR; PG8_WAIT_L(0); PG8_MMA(0, 1, At, B1); PG8_BAR;
            PG8_LDA(At, 1, 1); PG8_STAGE(PG8_SA(1, 0), a3, voffA);
            PG8_BAR; PG8_WAIT_L(0); PG8_MMA(1, 0, At, B0); PG8_BAR; PG8_SCHED;
            PG8_STAGE(PG8_SB(1, 1), b3 + hstep, voffB);
            PG8_WAIT_V(6); PG8_BAR; PG8_MMA(1, 1, At, B1); PG8_BAR;
            }
        }
        if constexpr (ALIGN_EPI) { if (wr == 0) PG8_BAR; }
        if constexpr (!Epi::AFTER_DRAIN) { E(acc, cur, wr, wc, fr, fq); S.done(cur); }
        if (!has_next) break;
#pragma unroll
        for (int a = 0; a < 2; ++a)
#pragma unroll
            for (int b = 0; b < 2; ++b)
#pragma unroll
                for (int m = 0; m < 4; ++m)
#pragma unroll
                    for (int n = 0; n < 2; ++n) acc[a][b][m][n] = (f32x4){0.f, 0.f, 0.f, 0.f};
        cur = nxt; cA = nA; cB = nB; ++ui;
        if constexpr (ALIGN_EPI) { if (wr == 1) PG8_BAR; }
    }
    PG8_WAIT_V(0);
    if constexpr (!ALIGN_EPI) { if (wr == 0) PG8_BAR; }
    PG8_BAR;
    if constexpr (Epi::AFTER_DRAIN) { E.fused(acc, cur, wr, wc, fr, fq, lds, wid, lane); S.done(cur); }
#undef PG8_SA
#undef PG8_SB
#undef PG8_STAGE
#undef PG8_LDA
#undef PG8_LDB
#undef PG8_MMA
#undef PG8_WAIT_V
#undef PG8_WAIT_L
#undef PG8_BAR
#undef PG8_SCHED
}
}

namespace att {
#define ALAS __attribute__((address_space(3)))
typedef short bf16x8 __attribute__((ext_vector_type(8)));
typedef short s16x4 __attribute__((ext_vector_type(4)));
typedef float f32x16 __attribute__((ext_vector_type(16)));
typedef unsigned u32x4 __attribute__((ext_vector_type(4)));
constexpr int KSLOT = 12288, VSLOT = 8192, KOFF = 0, VOFF = 2 * KSLOT, TABOFF = VOFF + 2 * VSLOT, SCROFF = TABOFF + 512, ATT_LDS = SCROFF + 8 * 128;
constexpr float LOG2E = 1.4426950408889634f;
__device__ __forceinline__ s16x4 vtr(const ALAS unsigned char* p) { return __builtin_bit_cast(s16x4, __builtin_amdgcn_ds_read_tr16_b64_v4i16((ALAS s16x4*)p)); }
__device__ __forceinline__ void glds16(const void* g, ALAS unsigned char* l) { __builtin_amdgcn_global_load_lds((const unsigned*)g, (ALAS unsigned*)l, 16, 0, 0); }
__device__ __forceinline__ int crow(int r, int hi) { return (r & 3) + 8 * (r >> 2) + 4 * hi; }

template <int MIXER> __device__ __forceinline__ void attn_unit(const Frame& F, unsigned char* ldsg, int b, int h, int j, const float* inv_freq) {
    constexpr int DQK = MIXER == 0 ? 64 : 96, ND0 = DQK / 16;
    const int lane = F.lane, w = F.wave, r32 = lane & 31, hi = lane >> 5;
    ALAS unsigned char* lds = (ALAS unsigned char*)ldsg;
    const int NT = 4 * j + 5;
    const int p0q = NMETA + 256 * j + 32 * w, p = p0q + r32, Tmax = (p0q + 31) >> 6;
    const size_t rowb = (size_t)b * LP;
    const bf16* Vb = MIXER == 0 ? F.P + OFF_VA + 64 * h : F.QKVB + 768 + 128 * h + 64;
    const int vpitch = MIXER == 0 ? DINP : NMLA;
    const float cs = (MIXER == 0 ? 0.125f : 0.10206207261596577f) * LOG2E;
    ALAS float* tab = (ALAS float*)(lds + TABOFF); ALAS float* scr = (ALAS float*)(lds + SCROFF + w * 128);
    const float b31 = MIXER == 0 ? F.rel_bias[31 * 8 + h] * LOG2E : 0.f;
    if (MIXER == 0 && F.tid < 128) tab[F.tid] = F.rel_bias[t5_bucket(F.tid) * 8 + h] * LOG2E - b31;
    const bf16* Kg = MIXER == 0 ? F.P + OFF_KA + 64 * h : F.QKVB + 768 + 128 * h;
    const unsigned kpitch = MIXER == 0 ? DINP : NMLA;
    const unsigned koff = (unsigned)(rowb + lane) * kpitch + 8u * w, peoff = (unsigned)(rowb + lane) * 32u + 8u * w;
    const unsigned voff = (unsigned)(rowb + 16 * (w & 3) + (lane >> 2)) * (unsigned)vpitch + (unsigned)((w >> 2) * 32 + (lane & 3) * 8);
#define ISSUE_TILE(T, slot) do { \
        glds16(Kg + (koff + (unsigned)(64 * (T)) * kpitch), lds + KOFF + (slot) * KSLOT + w * 1024); \
        if (MIXER == 1 && w < 4) glds16(F.KPER + (peoff + (unsigned)(64 * (T)) * 32u), lds + KOFF + (slot) * KSLOT + (8 + w) * 1024); \
        glds16(Vb + (voff + (unsigned)(64 * (T)) * (unsigned)vpitch), lds + VOFF + (slot) * VSLOT + w * 1024); } while (0)
    ISSUE_TILE(0, 0);
    bf16x8 qf[ND0];
    { const size_t qrow = rowb + p;
      const bf16* qp = MIXER == 0 ? F.P + qrow * DINP + OFF_QA + 64 * h : F.QKVB + qrow * NMLA + 96 * h;
#pragma unroll
      for (int d0 = 0; d0 < ND0; ++d0) qf[d0] = *(const bf16x8*)(qp + 16 * d0 + 8 * hi);
      if (MIXER == 1) {
        bf16x8 a = qf[4], c = qf[5];
#pragma unroll
        for (int jj = 0; jj < 8; ++jj) { const float x1 = bf2f((bf16)a[jj]), x2 = bf2f((bf16)c[jj]); const float ang = (float)p * inv_freq[8 * hi + jj]; const float co = cosf(ang), sn = sinf(ang);
            a[jj] = (short)f2bf((x1 * co - x2 * sn) * cs); c[jj] = (short)f2bf((x2 * co + x1 * sn) * cs); }
        qf[4] = a; qf[5] = c; }
#pragma unroll
      for (int d0 = 0; d0 < (MIXER == 1 ? 4 : ND0); ++d0) { bf16x8 a = qf[d0];
#pragma unroll
        for (int jj = 0; jj < 8; ++jj) a[jj] = (short)f2bf(bf2f((bf16)a[jj]) * cs);
        qf[d0] = a; } }
    const u64* bmrow = F.BM + ((size_t)b * SEQ + 256 * j + 32 * w + r32) * NW64;
    u64 mw_next = 0ull; if (MIXER == 0) mw_next = bmrow[0];
    f32x16 o0 = {}, o1 = {};
    float m = 0.f, l = 0.f;
    f32x16 negm;
#pragma unroll
    for (int r = 0; r < 16; ++r) negm[r] = b31;
    for (int T = 0; T < NT; ++T) {
        const int slot = T & 1;
        asm volatile("s_waitcnt vmcnt(0)" ::: "memory");
        __syncthreads();
        const u64 mw = mw_next;
        if (T + 1 < NT) { ISSUE_TILE(T + 1, slot ^ 1); if (MIXER == 0 && T + 1 <= Tmax) mw_next = bmrow[T + 1]; }
        if (T <= Tmax) {
            f32x16 s0 = negm, s1 = negm;
            const ALAS unsigned char* kp = lds + KOFF + slot * KSLOT + hi * 1024 + r32 * 16;
#pragma unroll
            for (int d0 = 0; d0 < ND0; ++d0) {
                const bf16x8 k0 = *(const ALAS bf16x8*)(kp + d0 * 2048), k1 = *(const ALAS bf16x8*)(kp + d0 * 2048 + 512);
                s0 = __builtin_amdgcn_mfma_f32_32x32x16_bf16(k0, qf[d0], s0, 0, 0, 0);
                s1 = __builtin_amdgcn_mfma_f32_32x32x16_bf16(k1, qf[d0], s1, 0, 0, 0);
            }
            const int dl = p - 64 * T - 4 * hi;
            const bool nearb = 64 * T + 63 > p0q - (MIXER == 0 ? 113 : 0);
            if (MIXER == 0) {
                const unsigned wl = (unsigned)mw >> (4 * hi), wh = (unsigned)(mw >> 32) >> (4 * hi);
                if (nearb) {
#pragma unroll
                    for (int r = 0; r < 16; ++r) { const int c = (r & 3) + 8 * (r >> 2);
                        const int i0 = min(max(dl - c, 0), 127), i1 = min(max(dl - c - 32, 0), 127);
                        s0[r] += tab[i0]; s1[r] += tab[i1]; }
                }
#pragma unroll
                for (int r = 0; r < 16; ++r) { const int c = (r & 3) + 8 * (r >> 2);
                    const unsigned k0 = (unsigned)__builtin_amdgcn_sbfe(wl, c, 1), k1 = (unsigned)__builtin_amdgcn_sbfe(wh, c, 1);
                    s0[r] = __uint_as_float((__float_as_uint(s0[r]) & k0) | (0xff800000u & ~k0));
                    s1[r] = __uint_as_float((__float_as_uint(s1[r]) & k1) | (0xff800000u & ~k1)); }
            } else if (nearb) {
#pragma unroll
                for (int r = 0; r < 16; ++r) { const int c = (r & 3) + 8 * (r >> 2);
                    s0[r] = (c > dl) ? -INFINITY : s0[r]; s1[r] = (c + 32 > dl) ? -INFINITY : s1[r]; }
            }
            float ta = __builtin_fmaxf(__builtin_fmaxf(s0[0], s0[1]), s1[0]), tb = __builtin_fmaxf(__builtin_fmaxf(s0[2], s0[3]), s1[1]);
            ta = __builtin_fmaxf(__builtin_fmaxf(ta, s1[2]), s1[3]);
#pragma unroll
            for (int r = 4; r < 16; r += 4) { ta = __builtin_fmaxf(__builtin_fmaxf(ta, s0[r]), s0[r + 1]); tb = __builtin_fmaxf(__builtin_fmaxf(tb, s0[r + 2]), s0[r + 3]);
                ta = __builtin_fmaxf(__builtin_fmaxf(ta, s1[r]), s1[r + 1]); tb = __builtin_fmaxf(__builtin_fmaxf(tb, s1[r + 2]), s1[r + 3]); }
            float tmax = __builtin_fmaxf(ta, tb);
            { auto rr = __builtin_amdgcn_permlane32_swap(__float_as_uint(tmax), __float_as_uint(tmax), false, false); tmax = __builtin_fmaxf(__uint_as_float(rr[0]), __uint_as_float(rr[1])); }
            if (T == 0 || __any(tmax > 8.f)) {
                const float dm = T == 0 ? tmax : __builtin_fmaxf(tmax, 0.f), al = __builtin_amdgcn_exp2f(-dm);
                m += dm; l *= al;
#pragma unroll
                for (int r = 0; r < 16; ++r) { s0[r] -= dm; s1[r] -= dm; negm[r] -= dm; }
                if (T != 0) {
                    if (hi == 0) scr[r32] = al;
                    asm volatile("s_waitcnt lgkmcnt(0)" ::: "memory");
#pragma unroll
                    for (int r = 0; r < 16; ++r) { const float a = scr[crow(r, hi)]; o0[r] *= a; o1[r] *= a; }
                }
            }
#pragma unroll
            for (int r = 0; r < 16; ++r) { s0[r] = __builtin_amdgcn_exp2f(s0[r]); s1[r] = __builtin_amdgcn_exp2f(s1[r]); }
            { f32x16 sm = s0 + s1; l += ((sm[0] + sm[1]) + (sm[2] + sm[3])) + ((sm[4] + sm[5]) + (sm[6] + sm[7])) + (((sm[8] + sm[9]) + (sm[10] + sm[11])) + ((sm[12] + sm[13]) + (sm[14] + sm[15]))); }
            bf16x8 pa[4];
#pragma unroll
            for (int ks = 0; ks < 4; ++ks) { u32x4 t;
#pragma unroll
                for (int i = 0; i < 4; ++i) { const float lo = (ks < 2) ? s0[8 * (ks & 1) + 2 * i] : s1[8 * (ks & 1) + 2 * i], hh = (ks < 2) ? s0[8 * (ks & 1) + 2 * i + 1] : s1[8 * (ks & 1) + 2 * i + 1]; t[i] = pg8::cvt_pk_bf16(lo, hh); }
                pa[ks] = __builtin_bit_cast(bf16x8, t); }
            const ALAS unsigned char* vb = lds + VOFF + slot * VSLOT + ((lane >> 4) & 1) * 32 + (lane & 3) * 8 + (4 * hi + ((lane & 15) >> 2)) * 64;
#pragma unroll
            for (int ks = 0; ks < 4; ++ks) {
                const s16x4 a0 = vtr(vb + ks * 1024), a1 = vtr(vb + ks * 1024 + 512), c0 = vtr(vb + 4096 + ks * 1024), c1 = vtr(vb + 4096 + ks * 1024 + 512);
                const bf16x8 v0 = (bf16x8){a0[0], a0[1], a0[2], a0[3], a1[0], a1[1], a1[2], a1[3]}, v1 = (bf16x8){c0[0], c0[1], c0[2], c0[3], c1[0], c1[1], c1[2], c1[3]};
                o0 = __builtin_amdgcn_mfma_f32_32x32x16_bf16(pa[ks], v0, o0, 0, 0, 0);
                o1 = __builtin_amdgcn_mfma_f32_32x32x16_bf16(pa[ks], v1, o1, 0, 0, 0);
            }
        }
    }
#undef ISSUE_TILE
    l += __shfl_xor(l, 32);
    if (hi == 0) scr[r32] = 1.f / l;
    asm volatile("s_waitcnt lgkmcnt(0)" ::: "memory");
    const int gcol = (MIXER == 0 ? OFF_GA : OFF_GB) + 64 * h + r32;
#pragma unroll
    for (int r = 0; r < 16; ++r) {
        const int q = crow(r, hi); const float rl = scr[q];
        const bf16* gp = F.P + (rowb + p0q + q) * DINP + gcol;
        const float g0 = bf2f(gp[0]), g1 = bf2f(gp[32]);
        const float y0 = o0[r] * rl * (g0 / (1.f + __expf(-g0))), y1 = o1[r] * rl * (g1 / (1.f + __expf(-g1)));
        bf16* op = F.MIX + ((size_t)b * SEQ + 256 * j + 32 * w + q) * DM + MIXER * 512 + 64 * h + r32;
        op[0] = (bf16)f2bf(y0); op[32] = (bf16)f2bf(y1);
        if ((r & 3) == 3) asm volatile("" ::: "memory");
    }
    asm volatile("s_waitcnt lgkmcnt(0)" ::: "memory");
    __syncthreads();
}
#undef ALAS
}

__device__ __forceinline__ void ph_attn_mfma(const Frame& F, unsigned char* lds, const float* inv_freq) {
    const bool bal = F.G == 256;
    const int nun = bal ? 4 : (1024 - F.bid + F.G - 1) / F.G;
    for (int i = 0; i < nun; ++i) {
        int b, h, j, mixer;
        if (bal) { const int vcu = (F.bid % 8) * 32 + F.bid / 8, bh = vcu >> 3, s = vcu & 7; b = bh >> 3; h = bh & 7; j = i < 2 ? 15 - s : s; mixer = i & 1; }
        else { const int u = F.bid + i * F.G; j = u & 15; h = (u >> 4) & 7; b = (u >> 7) & 3; mixer = u >> 9; }
        if (mixer == 0) att::attn_unit<0>(F, lds, b, h, j, inv_freq); else att::attn_unit<1>(F, lds, b, h, j, inv_freq);
    }
}

namespace idx {
#define ILAS __attribute__((address_space(3)))
#define IGAS __attribute__((address_space(1)))
__device__ __forceinline__ float relu1(float x) { return __builtin_amdgcn_fmed3f(x, 0.f, __builtin_inff()); }
typedef short bf16x8 __attribute__((ext_vector_type(8)));
typedef float f32x4 __attribute__((ext_vector_type(4)));
constexpr int NI = 33, NPAIR = 17, CAP = 128;
constexpr int QOFF = 0, CBOFF = 16384  , LCOFF = CBOFF + 256  , NEEDOFF = LCOFF + 64  , RESOFF = NEEDOFF + 64  , LISTOFF = RESOFF + 128  ,
              CHOFF = LISTOFF + 16 * CAP * 8  , IDX_LDS = CHOFF + 512;

__device__ __forceinline__ void index_unit(const Frame& F, unsigned char* ldsg, int b, int u) {
    const int lane = F.lane, w = F.wave, q = lane & 15, g = lane >> 4;
    ILAS unsigned char* lds = (ILAS unsigned char*)ldsg;
    ILAS int* cbuf = (ILAS int*)(lds + CBOFF); ILAS int* lcount = (ILAS int*)(lds + LCOFF); ILAS int* needs = (ILAS int*)(lds + NEEDOFF);
    ILAS unsigned* res = (ILAS unsigned*)(lds + RESOFF); ILAS unsigned* list = (ILAS unsigned*)(lds + LISTOFF);
    const size_t rowb = (size_t)b * LP;
    const int p = NMETA + 16 * u + q;
    const int nkt = u + 2;
    const int ni = (nkt - w + 7) >> 3;
    const int nwrite = 16 * (u >> 4) + 20;
    { const bf16* qp = F.P + (rowb + p) * DINP + OFF_QI + 64 * w + 8 * g;
      *(ILAS bf16x8*)(lds + QOFF + ((w * 2 + 0) * 64 + lane) * 16) = *(const bf16x8*)(qp);
      *(ILAS bf16x8*)(lds + QOFF + ((w * 2 + 1) * 64 + lane) * 16) = *(const bf16x8*)(qp + 32); }
    if (w == 0) { cbuf[lane & 47] = 0; if (lane < 16) lcount[lane] = 0; }
    ILAS float* chs = (ILAS float*)(lds + CHOFF);
    if (w == 1 && lane < 16) { const v4u wv = *(const v4u*)(F.P + (rowb + p) * DINP + OFF_WI);
#pragma unroll
      for (int h = 0; h < 4; ++h) { chs[(2 * h) * 16 + lane] = __uint_as_float(wv[h] << 16) * 0.35355339059327373f * 0.125f; chs[(2 * h + 1) * 16 + lane] = __uint_as_float(wv[h] & 0xffff0000u) * 0.35355339059327373f * 0.125f; } }
    asm volatile("s_waitcnt lgkmcnt(0)" ::: "memory");
    __syncthreads();
    unsigned kr[NI][4];
    const bf16* kptr = F.KIC + 8 * g + (unsigned)(rowb + 16 * w + q) * 64u;
    bf16x8 ka0 = {}, ka1 = {}, kb0 = {}, kb1 = {}, na0 = {}, na1 = {}, nb0 = {}, nb1 = {};
    if (ni > 0) { ka0 = *(const IGAS bf16x8*)(kptr); ka1 = *(const IGAS bf16x8*)(kptr + 32); }
    if (ni > 1) { kb0 = *(const IGAS bf16x8*)(kptr + 128 * 64); kb1 = *(const IGAS bf16x8*)(kptr + 128 * 64 + 32); }
#define IDX_KEYS(i_, S0, S1, S2, S3, valid_) do { int g4a = 4 * g; asm volatile("" : "+v"(g4a)); int wo_ = w; asm volatile("" : "+s"(wo_)); const int s0_ = 16 * (wo_ + 8 * (i_)) + g4a; \
        kr[i_][0] = ((valid_) && s0_ + 0 >= NMETA && s0_ + 0 <= p) ? fkey(S0) : 0u; kr[i_][1] = ((valid_) && s0_ + 1 >= NMETA && s0_ + 1 <= p) ? fkey(S1) : 0u; \
        kr[i_][2] = ((valid_) && s0_ + 2 >= NMETA && s0_ + 2 <= p) ? fkey(S2) : 0u; kr[i_][3] = ((valid_) && s0_ + 3 >= NMETA && s0_ + 3 <= p) ? fkey(S3) : 0u; } while (0)
#pragma unroll
    for (int m = 0; m < 16; ++m) {
        const int iA = 2 * m, iB = 2 * m + 1;
        if (iA < ni) {
            kptr += 256 * 64; asm volatile("" : "+v"(kptr));
            if (iA + 2 < ni) { na0 = *(const IGAS bf16x8*)(kptr); na1 = *(const IGAS bf16x8*)(kptr + 32); }
            if (iB + 2 < ni) { nb0 = *(const IGAS bf16x8*)(kptr + 128 * 64); nb1 = *(const IGAS bf16x8*)(kptr + 128 * 64 + 32); }
            float sa0 = 0.f, sa1 = 0.f, sa2 = 0.f, sa3 = 0.f, sb0 = 0.f, sb1 = 0.f, sb2 = 0.f, sb3 = 0.f;
            unsigned qa = QOFF + lane * 16, qc = CHOFF + q * 4;
#pragma nounroll
            for (int h = 0; h < 8; ++h, qa += 2048, qc += 64) {
                const bf16x8 q0 = *(const ILAS bf16x8*)(lds + qa), q1 = *(const ILAS bf16x8*)(lds + qa + 1024);
                const float chh = *(const ILAS float*)(lds + qc);
                f32x4 accA = {0.f, 0.f, 0.f, 0.f}, accB = {0.f, 0.f, 0.f, 0.f};
                accA = __builtin_amdgcn_mfma_f32_16x16x32_bf16(ka0, q0, accA, 0, 0, 0);
                accB = __builtin_amdgcn_mfma_f32_16x16x32_bf16(kb0, q0, accB, 0, 0, 0);
                accA = __builtin_amdgcn_mfma_f32_16x16x32_bf16(ka1, q1, accA, 0, 0, 0);
                accB = __builtin_amdgcn_mfma_f32_16x16x32_bf16(kb1, q1, accB, 0, 0, 0);
                sa0 += relu1(accA[0]) * chh; sa1 += relu1(accA[1]) * chh; sa2 += relu1(accA[2]) * chh; sa3 += relu1(accA[3]) * chh;
                sb0 += relu1(accB[0]) * chh; sb1 += relu1(accB[1]) * chh; sb2 += relu1(accB[2]) * chh; sb3 += relu1(accB[3]) * chh;
            }
            IDX_KEYS(iA, sa0, sa1, sa2, sa3, true);
            IDX_KEYS(iB, sb0, sb1, sb2, sb3, iB < ni);
            ka0 = na0; ka1 = na1; kb0 = nb0; kb1 = nb1;
        } else {
            kr[iA][0] = 0u; kr[iA][1] = 0u; kr[iA][2] = 0u; kr[iA][3] = 0u; kr[iB][0] = 0u; kr[iB][1] = 0u; kr[iB][2] = 0u; kr[iB][3] = 0u;
        }
    }
    if (32 < ni) {
        float sa0 = 0.f, sa1 = 0.f, sa2 = 0.f, sa3 = 0.f;
        unsigned qa = QOFF + lane * 16, qc = CHOFF + q * 4; asm volatile("" : "+v"(qa), "+v"(qc));
#pragma unroll
        for (int h = 0; h < 8; ++h) {
            const bf16x8 q0 = *(const ILAS bf16x8*)(lds + qa + (h * 2 + 0) * 1024), q1 = *(const ILAS bf16x8*)(lds + qa + (h * 2 + 1) * 1024);
            const float chh = *(const ILAS float*)(lds + qc + h * 64);
            f32x4 accA = {0.f, 0.f, 0.f, 0.f};
            accA = __builtin_amdgcn_mfma_f32_16x16x32_bf16(ka0, q0, accA, 0, 0, 0);
            accA = __builtin_amdgcn_mfma_f32_16x16x32_bf16(ka1, q1, accA, 0, 0, 0);
            sa0 += relu1(accA[0]) * chh; sa1 += relu1(accA[1]) * chh; sa2 += relu1(accA[2]) * chh; sa3 += relu1(accA[3]) * chh;
        }
        IDX_KEYS(32, sa0, sa1, sa2, sa3, true);
    } else { kr[32][0] = 0u; kr[32][1] = 0u; kr[32][2] = 0u; kr[32][3] = 0u; }
#undef IDX_KEYS
    int rk = 0;
#define IDX_REDUCE(c, out) do { const int nx_ = rk == 2 ? 0 : rk + 1; __hip_atomic_fetch_add(&cbuf[rk * 16 + q], (c), __ATOMIC_RELAXED, __HIP_MEMORY_SCOPE_WORKGROUP); \
        if (w == 0 && lane < 16) cbuf[nx_ * 16 + lane] = 0; \
        asm volatile("s_waitcnt lgkmcnt(0)" ::: "memory"); __syncthreads(); out = cbuf[rk * 16 + q]; rk = nx_; } while (0)
#define IDX_BISECT(X, target, t15, cge, cgt) do { t15 = 0u; cge = 0; \
        for (int bit = 14; bit >= 0; --bit) { const unsigned cand_ = t15 | (1u << bit), C_ = cand_ * 0x00010001u; int c_ = 0; \
            _Pragma("unroll") for (int i = 0; i < NI; ++i) if (i < ni) { c_ = __builtin_popcount((X[i][0] - C_) & 0x80008000u) + c_; c_ = __builtin_popcount((X[i][1] - C_) & 0x80008000u) + c_; } \
            int tot_; IDX_REDUCE(c_, tot_); if (tot_ >= (target)) { t15 = cand_; cge = tot_; } } \
        { const unsigned C_ = (t15 + 1u) * 0x00010001u; int c_ = 0; \
          _Pragma("unroll") for (int i = 0; i < NI; ++i) if (i < ni) { c_ = __builtin_popcount((X[i][0] - C_) & 0x80008000u) + c_; c_ = __builtin_popcount((X[i][1] - C_) & 0x80008000u) + c_; } \
          IDX_REDUCE(c_, cgt); } } while (0)
    unsigned thr = 0u; int sstar = LP;
    unsigned t0; int cge0, cgt0; bool live, big;
    {
        unsigned X[NI][2];
#pragma unroll
        for (int i = 0; i < NI; ++i) { X[i][0] = (((kr[i][1] & 0xffff0000u) | (kr[i][0] >> 16)) >> 1) | 0x80008000u; X[i][1] = (((kr[i][3] & 0xffff0000u) | (kr[i][2] >> 16)) >> 1) | 0x80008000u; }
        IDX_BISECT(X, KSEL, t0, cge0, cgt0);
        live = t0 != 0u;
        big = __any(live && cge0 - cgt0 > CAP);
        if (!big) {
            if (w == 0 && g == 0) needs[q] = KSEL - cgt0;
#pragma unroll
            for (int i = 0; i < NI; ++i) if (i < ni) {
                const unsigned Cp = (t0 | 0x8000u) * 0x00010001u, e0 = X[i][0] ^ Cp, e1 = X[i][1] ^ Cp;
                const unsigned z = (((e0 - 0x00010001u) & ~e0) | ((e1 - 0x00010001u) & ~e1)) & 0x80008000u;
                if (live && z != 0u) {
                    int g4b = 4 * g; asm volatile("" : "+v"(g4b)); int wo = w; asm volatile("" : "+s"(wo));
#pragma nounroll
                    for (int jj = 0; jj < 4; ++jj) {
                        const unsigned k = jj == 0 ? kr[i][0] : jj == 1 ? kr[i][1] : jj == 2 ? kr[i][2] : kr[i][3];
                        if ((k >> 17) == t0) {
                            const int pos = __hip_atomic_fetch_add(&lcount[q], 1, __ATOMIC_RELAXED, __HIP_MEMORY_SCOPE_WORKGROUP);
                            if (pos < CAP) { list[(q * CAP + pos) * 2] = k; list[(q * CAP + pos) * 2 + 1] = (unsigned)(16 * (wo + 8 * i) + g4b + jj); } }
                    }
                }
            }
        }
    }
    if (!big) {
        asm volatile("s_waitcnt lgkmcnt(0)" ::: "memory");
        __syncthreads();
        { const int q2 = 2 * w + (lane >> 5), e0 = lane & 31, mq = min(lcount[q2], CAP), nd = needs[q2];
          for (int e = e0; e < mq; e += 32) {
              const unsigned ke = list[(q2 * CAP + e) * 2], se = list[(q2 * CAP + e) * 2 + 1]; int rank = 0;
              for (int f = 0; f < mq; ++f) { const unsigned kf = list[(q2 * CAP + f) * 2], sf = list[(q2 * CAP + f) * 2 + 1]; rank += (kf > ke || (kf == ke && sf < se)) ? 1 : 0; }
              if (rank == nd - 1) { res[2 * q2] = ke; res[2 * q2 + 1] = se; } } }
        asm volatile("s_waitcnt lgkmcnt(0)" ::: "memory");
        __syncthreads();
        { int qo = q; asm volatile("" : "+v"(qo)); if (live) { thr = res[2 * qo]; sstar = (int)res[2 * qo + 1]; } }
    } else {
        for (int bit = 31; bit >= 0; --bit) {
            const unsigned cand = thr | (1u << bit); int c = 0;
#pragma unroll
            for (int i = 0; i < NI; ++i) if (i < ni) c += (int)(kr[i][0] >= cand) + (int)(kr[i][1] >= cand) + (int)(kr[i][2] >= cand) + (int)(kr[i][3] >= cand);
            int tot; IDX_REDUCE(c, tot);
            if (tot >= KSEL) thr = cand;
        }
        int c = 0;
#pragma unroll
        for (int i = 0; i < NI; ++i) if (i < ni) {
#pragma unroll
            for (int jj = 0; jj < 4; ++jj) c += (int)(kr[i][jj] >= thr) + ((int)(kr[i][jj] > thr) << 16); }
        int tot; IDX_REDUCE(c, tot);
        const int cge2 = tot & 0xffff, cgt2 = tot >> 16;
        const bool tie = thr != 0u && cge2 > KSEL;
        const int need = KSEL - cgt2; int lo = 0, hi = LP - 1;
        for (int it = 0; it < 13; ++it) {
            const int mid = (lo + hi) >> 1; int c2 = 0;
#pragma unroll
            for (int i = 0; i < NI; ++i) if (i < ni) { int g4b = 4 * g; asm volatile("" : "+v"(g4b)); int wo = w; asm volatile("" : "+s"(wo));
#pragma unroll
                for (int jj = 0; jj < 4; ++jj) c2 += (int)(kr[i][jj] == thr && 16 * (wo + 8 * i) + g4b + jj <= mid); }
            int t2; IDX_REDUCE(c2, t2);
            if (lo < hi) { if (t2 >= need) hi = mid; else lo = mid + 1; }
        }
        if (tie) sstar = lo;
    }
#undef IDX_BISECT
    const unsigned te = thr == 0u ? 1u : thr;
    unsigned short* bm16 = (unsigned short*)(F.BM + ((size_t)b * SEQ + 16 * u + q) * NW64);
#pragma unroll
    for (int i = 0; i < NI; ++i) {
        int wo = w; asm volatile("" : "+s"(wo));
        const int kt = wo + 8 * i;
        if (kt < nwrite) {
            unsigned nib = 0u; int g4c = 4 * g; asm volatile("" : "+v"(g4c));
#pragma unroll
            for (int jj = 0; jj < 4; ++jj) { const unsigned k = kr[i][jj]; const int s = 16 * kt + g4c + jj;
                const bool sel = (s < NMETA) || (k >= te && (k > thr || s <= sstar)); nib |= sel ? (1u << jj) : 0u; }
            unsigned v = nib << (4 * g); v |= __shfl_xor(v, 16); v |= __shfl_xor(v, 32);
            if (g == 0) bm16[kt] = (unsigned short)v;
        }
    }
#undef IDX_REDUCE
    __syncthreads();
}
#undef ILAS
#undef IGAS
}

__device__ __forceinline__ void ph_index_mfma(const Frame& F, unsigned char* lds) {
    const bool bal = F.G == 256;
    const int nun = bal ? 4 : (1024 - F.bid + F.G - 1) / F.G;
    for (int i = 0; i < nun; ++i) {
        int b, u, bid = F.bid; asm volatile("" : "+s"(bid));
        if (bal) { const int s = bid & 63; b = bid >> 6; u = i == 0 ? 255 - s : i == 1 ? 128 + s : i == 2 ? 127 - s : s; }
        else { const int t = bid + i * F.G; b = t >> 8; u = t & 255; }
        idx::index_unit(F, lds, b, u);
    }
}

#define LAS __attribute__((address_space(3)))
#define XB_TMO      128
#define XB_XCNT(j)  (256  + 64 * (j))
#define XB_XSUB(j)  (1280 + 64 * (j))
#define XB_XGEN(j)  (2304 + 64 * (j))
#define XB_TOP      3328
#define XB_TOPGEN   3392
#define XCD_BAR_WORDS 3456
#define XB_SPIN_CAP (1u << 18)

__device__ __forceinline__ unsigned xb_ld(unsigned* p)              { return __hip_atomic_load(p, __ATOMIC_RELAXED, __HIP_MEMORY_SCOPE_AGENT); }
__device__ __forceinline__ unsigned xb_add(unsigned* p, unsigned v) { return __hip_atomic_fetch_add(p, v, __ATOMIC_RELAXED, __HIP_MEMORY_SCOPE_AGENT); }
__device__ __forceinline__ unsigned xb_xcc_id() { return (unsigned)__builtin_amdgcn_s_getreg((3 << 11) | 20) & 0xFu; }
#define XB_SPIN(cond, bar) do { unsigned _sp = 0; while (cond) { __builtin_amdgcn_s_sleep(1); \
    if ((++_sp & 255u) == 0u) { if (xb_ld(&(bar)[XB_TMO])) break; if (_sp > XB_SPIN_CAP) { atomicAdd(&(bar)[XB_TMO], 1u); break; } } } } while (0)

struct XcdBarrier {
    unsigned* bar; unsigned x;
    volatile LAS unsigned* st;
};

__device__ __forceinline__ XcdBarrier xcd_barrier_post(unsigned* bar, volatile LAS unsigned* st) {
    XcdBarrier b; b.bar = bar; b.x = xb_xcc_id(); b.st = st;
    if (threadIdx.x == 0) (void)xb_add(&bar[XB_XCNT(b.x)], 1u);
    return b;
}
__device__ __forceinline__ void xcd_barrier_complete(unsigned* bar, unsigned x, unsigned& nloc, unsigned& nx) {
    const unsigned G = gridDim.x * gridDim.y * gridDim.z;
    unsigned sum, cnt, mine, sp = 0u;
    for (;;) {
        sum = 0u; cnt = 0u; mine = 0u;
#pragma unroll
        for (unsigned j = 0; j < 16; ++j) { const unsigned c = xb_ld(&bar[XB_XCNT(j)]); sum += c; cnt += (c > 0u) ? 1u : 0u; mine = (j == x) ? c : mine; }
        if (sum == G) break;
        __builtin_amdgcn_s_sleep(1);
        if ((++sp & 255u) == 0u) { if (xb_ld(&bar[XB_TMO])) break; if (sp > XB_SPIN_CAP) { atomicAdd(&bar[XB_TMO], 1u); break; } }
    }
    nloc = mine > 0u ? mine : 1u; nx = cnt > 0u ? cnt : 1u;
}

__device__ __forceinline__ void xcd_barrier(const XcdBarrier& b) {
    asm volatile("s_waitcnt vmcnt(0)" ::: "memory");
    __syncthreads();
    if (threadIdx.x == 0) {
        unsigned* bar = b.bar;
        __builtin_amdgcn_s_waitcnt(0);
        unsigned nloc = b.st[0], nx = b.st[1];
        if (nloc == 0u) { xcd_barrier_complete(bar, b.x, nloc, nx); b.st[0] = nloc; b.st[1] = nx; }
        const unsigned old = xb_add(&bar[XB_XSUB(b.x)], 1u);
        const unsigned gen = old / nloc;
        if (old + 1u == (gen + 1u) * nloc) {
            __builtin_amdgcn_fence(__ATOMIC_RELEASE, "agent");
            asm volatile("s_waitcnt vmcnt(0)" ::: "memory");
            const unsigned og = xb_add(&bar[XB_TOP], 1u);
            const unsigned tg = og / nx;
            if (og + 1u == (tg + 1u) * nx) xb_add(&bar[XB_TOPGEN], 1u);
            else XB_SPIN(xb_ld(&bar[XB_TOPGEN]) == tg, bar);
            __builtin_amdgcn_fence(__ATOMIC_ACQUIRE, "agent");
            xb_add(&bar[XB_XGEN(b.x)], 1u);
            asm volatile("s_waitcnt vmcnt(0)" ::: "memory");
        } else {
            XB_SPIN(xb_ld(&bar[XB_XGEN(b.x)]) == gen, bar);
            __builtin_amdgcn_fence(__ATOMIC_ACQUIRE, "agent");
            asm volatile("s_waitcnt vmcnt(0)" ::: "memory");
        }
    }
    __syncthreads();
}

constexpr int LDS_BYTES = 147456, MISC_OFF = 131072 + 320;
__global__ void __launch_bounds__(512, 2) fwd(Args args) {
    extern __shared__ __attribute__((aligned(16))) unsigned char lds[];
    Frame F;
    F.tid = threadIdx.x; F.lane = F.tid & 63; F.wave = __builtin_amdgcn_readfirstlane(F.tid >> 6); F.G = gridDim.x; F.bid = blockIdx.x;
    F.x = args.in[0]; F.meta = args.in[1]; F.lne_g = args.in[2]; F.lne_b = args.in[3]; F.w_in = args.in[4]; F.w_uq = args.in[5]; F.qn_g = args.in[6];
    F.w_ukv = args.in[7]; F.kvn_g = args.in[8]; F.rel_bias = args.in[9]; F.w_out = args.in[10]; F.lnp_g = args.in[11]; F.lnp_b = args.in[12];
    F.out = args.out;
    unsigned char* ws = args.ws;
    F.Win_t = (bf16*)(ws + WS_WIN); F.Wmla_t = (bf16*)(ws + WS_WMLA); F.Wout_t = (bf16*)(ws + WS_WOUT); F.KPER = (bf16*)(ws + WS_KPER);
    F.BM = (u64*)(ws + WS_BM); F.CQKVN = (bf16*)(ws + WS_CQKVN); F.XN = (bf16*)(ws + WS_XN); F.MIX = (bf16*)(ws + WS_XN);
    F.QKVB = (bf16*)(ws + WS_QKVB); F.P = (bf16*)(ws + WS_P); F.Z = (float*)(ws + WS_P); F.KIC = (bf16*)(ws + WS_KIC);
    const int lo = args.ph_lo, hi = args.ph_hi;
    volatile LAS unsigned* MISC = (volatile LAS unsigned*)((LAS unsigned char*)lds + MISC_OFF);
    if (F.tid < 32) MISC[F.tid] = 0u;
    __syncthreads();
    XcdBarrier bar = xcd_barrier_post((unsigned*)(ws + WS_CTL) + 4096, MISC + 8);
#define IN(k) (lo <= (k) && (k) < hi)
#define SEAM(k) do { if (IN(k) && IN((k) + 1)) xcd_barrier(bar); } while (0)
    if (IN(0)) ph_prologue(F, (float*)lds);
    SEAM(0);
    PG8_LAS unsigned char* ring = (PG8_LAS unsigned char*)lds;
    if (IN(1)) { pg8::Gemm g{F.XN, F.Win_t, MROWS, DINP, DM}; pg8::StaticOrder S; S.init(MROWS, DINP, F.G, F.bid); pg8::EpiBf16 E{F.P, DINP};
        pg8::gemm_phase<pg8::EpiBf16, pg8::StaticOrder, true, true>(ring, g, S, E); }
    SEAM(1);
    if (IN(2)) ph_rms(F, args.inv_freq);
    SEAM(2);
    if (IN(3)) { { pg8::Gemm g{F.CQKVN, F.Wmla_t, MROWS, NMLA, KMLA}; pg8::StaticOrder S; S.init(MROWS, NMLA, F.G, F.bid); pg8::EpiBf16 E{F.QKVB, NMLA};
        pg8::gemm_phase<pg8::EpiBf16, pg8::StaticOrder, true, true>(ring, g, S, E); }
        __syncthreads(); ph_index_mfma(F, lds); }
    SEAM(3);
    if (IN(4)) ph_attn_mfma(F, lds, args.inv_freq);
    SEAM(4);
    if (IN(5)) { pg8::Gemm g{F.MIX, F.Wout_t, MQ, DM, DM}; pg8::StaticOrder S; S.init(MQ, DM, F.G, F.bid); pg8::EpiF32 E{F.Z, DM, nullptr};
        pg8::gemm_phase<pg8::EpiF32, pg8::StaticOrder, true, true>(ring, g, S, E); }
    SEAM(5);
    if (IN(6)) ph_final(F);
#undef IN
#undef SEAM
}

#ifndef MK_N_LAUNCHES
#define MK_N_LAUNCHES 1
#endif
extern "C" void kernel_launch(void* const* d_in, const int* in_sizes, int n_in, void* d_out, int out_size, void* d_ws, size_t ws_size, hipStream_t stream) {
    static int grid_blocks = 0;
    if (!grid_blocks) {
        if (n_in != 13 || out_size != MQ * DM || ws_size < WS_END) { fprintf(stderr, "kernel_launch: unexpected shapes (n_in %d out %d ws %zu)\n", n_in, out_size, ws_size); grid_blocks = -1; return; }
        if (hipFuncSetAttribute((const void*)fwd, hipFuncAttributeMaxDynamicSharedMemorySize, LDS_BYTES) != hipSuccess) { fprintf(stderr, "kernel_launch: hipFuncSetAttribute failed\n"); grid_blocks = -1; return; }
        int dev = 0, cus = 0, per_cu = 0;
        (void)hipGetDevice(&dev);
        (void)hipDeviceGetAttribute(&cus, hipDeviceAttributeMultiprocessorCount, dev);
        (void)hipOccupancyMaxActiveBlocksPerMultiprocessor(&per_cu, (const void*)fwd, 512, LDS_BYTES);
        if (per_cu < 1 || cus < 1) { fprintf(stderr, "kernel_launch: occupancy query says %d blocks/CU on %d CUs\n", per_cu, cus); grid_blocks = -1; return; }
        grid_blocks = cus;
    }
    if (grid_blocks < 0) return;
    Args a{};
    for (int i = 0; i < 13; ++i) a.in[i] = (const float*)d_in[i];
    a.out = (float*)d_out; a.ws = (unsigned char*)d_ws;
    for (int i = 0; i < 16; ++i) a.inv_freq[i] = (float)pow(10000.0, -(double)(2 * i) / 32.0);
    (void)hipMemsetAsync((char*)d_ws + WS_CTL, 0, 65536, stream);
    a.ph_lo = 0; a.ph_hi = 7;
    hipLaunchKernelGGL(fwd, dim3(grid_blocks), dim3(512), LDS_BYTES, stream, a);
}
```
